# Optimizing an MI355X kernel written in HIP

```python
import math
import jax, jax.numpy as jnp
from jax import lax
import numpy as np

D_MODEL = 1024
BATCH = 8
SEQ = 4096
DEPTH = 1
DEC_BATCH = 4
DEC_SEQ = 4096
PAST_LEN = 128

HYENA_WIDTH = D_MODEL // 2
RET_WIDTH = D_MODEL - HYENA_WIDTH
HYENA_ORDER = 2
HYENA_COLS = (HYENA_ORDER + 1) * HYENA_WIDTH
FILTER_BANDS = 16
FILTER_EMB = 1 + 2 * FILTER_BANDS
FILTER_HIDDEN = 64
DECAY_TARGET = 1e-2
FAST_DECAY_PCT = 0.3
SLOW_DECAY_PCT = 1.5
RET_HEADS = 8
RET_HEAD_DIM = RET_WIDTH // RET_HEADS
RET_COLS = 4 * RET_WIDTH
CHUNK = 128
ROPE_BASE = 10000.0
DECAY_OFFSET_FWD = 5.0
DECAY_OFFSET_BWD = 5.5
D_FF = ((8 * D_MODEL // 3 + 127) // 128) * 128
IN_COLS = HYENA_COLS + RET_COLS
EPS = 1e-6

kernel_name = 'hyena_retention_hybrid_encoder'

F32 = jnp.float32


def rmsnorm(x, g):
    xf = x.astype(F32)
    y = xf * lax.rsqrt(jnp.mean(xf * xf, axis=-1, keepdims=True) + EPS) * g.astype(F32)
    return y.astype(x.dtype)


def dwconv3(u, w, b):
    up = jnp.pad(u, ((0, 0), (1, 1), (0, 0)))
    return up[:, :-2] * w[0] + up[:, 1:-1] * w[1] + up[:, 2:] * w[2] + b


def hyena_filter_spectra(L, w1, b1, w2, b2, w3, b3, freq, w4):
    w1, b1, w2, b2, w3, b3, freq, w4 = (a.astype(F32) for a in (w1, b1, w2, b2, w3, b3, freq, w4))
    pos = jnp.arange(L, dtype=F32)[:, None]
    t = jnp.linspace(0.0, 1.0, L, dtype=F32)[:, None]
    bands = jnp.linspace(1e-4, FILTER_BANDS - 1, FILTER_BANDS, dtype=F32)[None, :]
    ang = (2.0 * math.pi / L) * pos * bands
    z = jnp.concatenate([t, jnp.cos(ang), -jnp.sin(ang)], axis=-1)
    h = jnp.sin(freq * (z @ w1 + b1))
    h = jnp.sin(freq * (h @ w2 + b2))
    h = jnp.sin(freq * (h @ w3 + b3))
    h = (h @ w4).reshape(L, 2, HYENA_ORDER, HYENA_WIDTH)
    deltas = jnp.abs(jnp.linspace(math.log(DECAY_TARGET) / FAST_DECAY_PCT,
                                  math.log(DECAY_TARGET) / SLOW_DECAY_PCT,
                                  HYENA_WIDTH, dtype=F32))
    h = h * jnp.exp(-t * deltas)[:, None, None, :]
    h_fwd, h_bwd = h[:, 0], h[:, 1]
    two_sided = jnp.concatenate([h_fwd, jnp.zeros_like(h_fwd[:1]), h_bwd[1:][::-1]], axis=0)
    return jnp.fft.rfft(two_sided, axis=0)


def long_conv(u, spec, bias):
    L = u.shape[1]
    uf32 = u.astype(F32)
    uf = jnp.fft.rfft(uf32, n=2 * L, axis=1)
    y = jnp.fft.irfft(uf * spec[None], n=2 * L, axis=1)[:, :L]
    return (y + uf32 * bias.astype(F32)).astype(u.dtype)


def hyena_mixer(p, conv_w, conv_b, spec, bias, out_g):
    p = dwconv3(p, conv_w, conv_b)
    parts = jnp.split(p, HYENA_ORDER + 1, axis=-1)
    z = parts[0]
    for o in range(HYENA_ORDER):
        z = parts[o + 1] * long_conv(z, spec[:, o], bias[o])
    return rmsnorm(z, out_g)


def rotary(x):
    L = x.shape[1]
    half = RET_HEAD_DIM // 2
    inv = ROPE_BASE ** (-jnp.arange(0, RET_HEAD_DIM, 2, dtype=F32) / RET_HEAD_DIM)
    ang = jnp.arange(L, dtype=F32)[:, None] * inv[None, :]
    cos = jnp.cos(ang)[None, :, None, :]
    sin = jnp.sin(ang)[None, :, None, :]
    x1, x2 = x[..., :half], x[..., half:]
    return jnp.concatenate([x1 * cos - x2 * sin, x2 * cos + x1 * sin], axis=-1)


def retention_decays(offset):
    return 1.0 - 2.0 ** (-offset - jnp.arange(RET_HEADS, dtype=F32))


def chunk_retention(q, k, v, gamma, include_diag):
    B, H, L, Dh = q.shape
    n = L // CHUNK
    q = q.reshape(B, H, n, CHUNK, Dh)
    k = k.reshape(B, H, n, CHUNK, Dh)
    v = v.reshape(B, H, n, CHUNK, Dh)
    log_g = jnp.log(gamma)
    idx = jnp.arange(CHUNK, dtype=F32)
    diff = idx[:, None] - idx[None, :]
    mask = (diff >= 0) if include_diag else (diff > 0)
    decay_in = jnp.where(mask[None], jnp.exp(jnp.where(mask, diff, 0.0)[None] * log_g[:, None, None]), 0.0)
    scores = jnp.einsum('bhncd,bhnsd->bhncs', q, k) * decay_in[None, :, None]
    intra = jnp.einsum('bhncs,bhnse->bhnce', scores, v)
    key_decay = jnp.exp((CHUNK - 1.0 - idx)[None, :] * log_g[:, None])
    query_decay = jnp.exp((idx + 1.0)[None, :] * log_g[:, None])
    chunk_decay = jnp.exp(CHUNK * log_g)[None, :, None, None]
    kv = jnp.einsum('bhncd,hc,bhnce->nbhde', k, key_decay, v)

    def step(state, kv_n):
        return state * chunk_decay + kv_n, state

    _, prev = lax.scan(step, jnp.zeros((B, H, Dh, Dh), F32), kv)
    cross = jnp.einsum('bhncd,nbhde->bhnce', q, prev) * query_decay[None, :, None, :, None]
    return (intra + cross).reshape(B, H, L, Dh)


def retention_mixer(p, gn_g, gn_b):
    B, L, _ = p.shape
    q, k, v, g = jnp.split(p.astype(F32), 4, axis=-1)
    heads = lambda a: a.reshape(B, L, RET_HEADS, RET_HEAD_DIM)
    q = rotary(heads(q)).transpose(0, 2, 1, 3)
    k = (rotary(heads(k)) * RET_HEAD_DIM ** -0.5).transpose(0, 2, 1, 3)
    v = heads(v).transpose(0, 2, 1, 3)
    o_fwd = chunk_retention(q, k, v, retention_decays(DECAY_OFFSET_FWD), True)
    o_bwd = chunk_retention(q[:, :, ::-1], k[:, :, ::-1], v[:, :, ::-1],
                            retention_decays(DECAY_OFFSET_BWD), False)[:, :, ::-1]
    o = o_fwd + o_bwd
    mu = jnp.mean(o, axis=-1, keepdims=True)
    oc = o - mu
    o = oc * lax.rsqrt(jnp.mean(oc * oc, axis=-1, keepdims=True) + EPS)
    o = o.transpose(0, 2, 1, 3).reshape(B, L, RET_WIDTH) * gn_g.astype(F32) + gn_b.astype(F32)
    return (o * jax.nn.silu(g)).astype(p.dtype)


def conv_ffn(x, w_up, conv_w, conv_b, w_down):
    u = dwconv3(x @ w_up, conv_w, conv_b)
    a, b = jnp.split(u, 2, axis=-1)
    return (jax.nn.gelu(a) * b) @ w_down


def trunk(x, prm):
    L = x.shape[1]
    for l in range(DEPTH):
        spec = hyena_filter_spectra(L, prm['filt_w1'][l], prm['filt_b1'][l], prm['filt_w2'][l],
                                    prm['filt_b2'][l], prm['filt_w3'][l], prm['filt_b3'][l],
                                    prm['filt_freq'][l], prm['filt_w4'][l])
        h = rmsnorm(x, prm['norm1_g'][l])
        p = h @ prm['w_in'][l]
        y_hy = hyena_mixer(p[..., :HYENA_COLS], prm['hy_conv_w'][l], prm['hy_conv_b'][l],
                           spec, prm['hy_bias'][l], prm['hy_out_g'][l])
        y_rt = retention_mixer(p[..., HYENA_COLS:], prm['ret_gn_g'][l], prm['ret_gn_b'][l])
        x = x + jnp.concatenate([y_hy, y_rt], axis=-1) @ prm['w_out'][l]
        x = x + conv_ffn(rmsnorm(x, prm['norm2_g'][l]), prm['w_up'][l], prm['ffn_conv_w'][l],
                         prm['ffn_conv_b'][l], prm['w_down'][l])
    return rmsnorm(x, prm['final_g'])


def setup_inputs(seed: int = 0) -> dict:
    key = jax.random.key(seed)
    ks = jax.random.split(key, 26)
    nrm = lambda k, shape, s: jax.random.normal(k, shape, F32) * s
    return {
        'x_prompt': nrm(ks[0], (BATCH, SEQ, D_MODEL), 1.0),
        'x_sample': nrm(ks[1], (DEC_BATCH, DEC_SEQ, D_MODEL), 1.0),
        'norm1_g': 1.0 + nrm(ks[2], (DEPTH, D_MODEL), 0.02),
        'w_in': nrm(ks[3], (DEPTH, D_MODEL, IN_COLS), D_MODEL ** -0.5),
        'hy_conv_w': nrm(ks[4], (DEPTH, 3, HYENA_COLS), 3 ** -0.5),
        'hy_conv_b': nrm(ks[5], (DEPTH, HYENA_COLS), 0.02),
        'filt_w1': nrm(ks[6], (DEPTH, FILTER_EMB, FILTER_HIDDEN), FILTER_EMB ** -0.5),
        'filt_b1': nrm(ks[7], (DEPTH, FILTER_HIDDEN), 0.1),
        'filt_w2': nrm(ks[8], (DEPTH, FILTER_HIDDEN, FILTER_HIDDEN), FILTER_HIDDEN ** -0.5),
        'filt_b2': nrm(ks[9], (DEPTH, FILTER_HIDDEN), 0.1),
        'filt_w3': nrm(ks[10], (DEPTH, FILTER_HIDDEN, FILTER_HIDDEN), FILTER_HIDDEN ** -0.5),
        'filt_b3': nrm(ks[11], (DEPTH, FILTER_HIDDEN), 0.1),
        'filt_freq': 1.0 + nrm(ks[12], (DEPTH, FILTER_HIDDEN), 0.1),
        'filt_w4': nrm(ks[13], (DEPTH, FILTER_HIDDEN, 2 * HYENA_ORDER * HYENA_WIDTH), 0.05 * FILTER_HIDDEN ** -0.5),
        'hy_bias': nrm(ks[14], (DEPTH, HYENA_ORDER, HYENA_WIDTH), 0.1),
        'hy_out_g': 1.0 + nrm(ks[15], (DEPTH, HYENA_WIDTH), 0.02),
        'ret_gn_g': 1.0 + nrm(ks[16], (DEPTH, RET_WIDTH), 0.02),
        'ret_gn_b': nrm(ks[17], (DEPTH, RET_WIDTH), 0.02),
        'w_out': nrm(ks[18], (DEPTH, D_MODEL, D_MODEL), D_MODEL ** -0.5),
        'norm2_g': 1.0 + nrm(ks[19], (DEPTH, D_MODEL), 0.02),
        'w_up': nrm(ks[20], (DEPTH, D_MODEL, 2 * D_FF), D_MODEL ** -0.5),
        'ffn_conv_w': nrm(ks[21], (DEPTH, 3, 2 * D_FF), 3 ** -0.5),
        'ffn_conv_b': nrm(ks[22], (DEPTH, 2 * D_FF), 0.02),
        'w_down': nrm(ks[23], (DEPTH, D_FF, D_MODEL), D_FF ** -0.5),
        'final_g': 1.0 + nrm(ks[24], (D_MODEL,), 0.02),
    }


def reference(x_prompt, x_sample, norm1_g, w_in, hy_conv_w, hy_conv_b, filt_w1, filt_b1,
              filt_w2, filt_b2, filt_w3, filt_b3, filt_freq, filt_w4, hy_bias, hy_out_g,
              ret_gn_g, ret_gn_b, w_out, norm2_g, w_up, ffn_conv_w, ffn_conv_b, w_down, final_g):
    prm = {
        'norm1_g': norm1_g, 'w_in': w_in, 'hy_conv_w': hy_conv_w, 'hy_conv_b': hy_conv_b,
        'filt_w1': filt_w1, 'filt_b1': filt_b1, 'filt_w2': filt_w2, 'filt_b2': filt_b2,
        'filt_w3': filt_w3, 'filt_b3': filt_b3, 'filt_freq': filt_freq, 'filt_w4': filt_w4,
        'hy_bias': hy_bias, 'hy_out_g': hy_out_g, 'ret_gn_g': ret_gn_g, 'ret_gn_b': ret_gn_b,
        'w_out': w_out, 'norm2_g': norm2_g, 'w_up': w_up, 'ffn_conv_w': ffn_conv_w,
        'ffn_conv_b': ffn_conv_b, 'w_down': w_down, 'final_g': final_g,
    }
    y_prompt = trunk(x_prompt, prm)
    y_sample = trunk(x_sample, prm)
    return (y_prompt, y_sample)
```

```cpp
#include <hip/hip_runtime.h>
#include <hip/hip_cooperative_groups.h>
#include <cstdio>
namespace cg = cooperative_groups;

#define LAS __attribute__((address_space(3)))
typedef unsigned short bf16_t;
typedef short bf16x8 __attribute__((ext_vector_type(8)));
typedef float f32x4 __attribute__((ext_vector_type(4)));
typedef unsigned u32x4 __attribute__((ext_vector_type(4)));
typedef unsigned u32x2 __attribute__((ext_vector_type(2)));

constexpr int NTOK = 49152, NTOK_P = 32768, DM = 1024, SEQL = 4096, NBATCH = 12;
constexpr int HCOLS = 1536, RCOLS = 2048, DFF = 2816, UPC = 5632;
constexpr int GROUP_TOK = 16384;
constexpr size_t MiB = 1u << 20;
constexpr size_t WS_WIN = 0, WS_WOUT = 7 * MiB, WS_WUP = 9 * MiB, WS_WDN = 20 * MiB;
constexpr size_t WS_A = 26 * MiB;
constexpr size_t WS_B = 122 * MiB;
constexpr size_t WS_C = 250 * MiB;
constexpr size_t WS_D = 394 * MiB;
constexpr size_t WS_S = 466 * MiB;
constexpr size_t WS_RS1 = WS_S, WS_CS = WS_S + 1 * MiB, WS_H3T = WS_S + 2 * MiB, WS_P2 = WS_S + 3 * MiB, WS_P3 = WS_S + 6 * MiB, WS_BAR = WS_S + 9 * MiB, WS_END = 492 * MiB;
constexpr size_t WS_W4T = WS_S + 9 * MiB + 4096;
constexpr size_t WS_KV = WS_B + 32 * MiB;
constexpr size_t WS_Y1 = 386 * MiB, WS_Y2 = 476 * MiB; constexpr int Y_SPLIT = 40960;
constexpr int LDS_BYTES = 139264;
constexpr float EPS = 1e-6f;
#ifndef USE_CG_SYNC
#define USE_CG_SYNC 1
#endif
#ifndef PROBE
#define PROBE 0
#endif
#ifndef DIAG
#define DIAG 0
#endif

struct Params { const float* in[25]; float* out; unsigned char* ws; };

typedef __bf16 bf16v2 __attribute__((ext_vector_type(2)));
typedef float f32v2 __attribute__((ext_vector_type(2)));
__device__ __forceinline__ unsigned pk2(float lo, float hi) { f32v2 v = {lo, hi}; bf16v2 b = __builtin_convertvector(v, bf16v2); return __builtin_bit_cast(unsigned, b); }
__device__ __forceinline__ float bflo(unsigned u) { return __uint_as_float(u << 16); }
__device__ __forceinline__ float bfhi(unsigned u) { return __uint_as_float(u & 0xffff0000u); }
__device__ __forceinline__ float bf1(bf16_t b) { return __uint_as_float(((unsigned)b) << 16); }
__device__ __forceinline__ float wave_sum(float v) {
#pragma unroll
    for (int o = 1; o < 64; o <<= 1) v += __shfl_xor(v, o);
    return v;
}
__device__ __forceinline__ int opaque_tid() { int t = threadIdx.x; asm volatile("" : "+v"(t)); return t; }
template <int CTRL> __device__ __forceinline__ float dppf(float x) { return __builtin_bit_cast(float, __builtin_amdgcn_update_dpp(0, __builtin_bit_cast(int, x), CTRL, 0xF, 0xF, false)); }
__device__ __forceinline__ bf16_t* y_row(unsigned char* ws, int row) { return (row < Y_SPLIT) ? (bf16_t*)(ws + WS_Y1) + (size_t)row * DM : (bf16_t*)(ws + WS_Y2) + (size_t)(row - Y_SPLIT) * DM; }
#define LDS_WAIT() asm volatile("s_waitcnt lgkmcnt(0)" ::: "memory")

namespace pg8 {
constexpr int BM = 256, BK = 64, HALF = 128, HTB = HALF * BK * 2, NXCD = 8, WGM = 4;
__device__ __forceinline__ int lds_byte(int r, int c) { const int st = (r >> 4) * 2 + (c >> 5), rr = r & 15, cc = c & 31, ob = rr * 64 + cc * 2; return st * 1024 + (ob ^ (((ob >> 9) & 1) << 5)); }
__device__ __forceinline__ void stage_rc(int b, int& R, int& C) { const int st = b / 1024, sb = b % 1024, swz = sb ^ (((sb >> 9) & 1) << 5); R = (st >> 1) * 16 + swz / 64; C = (st & 1) * 32 + (swz % 64) / 2; }
__device__ __forceinline__ int perm32(int rho) { const int n = rho >> 4, i = rho & 15; return 8 * (i >> 2) + 4 * n + (i & 3); }
struct Unit { int pm, pn; };
struct Gemm { const bf16_t* A; const bf16_t* Bt; int M, N, K; int mtps; };
__device__ __forceinline__ long a_row0(const Gemm& g, int pm) { return g.mtps ? ((long)(pm / g.mtps) * 4096 + (long)(pm % g.mtps) * 254 - 1) : (long)pm * 256; }
struct StaticOrder {
    int nM, nN, nwg, G, c;
    __device__ void init(int M, int N, int G_, int c_) { nM = M / BM; nN = N / BM; nwg = nM * nN; G = G_; c = c_; }
    __device__ bool next(int i, Unit& u) const {
        const long L = (long)i * G + c; if (L >= nwg) return false;
        int wgid = (int)L; { const int q = nwg / NXCD, r = nwg % NXCD, xcd = wgid % NXCD, off = wgid / NXCD; wgid = (xcd < r ? xcd * (q + 1) : r * (q + 1) + (xcd - r) * q) + off; }
        const int nig = WGM * nN, gid = wgid / nig, fm = gid * WGM, gsz = (nM - fm) < WGM ? (nM - fm) : WGM;
        u.pm = fm + ((wgid % nig) % gsz); u.pn = (wgid % nig) / gsz; return true;
    }
};
template <class Epi>
__device__ __forceinline__ void gemm_phase(LAS unsigned char* lds, const Gemm g, const StaticOrder& S, const Epi& E) {
    const int tid = opaque_tid(), wid = __builtin_amdgcn_readfirstlane(tid >> 6), lane = tid & 63, wr = wid >> 2, wc = wid & 3, fr = lane & 15, fq = lane >> 4;
    const int K = g.K, nt = K / BK;
    unsigned voffA[2]; int voffB[2], voffB1[2];
#pragma unroll
    for (int i = 0; i < 2; ++i) { int R, C; stage_rc(tid * 16 + i * 8192, R, C);
        int Rb = R, Rb1 = R;
        if (Epi::BMAP == 1) { Rb = (R & ~31) + perm32(R & 31); Rb1 = Rb; }
        if (Epi::BMAP == 2) { Rb = (R & ~0x30) | ((R & 0x10) << 1) | ((R & 0x20) >> 1); Rb1 = Rb; }
        if (Epi::BMAP == 3) { Rb = 64 * (R >> 5) + perm32(R & 31); Rb1 = Rb + 32 - 128; }
        voffA[i] = (unsigned)(R * K + C) * 2u; voffB[i] = (Rb * K + C) * 2; voffB1[i] = (Rb1 * K + C) * 2; }
    const size_t kstep = (size_t)(BK * 2);
    const size_t hstep = (size_t)HALF * K * 2;
    const size_t tstep = 2 * hstep;
    const unsigned ldsw = (unsigned)wid * 1024u;
    const int aoff = lds_byte(wr * 64 + fr, fq * 8), boff = lds_byte(wc * 32 + fr, fq * 8);
#define PG8_SA(b, h) (((b) * 2 + (h)) * HTB)
#define PG8_SB(b, h) ((4 + (b) * 2 + (h)) * HTB)
#define PG8_STAGE(bufoff, gbase, voff) do { _Pragma("unroll") for (int _i = 0; _i < 2; ++_i) \
        __builtin_amdgcn_global_load_lds((const unsigned*)((const char*)(gbase) + (long)(voff)[_i]), (LAS unsigned*)(lds + (bufoff) + ldsw + _i * 8192), 16, 0, 0); } while (0)
#define PG8_LDA(dst, b, h) do { _Pragma("unroll") for (int m = 0; m < 4; ++m) _Pragma("unroll") for (int k = 0; k < 2; ++k) dst[m][k] = *(const LAS bf16x8*)(lds + PG8_SA(b, h) + aoff + m * 2048 + k * 1024); } while (0)
#define PG8_LDB(dst, b, h) do { _Pragma("unroll") for (int n = 0; n < 2; ++n) _Pragma("unroll") for (int k = 0; k < 2; ++k) dst[n][k] = *(const LAS bf16x8*)(lds + PG8_SB(b, h) + boff + n * 2048 + k * 1024); } while (0)
#define PG8_MMA(ai, bj, At, Bt) do { __builtin_amdgcn_s_setprio(1); _Pragma("unroll") for (int m = 0; m < 4; ++m) _Pragma("unroll") for (int n = 0; n < 2; ++n) _Pragma("unroll") for (int k = 0; k < 2; ++k) \
        acc[ai][bj][m][n] = __builtin_amdgcn_mfma_f32_16x16x32_bf16(Bt[n][k], At[m][k], acc[ai][bj][m][n], 0, 0, 0); __builtin_amdgcn_s_setprio(0); } while (0)
#define PG8_WAIT_V(n) asm volatile("s_waitcnt vmcnt(" #n ")" ::: "memory")
#define PG8_WAIT_L(n) asm volatile("s_waitcnt lgkmcnt(" #n ")" ::: "memory")
#define PG8_BAR __builtin_amdgcn_s_barrier()
#define PG8_SCHED __builtin_amdgcn_sched_barrier(0)
    Unit cur, nxt; int ui = 0;
    if (!S.next(0, cur)) return;
    f32x4 acc[2][2][4][2];
#pragma unroll
    for (int a = 0; a < 2; ++a)
#pragma unroll
        for (int b = 0; b < 2; ++b)
#pragma unroll
            for (int m = 0; m < 4; ++m)
#pragma unroll
                for (int n = 0; n < 2; ++n) acc[a][b][m][n] = (f32x4){0.f, 0.f, 0.f, 0.f};
    bf16x8 At[4][2], B0[2][2], B1[2][2];
    const char* cA = (const char*)g.A + a_row0(g, cur.pm) * (long)K * 2; const char* cB = (const char*)g.Bt + (size_t)cur.pn * tstep;
    PG8_STAGE(PG8_SB(0, 0), cB, voffB); PG8_STAGE(PG8_SA(0, 0), cA, voffA); PG8_STAGE(PG8_SB(0, 1), cB + hstep, voffB1); PG8_STAGE(PG8_SA(0, 1), cA + hstep, voffA);
    if (wr == 1) PG8_BAR;
    PG8_WAIT_V(4); PG8_BAR;
    PG8_STAGE(PG8_SB(1, 0), cB + kstep, voffB); PG8_STAGE(PG8_SA(1, 0), cA + kstep, voffA); PG8_STAGE(PG8_SB(1, 1), cB + hstep + kstep, voffB1);
    PG8_WAIT_V(6); PG8_BAR;
    for (;;) {
        const bool has_next = S.next(ui + 1, nxt);
        const char* nA = has_next ? (const char*)g.A + a_row0(g, nxt.pm) * (long)K * 2 : cA; const char* nB = has_next ? (const char*)g.Bt + (size_t)nxt.pn * tstep : cB;
        for (int t = 0; t < nt; t += 2) {
            const bool last = (t == nt - 2);
            const char* a1 = cA + (size_t)(t + 1) * kstep;
            const char* a2 = last ? nA : cA + (size_t)(t + 2) * kstep; const char* b2 = last ? nB : cB + (size_t)(t + 2) * kstep;
            const char* a3 = a2 + kstep; const char* b3 = b2 + kstep;
            PG8_LDB(B0, 0, 0); PG8_SCHED; PG8_LDA(At, 0, 0); PG8_STAGE(PG8_SA(1, 1), a1 + hstep, voffA);
            PG8_WAIT_L(8); PG8_BAR; PG8_WAIT_L(0); PG8_MMA(0, 0, At, B0); PG8_BAR; PG8_SCHED;
            PG8_LDB(B1, 0, 1); PG8_STAGE(PG8_SB(0, 0), b2, voffB);
            PG8_BAR; PG8_WAIT_L(0); PG8_MMA(0, 1, At, B1); PG8_BAR;
            PG8_LDA(At, 0, 1); PG8_STAGE(PG8_SA(0, 0), a2, voffA);
            PG8_BAR; PG8_WAIT_L(0); PG8_MMA(1, 0, At, B0); PG8_BAR; PG8_SCHED;
            PG8_STAGE(PG8_SB(0, 1), b2 + hstep, voffB1);
            PG8_WAIT_V(6); PG8_BAR; PG8_MMA(1, 1, At, B1); PG8_BAR;
            PG8_LDB(B0, 1, 0); PG8_SCHED; PG8_LDA(At, 1, 0); PG8_STAGE(PG8_SA(0, 1), a2 + hstep, voffA);
            PG8_WAIT_L(8); PG8_BAR; PG8_WAIT_L(0); PG8_MMA(0, 0, At, B0); PG8_BAR; PG8_SCHED;
            PG8_LDB(B1, 1, 1); PG8_STAGE(PG8_SB(1, 0), b3, voffB);
            PG8_BAR; PG8_WAIT_L(0); PG8_MMA(0, 1, At, B1); PG8_BAR;
            PG8_LDA(At, 1, 1); PG8_STAGE(PG8_SA(1, 0), a3, voffA);
            PG8_BAR; PG8_WAIT_L(0); PG8_MMA(1, 0, At, B0); PG8_BAR; PG8_SCHED;
            PG8_STAGE(PG8_SB(1, 1), b3 + hstep, voffB1);
            PG8_WAIT_V(6); PG8_BAR; PG8_MMA(1, 1, At, B1); PG8_BAR;
        }
        if (wr == 0) PG8_BAR;
        E(acc, cur, wr, wc, fr, fq);
        if (wr == 1) PG8_BAR;
        if (!has_next) break;
#pragma unroll
        for (int a = 0; a < 2; ++a)
#pragma unroll
            for (int b = 0; b < 2; ++b)
#pragma unroll
                for (int m = 0; m < 4; ++m)
#pragma unroll
                    for (int n = 0; n < 2; ++n) acc[a][b][m][n] = (f32x4){0.f, 0.f, 0.f, 0.f};
        cur = nxt; cA = nA; cB = nB; ++ui;
    }
    PG8_WAIT_V(0);
    if (wr == 0) PG8_BAR;
    PG8_BAR;
#undef PG8_SA
#undef PG8_SB
#undef PG8_STAGE
#undef PG8_LDA
#undef PG8_LDB
#undef PG8_MMA
#undef PG8_WAIT_V
#undef PG8_WAIT_L
#undef PG8_BAR
#undef PG8_SCHED
}
}
using pg8::Unit; using pg8::HALF; using pg8::BM;

struct EpiHy {
    static constexpr int BMAP = 1;
    bf16_t* O; const float* rs1;
    __device__ __forceinline__ void operator()(f32x4 (&acc)[2][2][4][2], const Unit& u, int wr, int wc, int fr, int fq) const {
        const int row0 = u.pm * BM + wr * 64 + fr, col0 = u.pn * BM + wc * 32 + 8 * fq;
        f32x4 sc[2][2];
#pragma unroll
        for (int bj = 0; bj < 2; ++bj) { sc[bj][0] = *(const f32x4*)(rs1 + col0 + bj * HALF); sc[bj][1] = *(const f32x4*)(rs1 + col0 + bj * HALF + 4); }
#pragma unroll
        for (int bj = 0; bj < 2; ++bj) {
#pragma unroll
            for (int ai = 0; ai < 2; ++ai)
#pragma unroll
                for (int m = 0; m < 4; ++m) {
                    const f32x4 v0 = acc[ai][bj][m][0] * sc[bj][0], v1 = acc[ai][bj][m][1] * sc[bj][1];
                    u32x4 o; o.x = pk2(v0[0], v0[1]); o.y = pk2(v0[2], v0[3]); o.z = pk2(v1[0], v1[1]); o.w = pk2(v1[2], v1[3]);
                    *(u32x4*)(O + (size_t)(row0 + ai * HALF + m * 16) * NTOK + col0 + bj * HALF) = o;
                }
        }
    }
};
struct EpiRet {
    static constexpr int BMAP = 3;
    bf16_t* O; const float* rs1; const float* cs;
    __device__ __forceinline__ void operator()(f32x4 (&acc)[2][2][4][2], const Unit& u, int wr, int wc, int fr, int fq) const {
        const int row0 = u.pm * BM + wr * 64 + fr;
        const bool rot = u.pn < 4; const float ksc = (u.pn >= 2 && u.pn < 4) ? 0.125f : 1.0f;
#pragma unroll
        for (int ai = 0; ai < 2; ++ai) {
            f32x4 cv[4][2], sv[4][2]; float rsv[4];
#pragma unroll
            for (int m = 0; m < 4; ++m) {
                const int row = row0 + ai * HALF + m * 16;
                rsv[m] = rs1[row];
                const float* cp = cs + (size_t)(row & (SEQL - 1)) * 64 + 8 * fq;
                cv[m][0] = *(const f32x4*)cp; cv[m][1] = *(const f32x4*)(cp + 4); sv[m][0] = *(const f32x4*)(cp + 32); sv[m][1] = *(const f32x4*)(cp + 36);
            }
            if (!rot) {
#pragma unroll
                for (int m = 0; m < 4; ++m) { cv[m][0] = cv[m][1] = (f32x4){1.f, 1.f, 1.f, 1.f}; sv[m][0] = sv[m][1] = (f32x4){0.f, 0.f, 0.f, 0.f}; }
            }
#pragma unroll
            for (int m = 0; m < 4; ++m) {
                const int row = row0 + ai * HALF + m * 16;
                const float rs = rsv[m] * ksc;
                u32x4 a, b2;
                {
                    const f32x4 x1 = acc[ai][0][m][0] * rs, x2 = acc[ai][1][m][0] * rs;
                    const f32x4 o1 = x1 * cv[m][0] - x2 * sv[m][0], o2 = x2 * cv[m][0] + x1 * sv[m][0];
                    a.x = pk2(o1[0], o1[1]); a.y = pk2(o1[2], o1[3]); b2.x = pk2(o2[0], o2[1]); b2.y = pk2(o2[2], o2[3]);
                }
                {
                    const f32x4 x1 = acc[ai][0][m][1] * rs, x2 = acc[ai][1][m][1] * rs;
                    const f32x4 o1 = x1 * cv[m][1] - x2 * sv[m][1], o2 = x2 * cv[m][1] + x1 * sv[m][1];
                    a.z = pk2(o1[0], o1[1]); a.w = pk2(o1[2], o1[3]); b2.z = pk2(o2[0], o2[1]); b2.w = pk2(o2[2], o2[3]);
                }
                bf16_t* pp = O + (size_t)row * RCOLS + u.pn * BM + 64 * wc + 8 * fq;
                *(u32x4*)pp = a; *(u32x4*)(pp + 32) = b2;
            }
        }
    }
};
struct EpiOut {
    static constexpr int BMAP = 1;
    bf16_t* O; float* part; LAS float* X;
    __device__ __forceinline__ void operator()(f32x4 (&acc)[2][2][4][2], const Unit& u, int wr, int wc, int fr, int fq) const {
        const int row0 = u.pm * BM + wr * 64 + fr, col0 = u.pn * BM + wc * 32 + 8 * fq;
#pragma unroll
        for (int ai = 0; ai < 2; ++ai) {
            u32x4 xr4[4][2];
#pragma unroll
            for (int m = 0; m < 4; ++m)
#pragma unroll
                for (int bj = 0; bj < 2; ++bj) xr4[m][bj] = *(const u32x4*)(O + (size_t)(row0 + ai * HALF + m * 16) * DM + col0 + bj * HALF);
#pragma unroll
            for (int m = 0; m < 4; ++m) {
                const int row = row0 + ai * HALF + m * 16;
                float ss = 0.f;
#pragma unroll
                for (int bj = 0; bj < 2; ++bj) {
                    u32x4* px = (u32x4*)(O + (size_t)row * DM + col0 + bj * HALF);
                    const u32x4 xr = xr4[m][bj];
                    f32x4 v0 = acc[ai][bj][m][0], v1 = acc[ai][bj][m][1];
                    v0[0] += bflo(xr.x); v0[1] += bfhi(xr.x); v0[2] += bflo(xr.y); v0[3] += bfhi(xr.y);
                    v1[0] += bflo(xr.z); v1[1] += bfhi(xr.z); v1[2] += bflo(xr.w); v1[3] += bfhi(xr.w);
                    ss += v0[0] * v0[0] + v0[1] * v0[1] + v0[2] * v0[2] + v0[3] * v0[3] + v1[0] * v1[0] + v1[1] * v1[1] + v1[2] * v1[2] + v1[3] * v1[3];
                    u32x4 o; o.x = pk2(v0[0], v0[1]); o.y = pk2(v0[2], v0[3]); o.z = pk2(v1[0], v1[1]); o.w = pk2(v1[2], v1[3]);
                    *px = o;
                }
                ss += __shfl_xor(ss, 16); ss += __shfl_xor(ss, 32);
                if (fq == 0) X[(ai * HALF + wr * 64 + m * 16 + fr) * 4 + wc] = ss;
            }
        }
        LDS_WAIT(); __builtin_amdgcn_s_barrier(); asm volatile("" ::: "memory");
        if (wr == 0) {
            const int r = wc * 64 + fq * 16 + fr;
            const f32x4 v = *(LAS const f32x4*)(X + r * 4);
            part[(size_t)(u.pm * BM + r) * 4 + u.pn] = (v[0] + v[1]) + (v[2] + v[3]);
        }
    }
};
struct EpiUp {
    static constexpr int BMAP = 1;
    bf16_t* O; const float* part; int row_base;
    __device__ __forceinline__ void operator()(f32x4 (&acc)[2][2][4][2], const Unit& u, int wr, int wc, int fr, int fq) const {
        const int row0 = u.pm * BM + wr * 64 + fr, col0 = u.pn * BM + wc * 32 + 8 * fq;
#pragma unroll
        for (int ai = 0; ai < 2; ++ai)
#pragma unroll
            for (int m = 0; m < 4; ++m) {
                const int row = row0 + ai * HALF + m * 16;
                const f32x4* pp = (const f32x4*)(part + (size_t)(row + row_base) * 16);
                const f32x4 p0 = pp[0], p1 = pp[1], p2 = pp[2], p3 = pp[3];
                const float ss = ((p0[0] + p0[1]) + (p0[2] + p0[3])) + ((p1[0] + p1[1]) + (p1[2] + p1[3])) + ((p2[0] + p2[1]) + (p2[2] + p2[3])) + ((p3[0] + p3[1]) + (p3[2] + p3[3]));
                const float rs = 1.0f / sqrtf(ss * (1.0f / DM) + EPS);
#pragma unroll
                for (int bj = 0; bj < 2; ++bj) {
                    const f32x4 v0 = acc[ai][bj][m][0] * rs, v1 = acc[ai][bj][m][1] * rs;
                    u32x4 o; o.x = pk2(v0[0], v0[1]); o.y = pk2(v0[2], v0[3]); o.z = pk2(v1[0], v1[1]); o.w = pk2(v1[2], v1[3]);
                    *(u32x4*)(O + (size_t)row * UPC + col0 + bj * HALF) = o;
                }
            }
    }
};

template <int CTRL> __device__ __forceinline__ f32x4 dpp4(f32x4 v) { f32x4 r; r[0] = dppf<CTRL>(v[0]); r[1] = dppf<CTRL>(v[1]); r[2] = dppf<CTRL>(v[2]); r[3] = dppf<CTRL>(v[3]); return r; }
__device__ __forceinline__ f32x4 gelu_fast4(f32x4 x) {
    f32x4 t = x * x; t = t * (-0.10294324f) + (-2.3022082f); t = t * x;
    f32x4 e; e[0] = __builtin_amdgcn_exp2f(t[0]); e[1] = __builtin_amdgcn_exp2f(t[1]); e[2] = __builtin_amdgcn_exp2f(t[2]); e[3] = __builtin_amdgcn_exp2f(t[3]);
    e = e + 1.0f;
    f32x4 r; r[0] = __builtin_amdgcn_rcpf(e[0]); r[1] = __builtin_amdgcn_rcpf(e[1]); r[2] = __builtin_amdgcn_rcpf(e[2]); r[3] = __builtin_amdgcn_rcpf(e[3]);
    return x * r;
}
__device__ __forceinline__ float gelu_fast(float x) {
    const float e = __builtin_amdgcn_exp2f(x * (-2.3022082f + -0.10294324f * x * x));
    return x * __builtin_amdgcn_rcpf(1.0f + e);
}
struct EpiFfn {
    static constexpr int BMAP = 1;
    bf16_t* Gout; const float* part; const float* cw; const float* cb; LAS float* X;
    __device__ __forceinline__ void operator()(f32x4 (&acc)[2][2][4][2], const Unit& u, int wr, int wc, int fr, int fq) const {
        const int seq = u.pm / 17, tbase = (u.pm % 17) * 254 - 1;
        const int colh = u.pn * 128 + wc * 32 + 8 * fq;
        f32x4 pq[2][4];
#pragma unroll
        for (int ai = 0; ai < 2; ++ai)
#pragma unroll
            for (int m = 0; m < 4; ++m) {
                const int t = tbase + 128 * ai + 64 * wr + 16 * m + fr;
                const int tc = t < 0 ? 0 : (t >= SEQL ? SEQL - 1 : t);
                pq[ai][m] = *(const f32x4*)(part + (size_t)(seq * SEQL + tc) * 4);
            }
#pragma unroll
        for (int ai = 0; ai < 2; ++ai)
#pragma unroll
            for (int m = 0; m < 4; ++m) {
                const int t = tbase + 128 * ai + 64 * wr + 16 * m + fr;
                const float ss = (pq[ai][m][0] + pq[ai][m][1]) + (pq[ai][m][2] + pq[ai][m][3]);
                const float rs = (t >= 0 && t < SEQL) ? __builtin_amdgcn_rsqf(ss * (1.0f / DM) + EPS) : 0.f;
#pragma unroll
                for (int bj = 0; bj < 2; ++bj)
#pragma unroll
                    for (int n = 0; n < 2; ++n) acc[ai][bj][m][n] = acc[ai][bj][m][n] * rs;
            }
#pragma unroll
        for (int ai = 0; ai < 2; ++ai)
#pragma unroll
            for (int bj = 0; bj < 2; ++bj)
#pragma unroll
                for (int n = 0; n < 2; ++n) {
                    LAS float* xb = X + ((2 * ai + wr) * 2) * 256 + bj * 128 + wc * 32 + 8 * fq + 4 * n;
                    if (fr == 0) *(LAS f32x4*)xb = acc[ai][bj][0][n];
                    if (fr == 15) *(LAS f32x4*)(xb + 256) = acc[ai][bj][3][n];
                }
        LDS_WAIT(); __builtin_amdgcn_s_barrier(); asm volatile("" ::: "memory");
#pragma unroll
        for (int n = 0; n < 2; ++n) {
            const int ca = colh + 4 * n;
            f32x4 wa[3], wb[3];
#pragma unroll
            for (int k = 0; k < 3; ++k) { wa[k] = *(const f32x4*)(cw + k * UPC + ca); wb[k] = *(const f32x4*)(cw + k * UPC + DFF + ca); }
            const f32x4 ba = *(const f32x4*)(cb + ca), bb = *(const f32x4*)(cb + DFF + ca);
#pragma unroll
            for (int ai = 0; ai < 2; ++ai) {
                const int strip = 2 * ai + wr;
                f32x4 xp[2], xn[2];
#pragma unroll
                for (int bj = 0; bj < 2; ++bj) {
                    LAS const float* xb = X + bj * 128 + wc * 32 + 8 * fq + 4 * n;
                    xp[bj] = (strip > 0) ? *(LAS const f32x4*)(xb + ((strip - 1) * 2 + 1) * 256) : (f32x4){0.f, 0.f, 0.f, 0.f};
                    xn[bj] = (strip < 3) ? *(LAS const f32x4*)(xb + ((strip + 1) * 2) * 256) : (f32x4){0.f, 0.f, 0.f, 0.f};
                }
#pragma unroll
                for (int m = 0; m < 4; ++m) {
                    f32x4 y[2];
#pragma unroll
                    for (int bj = 0; bj < 2; ++bj) {
                        const f32x4 cur = acc[ai][bj][m][n];
                        const f32x4 up = (m > 0) ? acc[ai][bj][m - 1][n] : xp[bj];
                        const f32x4 dn = (m < 3) ? acc[ai][bj][m + 1][n] : xn[bj];
                        f32x4 su, sd;
#pragma unroll
                        for (int j = 0; j < 4; ++j) { su[j] = (fr == 15) ? up[j] : cur[j]; sd[j] = (fr == 0) ? dn[j] : cur[j]; }
                        const f32x4 prev = dpp4<0x121>(su);
                        const f32x4 next = dpp4<0x12F>(sd);
                        y[bj] = bj ? (wb[0] * prev + wb[1] * cur + wb[2] * next + bb) : (wa[0] * prev + wa[1] * cur + wa[2] * next + ba);
                    }
                    const int lr = 128 * ai + 64 * wr + 16 * m + fr, t = tbase + lr;
                    const f32x4 gv = gelu_fast4(y[0]) * y[1];
                    u32x2 o; o.x = pk2(gv[0], gv[1]); o.y = pk2(gv[2], gv[3]);
                    if (lr >= 1 && lr <= 254 && t < SEQL) *(u32x2*)(Gout + (size_t)(seq * SEQL + t) * DFF + ca) = o;
                }
            }
        }
    }
};
struct EpiDown {
    static constexpr int BMAP = 1;
    unsigned char* ws; const bf16_t* X1; float* part;
    __device__ __forceinline__ void operator()(f32x4 (&acc)[2][2][4][2], const Unit& u, int wr, int wc, int fr, int fq) const {
        const int row0 = u.pm * BM + wr * 64 + fr, col0 = u.pn * BM + wc * 32 + 8 * fq;
#pragma unroll
        for (int ai = 0; ai < 2; ++ai) {
            u32x4 xr4[4][2];
#pragma unroll
            for (int m = 0; m < 4; ++m)
#pragma unroll
                for (int bj = 0; bj < 2; ++bj) xr4[m][bj] = *(const u32x4*)(X1 + (size_t)(row0 + ai * HALF + m * 16) * DM + col0 + bj * HALF);
#pragma unroll
            for (int m = 0; m < 4; ++m) {
                const int row = row0 + ai * HALF + m * 16;
                bf16_t* yr = y_row(ws, row);
                float ss = 0.f;
#pragma unroll
                for (int bj = 0; bj < 2; ++bj) {
                    const int col = col0 + bj * HALF;
                    const u32x4 xr = xr4[m][bj];
                    f32x4 v0 = acc[ai][bj][m][0], v1 = acc[ai][bj][m][1];
                    v0[0] += bflo(xr.x); v0[1] += bfhi(xr.x); v0[2] += bflo(xr.y); v0[3] += bfhi(xr.y);
                    v1[0] += bflo(xr.z); v1[1] += bfhi(xr.z); v1[2] += bflo(xr.w); v1[3] += bfhi(xr.w);
                    ss += v0[0] * v0[0] + v0[1] * v0[1] + v0[2] * v0[2] + v0[3] * v0[3] + v1[0] * v1[0] + v1[1] * v1[1] + v1[2] * v1[2] + v1[3] * v1[3];
                    u32x4 o; o.x = pk2(v0[0], v0[1]); o.y = pk2(v0[2], v0[3]); o.z = pk2(v1[0], v1[1]); o.w = pk2(v1[2], v1[3]);
                    *(u32x4*)(yr + col) = o;
                }
                ss += __shfl_xor(ss, 16); ss += __shfl_xor(ss, 32);
                if (fq == 0) part[(size_t)row * 16 + u.pn * 4 + wc] = ss;
            }
        }
    }
};

struct EpiNull { static constexpr int BMAP = 1;
    __device__ __forceinline__ void operator()(f32x4 (&acc)[2][2][4][2], const Unit& u, int wr, int wc, int fr, int fq) const {
        float s = 0.f;
#pragma unroll
        for (int ai = 0; ai < 2; ++ai)
#pragma unroll
            for (int bj = 0; bj < 2; ++bj)
#pragma unroll
                for (int m = 0; m < 4; ++m)
#pragma unroll
                    for (int n = 0; n < 2; ++n) s += acc[ai][bj][m][n][0] + acc[ai][bj][m][n][1] + acc[ai][bj][m][n][2] + acc[ai][bj][m][n][3];
        if (s == 123.456f) *sink = s;
    }
    float* sink; };
template <int UPPERM>
__device__ __forceinline__ void transpose_item(const float* W, const float* gk, int K, int N, bf16_t* WT, LAS float* scr, int item, int lane) {
    const int nblk = N / 32, kb = item / nblk, nb = item % nblk, k0 = 64 * kb, n0 = 32 * nb;
#pragma unroll 16
    for (int i = 0; i < 32; ++i) { const int kk = 2 * i + (lane >> 5); const float s = gk ? gk[k0 + kk] : 1.0f; scr[kk * 33 + (lane & 31)] = W[(size_t)(k0 + kk) * N + n0 + (lane & 31)] * s; }
    LDS_WAIT();
    const int c = lane & 7;
#pragma unroll
    for (int j = 0; j < 4; ++j) { const int n = (lane >> 3) + 8 * j; const LAS float* s = scr + (8 * c) * 33 + n;
        u32x4 o; o.x = pk2(s[0 * 33], s[1 * 33]); o.y = pk2(s[2 * 33], s[3 * 33]); o.z = pk2(s[4 * 33], s[5 * 33]); o.w = pk2(s[6 * 33], s[7 * 33]);
        int nr = n0 + n;
        if (UPPERM) { const int oo = nr < DFF ? nr : nr - DFF; nr = 256 * (oo >> 7) + (oo & 127) + (nr < DFF ? 0 : 128); }
        *(u32x4*)(WT + (size_t)nr * K + k0 + 8 * c) = o; }
    LDS_WAIT();
}
__device__ __forceinline__ void phase_a(const Params& p, LAS unsigned char* lds) {
    const int tid = opaque_tid(), wave = tid >> 6, lane = tid & 63;
    const int gw = blockIdx.x * 8 + wave, NGW = gridDim.x * 8;
    unsigned char* ws = p.ws;
    LAS float* scr = (LAS float*)(lds + wave * 8704);
    constexpr int I_IN = 16 * (3584 / 32), I_OUT = 16 * 32, I_UP = 16 * (UPC / 32), I_DN = (DFF / 64) * 32;
    constexpr int I_T = I_IN + I_OUT + I_UP + I_DN, I_H3 = SEQL, I_X = NTOK;
    for (int it = gw; it < I_T + I_H3; it += NGW) {
        int r = it;
        if (r < I_IN) { transpose_item<0>(p.in[3], p.in[2], DM, 3584, (bf16_t*)(ws + WS_WIN), scr, r, lane); continue; } r -= I_IN;
        if (r < I_OUT) { transpose_item<0>(p.in[18], nullptr, DM, DM, (bf16_t*)(ws + WS_WOUT), scr, r, lane); continue; } r -= I_OUT;
        if (r < I_UP) { transpose_item<1>(p.in[20], p.in[19], DM, UPC, (bf16_t*)(ws + WS_WUP), scr, r, lane); continue; } r -= I_UP;
        if (r < I_DN) { transpose_item<0>(p.in[23], nullptr, DFF, DM, (bf16_t*)(ws + WS_WDN), scr, r, lane); continue; } r -= I_DN;
        if (r < I_H3) {
            const int l = r; const float fl = (float)l;
            float z = 0.f;
            if (lane == 0) z = fl * (1.0f / 4095.0f);
            else if (lane < 33) { const int bi = (lane - 1) & 15; const float band = 1e-4f + (float)bi * ((15.0f - 1e-4f) / 15.0f);
                const float ang = (6.283185307179586f / 4096.0f) * fl * band; z = (lane < 17) ? cosf(ang) : -sinf(ang); }
            const float fr = p.in[12][lane];
            float a = p.in[7][lane];
            for (int e = 0; e < 33; ++e) a += __shfl(z, e) * p.in[6][e * 64 + lane];
            float h = sinf(fr * a);
            a = p.in[9][lane];
            for (int e = 0; e < 64; ++e) a += __shfl(h, e) * p.in[8][e * 64 + lane];
            h = sinf(fr * a);
            a = p.in[11][lane];
            for (int e = 0; e < 64; ++e) a += __shfl(h, e) * p.in[10][e * 64 + lane];
            h = sinf(fr * a);
            ((float*)(ws + WS_H3T))[lane * SEQL + l] = h;
            continue;
        }
        (void)r;
    }
    for (int row0 = gw; row0 < I_X; row0 += 2 * NGW) {
        const int row1 = row0 + NGW; const bool has1 = row1 < I_X;
        const int rr1 = has1 ? row1 : row0;
        const float* xr0 = (row0 < NTOK_P) ? p.in[0] + (size_t)row0 * DM : p.in[1] + (size_t)(row0 - NTOK_P) * DM;
        const float* xr1 = (rr1 < NTOK_P) ? p.in[0] + (size_t)rr1 * DM : p.in[1] + (size_t)(rr1 - NTOK_P) * DM;
        f32x4 v0[4], v1[4]; float s0 = 0.f, s1 = 0.f;
#pragma unroll
        for (int j = 0; j < 4; ++j) { v0[j] = *(const f32x4*)(xr0 + 256 * j + 4 * lane); v1[j] = *(const f32x4*)(xr1 + 256 * j + 4 * lane); }
#pragma unroll
        for (int j = 0; j < 4; ++j) { s0 += v0[j][0] * v0[j][0] + v0[j][1] * v0[j][1] + v0[j][2] * v0[j][2] + v0[j][3] * v0[j][3]; s1 += v1[j][0] * v1[j][0] + v1[j][1] * v1[j][1] + v1[j][2] * v1[j][2] + v1[j][3] * v1[j][3]; }
        s0 = wave_sum(s0); s1 = wave_sum(s1);
        if (lane == 0) { ((float*)(ws + WS_RS1))[row0] = 1.0f / sqrtf(s0 * (1.0f / DM) + EPS); if (has1) ((float*)(ws + WS_RS1))[row1] = 1.0f / sqrtf(s1 * (1.0f / DM) + EPS); }
        bf16_t* xb0 = (bf16_t*)(ws + WS_A) + (size_t)row0 * DM; bf16_t* xb1 = (bf16_t*)(ws + WS_A) + (size_t)rr1 * DM;
#pragma unroll
        for (int j = 0; j < 4; ++j) { u32x2 o; o.x = pk2(v0[j][0], v0[j][1]); o.y = pk2(v0[j][2], v0[j][3]); *(u32x2*)(xb0 + 256 * j + 4 * lane) = o; }
        if (has1) {
#pragma unroll
            for (int j = 0; j < 4; ++j) { u32x2 o; o.x = pk2(v1[j][0], v1[j][1]); o.y = pk2(v1[j][2], v1[j][3]); *(u32x2*)(xb1 + 256 * j + 4 * lane) = o; }
        }
    }
    for (int e = blockIdx.x * 512 + tid; e < 64 * 2048; e += gridDim.x * 512) ((float*)(ws + WS_W4T))[e] = p.in[13][(e & 63) * 2048 + (e >> 6)];
    for (int e = blockIdx.x * 512 + tid; e < SEQL * 32; e += gridDim.x * 512) {
        const int t = e >> 5, i = e & 31;
        const float inv = powf(10000.0f, -(float)(2 * i) / 64.0f);
        const float ang = (float)t * inv;
        float* cs = (float*)(ws + WS_CS) + (size_t)t * 64;
        cs[i] = cosf(ang); cs[32 + i] = sinf(ang);
    }
}
__device__ __forceinline__ void phase_b(const Params& p) {
    const int tid = opaque_tid();
    const float* h3t = (const float*)(p.ws + WS_H3T); const float* w4 = p.in[13];
    float* hft = (float*)(p.ws + WS_D);
    for (int it = blockIdx.x; it < 256 * 8; it += gridDim.x) {
        const int cg8 = it >> 3, l = (it & 7) * 512 + tid, col0 = cg8 * 8;
        float a[8];
#pragma unroll
        for (int j = 0; j < 8; ++j) a[j] = 0.f;
        for (int k = 0; k < 64; ++k) {
            const float hv = h3t[k * SEQL + l];
            const f32x4 w0 = *(const f32x4*)(w4 + k * 2048 + col0), w1 = *(const f32x4*)(w4 + k * 2048 + col0 + 4);
            a[0] += hv * w0[0]; a[1] += hv * w0[1]; a[2] += hv * w0[2]; a[3] += hv * w0[3];
            a[4] += hv * w1[0]; a[5] += hv * w1[1]; a[6] += hv * w1[2]; a[7] += hv * w1[3];
        }
        const float tl = (float)l * (1.0f / 4095.0f);
        const float d0 = -15.350567286626973f, d1 = -3.0701134573253945f;
#pragma unroll
        for (int j = 0; j < 8; ++j) {
            const int c = (col0 + j) & 511;
            const float delta = fabsf(d0 + (float)c * ((d1 - d0) / 511.0f));
            hft[(size_t)(col0 + j) * SEQL + l] = a[j] * expf(-tl * delta);
        }
    }
}
__device__ __forceinline__ void phase_toep(const Params& p) {
    const int tid = opaque_tid();
    const float* hft = (const float*)(p.ws + WS_D); const float* bias = p.in[14];
    bf16_t* T = (bf16_t*)(p.ws + WS_B);
    for (int it = blockIdx.x; it < 2048; it += gridDim.x) {
        const int oc = it >> 1, sh = it & 1;
        const float* hf = hft + (size_t)oc * SEQL; const float* hb = hft + (size_t)(1024 + oc) * SEQL;
        const float bz = bias[oc];
        for (int up = tid; up < 1024; up += 512) {
            float v[8];
#pragma unroll
            for (int j = 0; j < 8; ++j) {
                const int m = 8 * (up - 512) + j + sh, d = -m;
                float x = 0.f;
                if (d >= 0 && d < SEQL) x = hf[d]; else if (d < 0 && d > -SEQL) x = hb[-d];
                if (d == 0) x += bz;
                v[j] = x;
            }
            u32x4 o; o.x = pk2(v[0], v[1]); o.y = pk2(v[2], v[3]); o.z = pk2(v[4], v[5]); o.w = pk2(v[6], v[7]);
            *(u32x4*)(T + ((size_t)it * 1024 + up) * 8) = o;
        }
    }
}

__device__ __forceinline__ void phase_rf(const Params& p) {
    const int tid = opaque_tid();
    const float* h3t = (const float*)(p.ws + WS_H3T); const float* w4t = (const float*)(p.ws + WS_W4T); const float* bias = p.in[14];
    bf16_t* T = (bf16_t*)(p.ws + WS_B);
    const float d0 = -15.350567286626973f, d1 = -3.0701134573253945f;
    for (int q = blockIdx.x; q < 256; q += gridDim.x) {
#pragma unroll 1
        for (int lp = 0; lp < 8; ++lp) {
            const int l = lp * 512 + tid;
            float h[64];
#pragma unroll
            for (int k = 0; k < 64; ++k) h[k] = h3t[k * SEQL + l];
            const float tl = (float)l * (1.0f / 4095.0f);
#pragma unroll 1
            for (int j = 0; j < 4; ++j) {
                const int oc = __builtin_amdgcn_readfirstlane(q * 4 + j), c = oc & 511;
                const float* wf = w4t + (size_t)oc * 64; const float* wb = w4t + (size_t)(1024 + oc) * 64;
                float af = 0.f, ab = 0.f;
#pragma unroll
                for (int k = 0; k < 64; ++k) { af += h[k] * wf[k]; ab += h[k] * wb[k]; }
                const float decay = expf(-tl * fabsf(d0 + (float)c * ((d1 - d0) / 511.0f)));
                af *= decay; ab *= decay;
                if (l == 0) af += bias[oc];
                const bf16_t vf = (bf16_t)(pk2(af, 0.f) & 0xffff), vb = (bf16_t)(pk2(ab, 0.f) & 0xffff);
                bf16_t* T0 = T + (size_t)(oc * 2) * 8192; bf16_t* T1 = T0 + 8192;
                T0[4096 - l] = vf; T1[4095 - l] = vf;
                if (l >= 1) { T0[4096 + l] = vb; T1[4095 + l] = vb; }
                else { T0[0] = 0; T1[8191] = 0; }
            }
        }
    }
}

constexpr int ZS = 4112;
#define MFMA16(a, b, c) __builtin_amdgcn_mfma_f32_16x16x32_bf16(a, b, c, 0, 0, 0)
typedef u32x4 u32x4_a4 __attribute__((aligned(4)));
__device__ __forceinline__ bf16x8 ld_filt(LAS const bf16_t* q) {
    const u32x4 v = *(LAS const u32x4_a4*)q;
    return __builtin_bit_cast(bf16x8, v);
}
__device__ __forceinline__ void hyena_group(LAS const bf16_t* Rl, LAS const bf16_t* Zl, int g, f32x4 (&acc)[16]) {
    bf16x8 Aw[16];
#pragma unroll
    for (int i = 0; i < 16; ++i) { Aw[i] = ld_filt(Rl - 16 * (16 * g + i)); acc[i] = (f32x4){0.f, 0.f, 0.f, 0.f}; }
    bf16x8 Bz = *(LAS const bf16x8*)(Zl);
    for (int q = 0; q < 16; ++q) {
#pragma unroll
        for (int e = 0; e < 8; ++e) {
            const int sg = 8 * q + e;
            const int dn = 16 * g - 2 * ((sg + 1) & 127);
            const bf16x8 Bn = *(LAS const bf16x8*)(Zl + 32 * ((sg + 1) & 127));
            const bf16x8 An0 = ld_filt(Rl - 16 * dn);
            const bf16x8 An1 = ld_filt(Rl - 16 * (dn + 1));
            __builtin_amdgcn_sched_barrier(0);
#pragma unroll
            for (int i = 15; i >= 0; --i) acc[i] = MFMA16(Aw[(i - 2 * e) & 15], Bz, acc[i]);
            __builtin_amdgcn_sched_barrier(0);
            Aw[(14 - 2 * e) & 15] = An0;
            Aw[(15 - 2 * e) & 15] = An1;
            Bz = Bn;
        }
    }
}
__device__ __forceinline__ f32x4 gate4(const bf16_t* raw, int t, float w0, float w1, float w2, float cb) {
    const u32x2 x = *(const u32x2*)(raw + t);
    const float xm0 = bf1(raw[t > 0 ? t - 1 : 0]), xp0 = bf1(raw[t + 4 < SEQL ? t + 4 : SEQL - 1]);
    const float xm = (t > 0) ? xm0 : 0.f, xp = (t + 4 < SEQL) ? xp0 : 0.f;
    const float x0 = bflo(x.x), x1 = bfhi(x.x), x2 = bflo(x.y), x3 = bfhi(x.y);
    f32x4 g;
    g[0] = w0 * xm + w1 * x0 + w2 * x1 + cb; g[1] = w0 * x0 + w1 * x1 + w2 * x2 + cb;
    g[2] = w0 * x1 + w1 * x2 + w2 * x3 + cb; g[3] = w0 * x2 + w1 * x3 + w2 * xp + cb;
    return g;
}
template <int FAKE>
__device__ __forceinline__ void hyena_channel(const Params& p, LAS unsigned char* lds, int c) {
    const int tid = opaque_tid(), wave = tid >> 6, lane = tid & 63, fr = lane & 15, fq = lane >> 4;
    const bf16_t* PhT = (const bf16_t*)(p.ws + WS_C);
    const bf16_t* RFg = (const bf16_t*)(p.ws + WS_B);
    bf16_t* Z2T = (bf16_t*)(p.ws + WS_D);
    const float* cw = p.in[4]; const float* cbv = p.in[5];
    LAS bf16_t* Z = (LAS bf16_t*)lds;
    LAS bf16_t* RF = (LAS bf16_t*)(lds + NBATCH * ZS * 2);
    __syncthreads();
    for (int i = tid; i < 2048; i += 512) *(LAS u32x4*)(RF + 8 * i) = *(const u32x4*)(RFg + (size_t)(0 * 512 + c) * 16384 + 8 * i);
    {
        const float w0 = cw[c], w1 = cw[HCOLS + c], w2 = cw[2 * HCOLS + c], cb = cbv[c];
#pragma unroll 1
        for (int h6 = 0; h6 < 12; h6 += 6) {
        u32x4 xv[6]; bf16_t xm[6], xp[6];
#pragma unroll
        for (int it = 0; it < 6; ++it) {
            const int idx = tid + 512 * (it + h6), b = idx >> 9, t8 = (idx & 511) * 8;
            const bf16_t* base = PhT + (size_t)c * NTOK + b * SEQL + t8;
            xv[it] = *(const u32x4*)base; xm[it] = base[t8 > 0 ? -1 : 0]; xp[it] = base[t8 + 8 < SEQL ? 8 : 7];
        }
#pragma unroll
        for (int it = 0; it < 6; ++it) {
            const int idx = tid + 512 * (it + h6), b = idx >> 9, t8 = (idx & 511) * 8;
            const u32x4 x = xv[it];
            float v[10];
            v[0] = (t8 > 0) ? bf1(xm[it]) : 0.f; v[9] = (t8 + 8 < SEQL) ? bf1(xp[it]) : 0.f;
            v[1] = bflo(x.x); v[2] = bfhi(x.x); v[3] = bflo(x.y); v[4] = bfhi(x.y); v[5] = bflo(x.z); v[6] = bfhi(x.z); v[7] = bflo(x.w); v[8] = bfhi(x.w);
            float o[8];
#pragma unroll
            for (int j = 0; j < 8; ++j) o[j] = w0 * v[j] + w1 * v[j + 1] + w2 * v[j + 2] + cb;
            u32x4 ov; ov.x = pk2(o[0], o[1]); ov.y = pk2(o[2], o[3]); ov.z = pk2(o[4], o[5]); ov.w = pk2(o[6], o[7]);
            *(LAS u32x4*)(Z + b * ZS + t8) = ov;
        }
        }
    }
    __syncthreads();
    const int bb = (fr < NBATCH) ? fr : fr - NBATCH;
    LAS const bf16_t* Rl = (fr & 1) ? RF + 8192 + 4096 + 8 * fq - fr - 1 : RF + 4096 + 8 * fq - fr;
    if (FAKE) Rl = RF + 4096 + 8 * fq - 16;
    LAS const bf16_t* Zl = Z + bb * ZS + 8 * fq;
    f32x4 acc[16];
    {
        const int gc = 512 + c;
        const float w0 = cw[gc], w1 = cw[HCOLS + gc], w2 = cw[2 * HCOLS + gc], cb = cbv[gc];
        const bf16_t* raw = PhT + (size_t)gc * NTOK + bb * SEQL;
#pragma unroll 1
        for (int gi = 0; gi < 2; ++gi) {
            const int g = wave + 8 * gi;
            hyena_group(Rl, Zl, g, acc);
            f32x4 gts[16];
#pragma unroll
            for (int i = 0; i < 16; ++i) gts[i] = gate4(raw, 256 * g + 16 * i + 4 * fq, w0, w1, w2, cb);
#pragma unroll
            for (int i = 0; i < 16; ++i) {
                const int t = 256 * g + 16 * i + 4 * fq;
                const f32x4 zz = gts[i] * acc[i];
                u32x2 o; o.x = pk2(zz[0], zz[1]); o.y = pk2(zz[2], zz[3]);
                if (fr < NBATCH && (!FAKE || zz[0] == 123.4567f)) *(u32x2*)(Z2T + (size_t)c * NTOK + fr * SEQL + t) = o;
            }
        }
    }
    __threadfence();
    __syncthreads();
    for (int i = tid; i < 2048; i += 512) *(LAS u32x4*)(RF + 8 * i) = *(const u32x4*)(RFg + (size_t)(1 * 512 + c) * 16384 + 8 * i);
#pragma unroll 1
    for (int h6 = 0; h6 < 12; h6 += 6) {
        u32x4 zv[6];
#pragma unroll
        for (int it = 0; it < 6; ++it) { const int idx = tid + 512 * (it + h6), b = idx >> 9, t8 = (idx & 511) * 8;
            zv[it] = __builtin_nontemporal_load((const u32x4*)(Z2T + (size_t)c * NTOK + b * SEQL + t8)); }
#pragma unroll
        for (int it = 0; it < 6; ++it) { const int idx = tid + 512 * (it + h6), b = idx >> 9, t8 = (idx & 511) * 8; *(LAS u32x4*)(Z + b * ZS + t8) = zv[it]; }
    }
    __syncthreads();
    {
        const int gc = 1024 + c;
        const float w0 = cw[gc], w1 = cw[HCOLS + gc], w2 = cw[2 * HCOLS + gc], cb = cbv[gc];
        const bf16_t* raw = PhT + (size_t)gc * NTOK + bb * SEQL;
#pragma unroll 1
        for (int gi = 0; gi < 2; ++gi) {
            const int g = wave + 8 * gi;
            hyena_group(Rl, Zl, g, acc);
            f32x4 gts[16];
#pragma unroll
            for (int i = 0; i < 16; ++i) gts[i] = gate4(raw, 256 * g + 16 * i + 4 * fq, w0, w1, w2, cb);
#pragma unroll
            for (int i = 0; i < 16; ++i) {
                const int t = 256 * g + 16 * i + 4 * fq;
                const f32x4 zz = gts[i] * acc[i];
                u32x2 o; o.x = pk2(zz[0], zz[1]); o.y = pk2(zz[2], zz[3]);
                if (fr < NBATCH && (!FAKE || zz[0] == 123.4567f)) *(u32x2*)(Z2T + (size_t)c * NTOK + fr * SEQL + t) = o;
            }
        }
    }
}
__device__ __forceinline__ float lg2f_fwd(int h) { return log2f(1.0f - exp2f(-5.0f - (float)h)); }
__device__ __forceinline__ float lg2f_bwd(int h) { return log2f(1.0f - exp2f(-5.5f - (float)h)); }
constexpr int TS = 136;
struct KvRegs { u32x4 kx[2], vx[2]; };
__device__ __forceinline__ void ret_kv_load(const Params& p, int item, int tid, KvRegs& r) {
    const int bh = item >> 5, n = item & 31, b = bh >> 3, h = bh & 7;
    const bf16_t* Pr = (const bf16_t*)p.out;
    const size_t tok0 = (size_t)b * SEQL + n * 128;
#pragma unroll
    for (int q = 0; q < 2; ++q) {
        const int idx = tid + 512 * q, i = idx >> 3, dc = idx & 7;
        r.kx[q] = *(const u32x4*)(Pr + (tok0 + i) * RCOLS + 512 + 64 * h + 8 * dc);
        r.vx[q] = *(const u32x4*)(Pr + (tok0 + i) * RCOLS + 1024 + 64 * h + 8 * dc);
    }
}
__device__ __forceinline__ void ret_kv_item(const Params& p, LAS unsigned char* lds, int item, KvRegs& cur, int nxt_item) {
    const int tid = opaque_tid(), wave = tid >> 6, lane = tid & 63, fr = lane & 15, fq = lane >> 4;
    const int bh = item >> 5, n = item & 31, h = bh & 7;
    bf16_t* KV = (bf16_t*)(p.ws + WS_KV);
    LAS bf16_t* KfT = (LAS bf16_t*)lds; LAS bf16_t* KbT = KfT + 64 * TS; LAS bf16_t* VT = KbT + 64 * TS;
    const float lf = lg2f_fwd(h), lb = lg2f_bwd(h);
    __syncthreads();
#pragma unroll
    for (int q = 0; q < 2; ++q) {
        const int idx = tid + 512 * q, i = idx >> 3, dc = idx & 7;
        const u32x4 kx = cur.kx[q], vx = cur.vx[q];
        const float df = __builtin_amdgcn_exp2f((float)(127 - i) * lf), db = __builtin_amdgcn_exp2f((float)i * lb);
        const unsigned kk[4] = {kx.x, kx.y, kx.z, kx.w}, vv[4] = {vx.x, vx.y, vx.z, vx.w};
#pragma unroll
        for (int j = 0; j < 4; ++j) {
            const float k0 = bflo(kk[j]), k1 = bfhi(kk[j]);
            const unsigned f = pk2(k0 * df, k1 * df), bw = pk2(k0 * db, k1 * db);
            KfT[(8 * dc + 2 * j) * TS + i] = (bf16_t)(f & 0xffff); KfT[(8 * dc + 2 * j + 1) * TS + i] = (bf16_t)(f >> 16);
            KbT[(8 * dc + 2 * j) * TS + i] = (bf16_t)(bw & 0xffff); KbT[(8 * dc + 2 * j + 1) * TS + i] = (bf16_t)(bw >> 16);
            VT[(8 * dc + 2 * j) * TS + i] = (bf16_t)(vv[j] & 0xffff); VT[(8 * dc + 2 * j + 1) * TS + i] = (bf16_t)(vv[j] >> 16);
        }
    }
    if (nxt_item >= 0) ret_kv_load(p, nxt_item, tid, cur);
    __syncthreads();
    const int dir = wave >> 2, dt = wave & 3;
    LAS const bf16_t* KT = dir ? KbT : KfT;
    bf16x8 A[4];
#pragma unroll
    for (int kk = 0; kk < 4; ++kk) A[kk] = *(LAS const bf16x8*)(KT + (16 * dt + fr) * TS + 32 * kk + 8 * fq);
    bf16_t* dst = KV + ((size_t)(bh * 32 + n) * 2 + dir) * 4096;
#pragma unroll
    for (int et = 0; et < 4; ++et) {
        f32x4 o = (f32x4){0.f, 0.f, 0.f, 0.f};
#pragma unroll
        for (int kk = 0; kk < 4; ++kk) { const bf16x8 B = *(LAS const bf16x8*)(VT + (16 * et + fr) * TS + 32 * kk + 8 * fq); o = MFMA16(A[kk], B, o); }
        u32x2 w; w.x = pk2(o[0], o[1]); w.y = pk2(o[2], o[3]);
        *(u32x2*)(dst + (16 * et + fr) * 64 + 16 * dt + 4 * fq) = w;
    }
}

__device__ __forceinline__ void ret_kv_item_simple(const Params& p, int item) {
    const int bh = item >> 5, n = item & 31, b = bh >> 3, h = bh & 7;
    const bf16_t* Pr = (const bf16_t*)p.out;
    bf16_t* KV = (bf16_t*)(p.ws + WS_KV);
    const float lf = lg2f_fwd(h), lb = lg2f_bwd(h);
    const size_t tok0 = (size_t)b * SEQL + n * 128;
    for (int o = threadIdx.x; o < 8192; o += 512) {
        const int dir = o >> 12, e = (o >> 6) & 63, d = o & 63;
        float a = 0.f;
        for (int i = 0; i < 128; ++i) {
            const float dec = dir ? exp2f((float)i * lb) : exp2f((float)(127 - i) * lf);
            const float kq = bf1((bf16_t)(pk2(bf1(Pr[(tok0 + i) * RCOLS + 512 + 64 * h + d]) * dec, 0.f) & 0xffff));
            a += kq * bf1(Pr[(tok0 + i) * RCOLS + 1024 + 64 * h + e]);
        }
        KV[((size_t)(bh * 32 + n) * 2 + dir) * 4096 + e * 64 + d] = (bf16_t)(pk2(a, 0.f) & 0xffff);
    }
}
__device__ __forceinline__ void phase_d(const Params& p, LAS unsigned char* lds) {
    if (DIAG != 45 && DIAG != 47 && DIAG != 46) {
#pragma unroll 1
        for (int c = blockIdx.x; c < 512; c += gridDim.x) hyena_channel<0>(p, lds, c);
        if (PROBE == 6) { for (int c = blockIdx.x; c < 512; c += gridDim.x) hyena_channel<1>(p, lds, c); }
        if (PROBE == 1) { for (int c = blockIdx.x; c < 512; c += gridDim.x) hyena_channel<0>(p, lds, c); }
    }
    if (DIAG == 46) { for (int it = blockIdx.x; it < 96 * 32; it += gridDim.x) ret_kv_item_simple(p, it); return; }
    {
        KvRegs kr;
        if ((int)blockIdx.x < 96 * 32) ret_kv_load(p, blockIdx.x, opaque_tid(), kr);
#pragma unroll 1
        for (int it = blockIdx.x; it < 96 * 32; it += gridDim.x) { const int nx = it + (int)gridDim.x; ret_kv_item(p, lds, it, kr, nx < 96 * 32 ? nx : -1); }
    }
}

__device__ __forceinline__ void phase_e(const Params& p, LAS unsigned char* lds) {
    const int tid = opaque_tid(), wave = tid >> 6, lane = tid & 63;
    {
        bf16_t* KV = (bf16_t*)(p.ws + WS_KV);
        for (int id = blockIdx.x * 512 + tid; id < 96 * 2 * 512; id += gridDim.x * 512) {
            const int e8 = id & 511, dir = (id >> 9) & 1, bh = id >> 10, h = bh & 7;
            const float cd = exp2f(128.0f * (dir ? lg2f_bwd(h) : lg2f_fwd(h)));
            float s[8];
#pragma unroll
            for (int j = 0; j < 8; ++j) s[j] = 0.f;
            bf16_t* basep = KV + ((size_t)(bh * 32) * 2 + dir) * 4096 + e8 * 8;
#pragma unroll 1
            for (int q0 = 0; q0 < 32; q0 += 8) {
                u32x4 kvv[8];
#pragma unroll
                for (int j = 0; j < 8; ++j) { const int n = dir ? 31 - (q0 + j) : (q0 + j); kvv[j] = *(const u32x4*)(basep + (size_t)n * 8192); }
#pragma unroll
                for (int j = 0; j < 8; ++j) {
                    const int n = dir ? 31 - (q0 + j) : (q0 + j);
                    u32x4 o; o.x = pk2(s[0], s[1]); o.y = pk2(s[2], s[3]); o.z = pk2(s[4], s[5]); o.w = pk2(s[6], s[7]);
                    *(u32x4*)(basep + (size_t)n * 8192) = o;
                    const u32x4 kv = kvv[j];
                    s[0] = s[0] * cd + bflo(kv.x); s[1] = s[1] * cd + bfhi(kv.x); s[2] = s[2] * cd + bflo(kv.y); s[3] = s[3] * cd + bfhi(kv.y);
                    s[4] = s[4] * cd + bflo(kv.z); s[5] = s[5] * cd + bfhi(kv.z); s[6] = s[6] * cd + bflo(kv.w); s[7] = s[7] * cd + bfhi(kv.w);
                }
            }
        }
    }
    {
        const bf16_t* Z2T = (const bf16_t*)(p.ws + WS_D);
        bf16_t* Yc = (bf16_t*)(p.ws + WS_C);
        const float* og = p.in[15];
        LAS unsigned* Tl = (LAS unsigned*)lds;
        for (int it = blockIdx.x; it < NTOK / 64; it += gridDim.x) {
            const int tok0 = it * 64;
            __syncthreads();
            {
                const bf16_t* src = Z2T + (size_t)tid * NTOK + tok0;
#pragma unroll
                for (int q = 0; q < 8; ++q) { const u32x4 x = *(const u32x4*)(src + 8 * q);
                    Tl[tid * 33 + 4 * q] = x.x; Tl[tid * 33 + 4 * q + 1] = x.y; Tl[tid * 33 + 4 * q + 2] = x.z; Tl[tid * 33 + 4 * q + 3] = x.w; }
            }
            __syncthreads();
            LAS const bf16_t* Tb = (LAS const bf16_t*)lds;
            float ogv[8];
#pragma unroll
            for (int j = 0; j < 8; ++j) ogv[j] = og[lane + 64 * j];
#pragma unroll 4
            for (int q = 0; q < 8; ++q) {
                const int tt = wave * 8 + q;
                float v[8]; float ss = 0.f;
#pragma unroll
                for (int j = 0; j < 8; ++j) { v[j] = bf1(Tb[(lane + 64 * j) * 66 + tt]); ss += v[j] * v[j]; }
                ss = wave_sum(ss);
                const float rs = 1.0f / sqrtf(ss * (1.0f / 512.0f) + EPS);
#pragma unroll
                for (int j = 0; j < 8; ++j) { const float o = v[j] * rs * ogv[j]; Yc[(size_t)(tok0 + tt) * DM + lane + 64 * j] = (bf16_t)(pk2(o, 0.f) & 0xffff); }
            }
        }
    }
}

__device__ __forceinline__ void ret_out_pair(const Params& p, LAS unsigned char* lds, int pair) {
    const int tid = opaque_tid(), wave = tid >> 6, lane = tid & 63, fr = lane & 15, fq = lane >> 4;
    const int bh = pair >> 4, n0 = (pair & 15) * 2, b = bh >> 3, h = bh & 7;
    const bf16_t* Pr = (const bf16_t*)p.out;
    const bf16_t* KV = (const bf16_t*)(p.ws + WS_KV);
    bf16_t* Yc = (bf16_t*)(p.ws + WS_C);
    constexpr int KS = 72;
    constexpr int IMG = 64 * TS + 128 * KS + 128 * KS;
    const float lf = lg2f_fwd(h), lb = lg2f_bwd(h);
    const int t0 = 16 * wave;
    bf16x8 qr2[2][2];
#pragma unroll
    for (int sub = 0; sub < 2; ++sub)
#pragma unroll
        for (int kk = 0; kk < 2; ++kk) qr2[sub][kk] = *(const bf16x8*)(Pr + ((size_t)b * SEQL + (n0 + sub) * 128 + t0 + fr) * RCOLS + 64 * h + 32 * kk + 8 * fq);
    __syncthreads();
#pragma unroll
    for (int sub = 0; sub < 2; ++sub) {
        const size_t tok0 = (size_t)b * SEQL + (n0 + sub) * 128;
        const bf16_t* Sf = KV + ((size_t)(bh * 32 + n0 + sub) * 2 + 0) * 4096;
        LAS bf16_t* VT = (LAS bf16_t*)lds + sub * IMG; LAS bf16_t* KL = VT + 64 * TS; LAS bf16_t* SL = KL + 128 * KS;
#pragma unroll
        for (int it2 = 0; it2 < 2; ++it2) {
            const int idx = tid + 512 * it2, i = idx >> 3, dc = idx & 7;
            const u32x4 vx = *(const u32x4*)(Pr + (tok0 + i) * RCOLS + 1024 + 64 * h + 8 * dc);
            const u32x4 kx = *(const u32x4*)(Pr + (tok0 + i) * RCOLS + 512 + 64 * h + 8 * dc);
            const u32x4 sx = *(const u32x4*)(Sf + (size_t)idx * 8);
            *(LAS u32x4*)(KL + i * KS + 8 * dc) = kx;
            *(LAS u32x4*)(SL + (idx >> 3) * KS + 8 * dc) = sx;
            const unsigned vv[4] = {vx.x, vx.y, vx.z, vx.w};
#pragma unroll
            for (int j = 0; j < 4; ++j) { VT[(8 * dc + 2 * j) * TS + i] = (bf16_t)(vv[j] & 0xffff); VT[(8 * dc + 2 * j + 1) * TS + i] = (bf16_t)(vv[j] >> 16); }
        }
    }
    __syncthreads();
#pragma unroll 1
    for (int sub = 0; sub < 2; ++sub) {
    const size_t tok0 = (size_t)b * SEQL + (n0 + sub) * 128;
    LAS const bf16_t* VT = (LAS const bf16_t*)lds + sub * IMG; LAS const bf16_t* KL = VT + 64 * TS; LAS const bf16_t* SL = KL + 128 * KS;
    bf16x8 qr[2]; qr[0] = sub ? qr2[1][0] : qr2[0][0]; qr[1] = sub ? qr2[1][1] : qr2[0][1];
    bf16_t gates[4][4];
#pragma unroll
    for (int r = 0; r < 4; ++r)
#pragma unroll
        for (int et = 0; et < 4; ++et) gates[r][et] = Pr[(tok0 + t0 + 4 * fq + r) * RCOLS + 1536 + 64 * h + 16 * et + fr];
    f32x4 st[8];
#pragma unroll
    for (int a = 0; a < 8; ++a) {
        st[a] = (f32x4){0.f, 0.f, 0.f, 0.f};
#pragma unroll
        for (int kk = 0; kk < 2; ++kk) { const bf16x8 kr = *(LAS const bf16x8*)(KL + (16 * a + fr) * KS + 32 * kk + 8 * fq); st[a] = MFMA16(kr, qr[kk], st[a]); }
        const int it = t0 + fr;
#pragma unroll
        for (int r = 0; r < 4; ++r) { const int is = 16 * a + 4 * fq + r; const int diff = it - is;
            const float dm = __builtin_amdgcn_exp2f((diff >= 0) ? (float)diff * lf : (float)(-diff) * lb); st[a][r] *= dm; }
    }
    f32x4 oi[4], of[4], ob[4];
#pragma unroll
    for (int et = 0; et < 4; ++et) { oi[et] = (f32x4){0.f, 0.f, 0.f, 0.f}; of[et] = oi[et]; ob[et] = oi[et]; }
#pragma unroll
    for (int kb = 0; kb < 4; ++kb) {
        bf16x8 pa;
        { const unsigned a0 = pk2(st[2 * kb][0], st[2 * kb][1]), a1 = pk2(st[2 * kb][2], st[2 * kb][3]), a2 = pk2(st[2 * kb + 1][0], st[2 * kb + 1][1]), a3 = pk2(st[2 * kb + 1][2], st[2 * kb + 1][3]);
          u32x4 t; t.x = a0; t.y = a1; t.z = a2; t.w = a3; pa = __builtin_bit_cast(bf16x8, t); }
#pragma unroll
        for (int et = 0; et < 4; ++et) {
            const u32x2 v0 = *(LAS const u32x2*)(VT + (16 * et + fr) * TS + 32 * kb + 4 * fq);
            const u32x2 v1 = *(LAS const u32x2*)(VT + (16 * et + fr) * TS + 32 * kb + 16 + 4 * fq);
            u32x4 t; t.x = v0.x; t.y = v0.y; t.z = v1.x; t.w = v1.y;
            oi[et] = MFMA16(pa, __builtin_bit_cast(bf16x8, t), oi[et]);
        }
    }
#pragma unroll
    for (int et = 0; et < 4; ++et)
#pragma unroll
        for (int kk = 0; kk < 2; ++kk) {
            const bf16x8 sf = *(LAS const bf16x8*)(SL + (16 * et + fr) * KS + 32 * kk + 8 * fq);
            const bf16x8 sb = *(LAS const bf16x8*)(SL + (64 + 16 * et + fr) * KS + 32 * kk + 8 * fq);
            of[et] = MFMA16(qr[kk], sf, of[et]); ob[et] = MFMA16(qr[kk], sb, ob[et]);
        }
    const float* gg = p.in[16] + 64 * h; const float* gb = p.in[17] + 64 * h;
#pragma unroll
    for (int r = 0; r < 4; ++r) {
        const int i = t0 + 4 * fq + r;
        const float qdf = __builtin_amdgcn_exp2f((float)(i + 1) * lf), qdb = __builtin_amdgcn_exp2f((float)(128 - i) * lb);
        float o[4]; float s = 0.f;
#pragma unroll
        for (int et = 0; et < 4; ++et) { o[et] = oi[et][r] + qdf * of[et][r] + qdb * ob[et][r]; s += o[et]; }
        s += dppf<0x128>(s); s += dppf<0x124>(s); s += dppf<0x122>(s); s += dppf<0x121>(s);
        const float mu = s * (1.0f / 64.0f);
        float vs = 0.f;
#pragma unroll
        for (int et = 0; et < 4; ++et) { o[et] -= mu; vs += o[et] * o[et]; }
        vs += dppf<0x128>(vs); vs += dppf<0x124>(vs); vs += dppf<0x122>(vs); vs += dppf<0x121>(vs);
        const float rstd = __builtin_amdgcn_rsqf(vs * (1.0f / 64.0f) + EPS);
        const size_t tok = tok0 + i;
#pragma unroll
        for (int et = 0; et < 4; ++et) {
            const int e = 16 * et + fr;
            const float gate = bf1(gates[r][et]);
            const float y = (o[et] * rstd * gg[e] + gb[e]) * (gate * __builtin_amdgcn_rcpf(1.0f + __builtin_amdgcn_exp2f(-1.4426950409f * gate)));
            Yc[tok * DM + 512 + 64 * h + e] = (bf16_t)(pk2(y, 0.f) & 0xffff);
        }
    }
    }
}
__device__ __forceinline__ float gelu_tanh(float x) {
    const float u = 0.7978845608028654f * (x + 0.044715f * x * x * x);
    return x / (1.0f + __expf(-2.0f * u));
}
__device__ __forceinline__ void unpack8(const u32x4 x, float (&v)[8]) {
    v[0] = bflo(x.x); v[1] = bfhi(x.x); v[2] = bflo(x.y); v[3] = bfhi(x.y); v[4] = bflo(x.z); v[5] = bfhi(x.z); v[6] = bflo(x.w); v[7] = bfhi(x.w);
}
__device__ __forceinline__ void phase_i(const Params& p, int g0) {
    const bf16_t* U = (const bf16_t*)p.out;
    bf16_t* G = (bf16_t*)(p.ws + WS_B);
    const float* cw = p.in[21]; const float* cb = p.in[22];
    constexpr int NCH = DFF / 4, RUN = 8;
    const int tid = opaque_tid();
    for (int id = blockIdx.x * 512 + tid; id < (GROUP_TOK / RUN) * NCH; id += gridDim.x * 512) {
        const int cc = id % NCH, run = id / NCH, ca = 4 * cc, cbcol = DFF + 4 * cc;
        const int l0 = run * RUN;
        const int t0 = (g0 + l0) & (SEQL - 1);
        u32x2 ra[RUN + 2], rb[RUN + 2];
#pragma unroll
        for (int q = 0; q < RUN + 2; ++q) {
            const bool valid = (q == 0) ? (t0 > 0) : ((q == RUN + 1) ? (t0 + RUN < SEQL) : true);
            ra[q] = (u32x2){0u, 0u}; rb[q] = (u32x2){0u, 0u};
            if (valid) { const bf16_t* rowp = U + (size_t)(l0 - 1 + q) * UPC; ra[q] = *(const u32x2*)(rowp + ca); rb[q] = *(const u32x2*)(rowp + cbcol); }
        }
        f32x4 wa[3], wb[3];
#pragma unroll
        for (int k = 0; k < 3; ++k) { wa[k] = *(const f32x4*)(cw + k * UPC + ca); wb[k] = *(const f32x4*)(cw + k * UPC + cbcol); }
        const f32x4 ba = *(const f32x4*)(cb + ca), bb = *(const f32x4*)(cb + cbcol);
#pragma unroll
        for (int q = 0; q < RUN; ++q) {
            f32x4 pa, ca_, na, pb, cb_, nb;
            pa[0] = bflo(ra[q].x); pa[1] = bfhi(ra[q].x); pa[2] = bflo(ra[q].y); pa[3] = bfhi(ra[q].y);
            ca_[0] = bflo(ra[q + 1].x); ca_[1] = bfhi(ra[q + 1].x); ca_[2] = bflo(ra[q + 1].y); ca_[3] = bfhi(ra[q + 1].y);
            na[0] = bflo(ra[q + 2].x); na[1] = bfhi(ra[q + 2].x); na[2] = bflo(ra[q + 2].y); na[3] = bfhi(ra[q + 2].y);
            pb[0] = bflo(rb[q].x); pb[1] = bfhi(rb[q].x); pb[2] = bflo(rb[q].y); pb[3] = bfhi(rb[q].y);
            cb_[0] = bflo(rb[q + 1].x); cb_[1] = bfhi(rb[q + 1].x); cb_[2] = bflo(rb[q + 1].y); cb_[3] = bfhi(rb[q + 1].y);
            nb[0] = bflo(rb[q + 2].x); nb[1] = bfhi(rb[q + 2].x); nb[2] = bflo(rb[q + 2].y); nb[3] = bfhi(rb[q + 2].y);
            const f32x4 av = wa[0] * pa + wa[1] * ca_ + wa[2] * na + ba;
            const f32x4 bv = wb[0] * pb + wb[1] * cb_ + wb[2] * nb + bb;
            u32x2 ov; ov.x = pk2(gelu_tanh(av[0]) * bv[0], gelu_tanh(av[1]) * bv[1]); ov.y = pk2(gelu_tanh(av[2]) * bv[2], gelu_tanh(av[3]) * bv[3]);
            *(u32x2*)(G + (size_t)(g0 + l0 + q) * DFF + ca) = ov;
        }
    }
}
__device__ __forceinline__ void phase_k(const Params& p) {
    const int tid = opaque_tid(), wave = tid >> 6, lane = tid & 63;
    const float* part = (const float*)(p.ws + WS_P3); const float* fg = p.in[24];
    f32x4 g[4];
#pragma unroll
    for (int j = 0; j < 4; ++j) g[j] = *(const f32x4*)(fg + 256 * j + 4 * lane);
    const int NGW = gridDim.x * 8;
    for (int row0 = blockIdx.x * 8 + wave; row0 < NTOK; row0 += 2 * NGW) {
        const int row1 = (row0 + NGW < NTOK) ? row0 + NGW : row0;
        float ss0 = (lane < 16) ? part[(size_t)row0 * 16 + lane] : 0.f, ss1 = (lane < 16) ? part[(size_t)row1 * 16 + lane] : 0.f;
        const bf16_t* y0 = y_row(p.ws, row0); const bf16_t* y1 = y_row(p.ws, row1);
        u32x2 v0[4], v1[4];
#pragma unroll
        for (int j = 0; j < 4; ++j) { v0[j] = *(const u32x2*)(y0 + 256 * j + 4 * lane); v1[j] = *(const u32x2*)(y1 + 256 * j + 4 * lane); }
        ss0 = wave_sum(ss0); ss1 = wave_sum(ss1);
        const float rs0 = 1.0f / sqrtf(ss0 * (1.0f / DM) + EPS), rs1 = 1.0f / sqrtf(ss1 * (1.0f / DM) + EPS);
        float* o0 = p.out + (size_t)row0 * DM; float* o1 = p.out + (size_t)row1 * DM;
#pragma unroll
        for (int j = 0; j < 4; ++j) { f32x4 v; v[0] = bflo(v0[j].x); v[1] = bfhi(v0[j].x); v[2] = bflo(v0[j].y); v[3] = bfhi(v0[j].y); *(f32x4*)(o0 + 256 * j + 4 * lane) = v * g[j] * rs0; }
        if (row1 != row0) {
#pragma unroll
            for (int j = 0; j < 4; ++j) { f32x4 v; v[0] = bflo(v1[j].x); v[1] = bfhi(v1[j].x); v[2] = bflo(v1[j].y); v[3] = bfhi(v1[j].y); *(f32x4*)(o1 + 256 * j + 4 * lane) = v * g[j] * rs1; }
        }
    }
}


__device__ __forceinline__ void diag_dump_bf16(const Params& p, const bf16_t* src) {
    for (size_t i = (size_t)blockIdx.x * 512 + threadIdx.x; i < (size_t)NTOK * DM; i += (size_t)gridDim.x * 512) p.out[i] = bf1(src[i]);
}
__device__ __forceinline__ void diag_dump_c(const Params& p) {
    const bf16_t* PhT = (const bf16_t*)(p.ws + WS_C);
    for (size_t i = (size_t)blockIdx.x * 512 + threadIdx.x; i < (size_t)NTOK * DM; i += (size_t)gridDim.x * 512) {
        const unsigned u = ((const unsigned*)p.out)[i]; const size_t tok = i >> 10; const int c = (int)(i & 1023);
        p.out[i] = bflo(u) + bfhi(u) + bf1(PhT[(size_t)c * NTOK + tok]) + bf1(PhT[(size_t)(c + 512) * NTOK + tok]);
    }
}

__device__ __forceinline__ void gsync(const Params& p, int k) {
#if USE_CG_SYNC
    cg::this_grid().sync();
#else
    __syncthreads();
    if (threadIdx.x == 0) {
        unsigned* bar = (unsigned*)(p.ws + WS_BAR);
        const unsigned gen = (unsigned)k * gridDim.x;
        __hip_atomic_fetch_add(bar, 1u, __ATOMIC_RELEASE, __HIP_MEMORY_SCOPE_AGENT);
        while (__hip_atomic_load(bar, __ATOMIC_ACQUIRE, __HIP_MEMORY_SCOPE_AGENT) < gen) __builtin_amdgcn_s_sleep(2);
    }
    __syncthreads();
#endif
}
__global__ void __launch_bounds__(512, 2) fwd_megakernel(Params p) {
    extern __shared__ __attribute__((aligned(16))) unsigned char shm[];
    LAS unsigned char* lds = (LAS unsigned char*)shm;
    unsigned char* ws = p.ws;
    pg8::StaticOrder S;
    const int G = gridDim.x, c = blockIdx.x;

    phase_a(p, lds);
    if (PROBE == 5) { __syncthreads(); phase_a(p, lds); }
    gsync(p, 1);
    phase_rf(p);
    __syncthreads();
#pragma unroll 1
    for (int rep = 0; rep < (PROBE == 2 ? 2 : 1); ++rep) {
    {
        pg8::Gemm g{(const bf16_t*)(ws + WS_WIN), (const bf16_t*)(ws + WS_A), HCOLS, NTOK, DM, 0};
        EpiHy E{(bf16_t*)(ws + WS_C), (const float*)(ws + WS_RS1)};
        S.init(g.M, g.N, G, c); pg8::gemm_phase(lds, g, S, E);
    }
    {
        pg8::Gemm g{(const bf16_t*)(ws + WS_A), (const bf16_t*)(ws + WS_WIN) + (size_t)HCOLS * DM, NTOK, RCOLS, DM, 0};
        EpiRet E{(bf16_t*)p.out, (const float*)(ws + WS_RS1), (const float*)(ws + WS_CS)};
        S.init(g.M, g.N, G, c); pg8::gemm_phase(lds, g, S, E);
    }
    }
    if (PROBE == 7) {
        EpiNull E{(float*)(ws + WS_BAR + 512)};
        pg8::Gemm g{(const bf16_t*)(ws + WS_A), (const bf16_t*)(ws + WS_WUP), 16384, 3072, DM, 0}; S.init(g.M, g.N, G, c); pg8::gemm_phase(lds, g, S, E);
    }
    if (PROBE == 4) {
        EpiNull E{(float*)(ws + WS_BAR + 512)};
        { pg8::Gemm g{(const bf16_t*)(ws + WS_WIN), (const bf16_t*)(ws + WS_A), HCOLS, NTOK, DM, 0}; S.init(g.M, g.N, G, c); pg8::gemm_phase(lds, g, S, E); }
        { pg8::Gemm g{(const bf16_t*)(ws + WS_A), (const bf16_t*)(ws + WS_WIN) + (size_t)HCOLS * DM, NTOK, RCOLS, DM, 0}; S.init(g.M, g.N, G, c); pg8::gemm_phase(lds, g, S, E); }
    }
    gsync(p, 3);
    if (DIAG == 3) { diag_dump_c(p); return; }
    if (DIAG == 32) {
        const bf16_t* Pr = (const bf16_t*)p.out; float* scr = (float*)(ws + WS_D);
        for (int i = blockIdx.x * 512 + threadIdx.x; i < 384 * 2048; i += gridDim.x * 512) {
            const int n = i >> 11, col = i & 2047; float a = 0.f;
            for (int r = 0; r < 128; ++r) a += bf1(Pr[(size_t)(n * 128 + r) * RCOLS + col]) * (float)(1 + (r & 3));
            scr[i] = a; }
        gsync(p, 4);
        for (size_t i = (size_t)blockIdx.x * 512 + threadIdx.x; i < (size_t)NTOK * DM; i += (size_t)gridDim.x * 512) p.out[i] = (i < 384 * 2048) ? scr[i] : 0.f;
        return; }
    phase_d(p, lds);
    gsync(p, 4);
    if (DIAG == 47) { const unsigned* KVu = (const unsigned*)(ws + WS_A);
        for (size_t i = (size_t)blockIdx.x * 512 + threadIdx.x; i < (size_t)NTOK * DM; i += (size_t)gridDim.x * 512) {
            float v = 0.f;
            if (i < (size_t)96 * 32 * 4096) { const unsigned u = __hip_atomic_load(KVu + i, __ATOMIC_RELAXED, __HIP_MEMORY_SCOPE_AGENT); v = bflo(u) + 2.0f * bfhi(u); }
            p.out[i] = v; }
        return; }
    if (DIAG == 44 || DIAG == 45 || DIAG == 46) { const bf16_t* KV = (const bf16_t*)(ws + WS_A);
        for (size_t i = (size_t)blockIdx.x * 512 + threadIdx.x; i < (size_t)NTOK * DM; i += (size_t)gridDim.x * 512) p.out[i] = (i < (size_t)96 * 32 * 2 * 4096) ? bf1(KV[i]) : 0.f;
        return; }
    phase_e(p, lds);
    gsync(p, 5);
    if (DIAG == 5) { const bf16_t* Yc = (const bf16_t*)(ws + WS_C);
        for (size_t i = (size_t)blockIdx.x * 512 + threadIdx.x; i < (size_t)NTOK * DM; i += (size_t)gridDim.x * 512) p.out[i] = bf1(Yc[(i & ~(size_t)1023) + (i & 511)]);
        return; }
    if (DIAG == 55) { const bf16_t* KV = (const bf16_t*)(ws + WS_A);
        for (size_t i = (size_t)blockIdx.x * 512 + threadIdx.x; i < (size_t)NTOK * DM; i += (size_t)gridDim.x * 512) p.out[i] = (i < (size_t)96 * 32 * 2 * 4096) ? bf1(KV[i]) : 0.f;
        return; }
    for (int it = blockIdx.x; it < 96 * 16; it += gridDim.x) ret_out_pair(p, lds, it);
    gsync(p, 6);
    if (DIAG == 6) { diag_dump_bf16(p, (const bf16_t*)(ws + WS_C)); return; }
    {
        pg8::Gemm g{(const bf16_t*)(ws + WS_C), (const bf16_t*)(ws + WS_WOUT), NTOK, DM, DM, 0};
        EpiOut E{(bf16_t*)(ws + WS_A), (float*)(ws + WS_P2), (LAS float*)(lds + 131072)};
        S.init(g.M, g.N, G, c); pg8::gemm_phase(lds, g, S, E);
    }
    gsync(p, 7);
    if (DIAG == 7) { diag_dump_bf16(p, (const bf16_t*)(ws + WS_A)); return; }
    {
        pg8::Gemm g{(const bf16_t*)(ws + WS_A), (const bf16_t*)(ws + WS_WUP), 12 * 17 * 256, UPC, DM, 17};
        EpiFfn E{(bf16_t*)(ws + WS_B), (const float*)(ws + WS_P2), p.in[21], p.in[22], (LAS float*)(lds + 131072)};
        S.init(g.M, g.N, G, c); pg8::gemm_phase(lds, g, S, E);
    }
    gsync(p, 8);
    {
        pg8::Gemm g{(const bf16_t*)(ws + WS_B), (const bf16_t*)(ws + WS_WDN), NTOK, DM, DFF, 0};
        EpiDown E{ws, (const bf16_t*)(ws + WS_A), (float*)(ws + WS_P3)};
        S.init(g.M, g.N, G, c); pg8::gemm_phase(lds, g, S, E);
    }
    gsync(p, 9);
    phase_k(p);
}

extern "C" void kernel_launch(void* const* d_in, const int* in_sizes, int n_in, void* d_out, int out_size, void* d_ws, size_t ws_size, hipStream_t stream) {
    static int grid_blocks = 0;
    if (grid_blocks == 0) {
        if (n_in != 25 || out_size != NTOK * DM || ws_size < WS_END) { fprintf(stderr, "kernel_launch: unexpected shapes (n_in %d out %d ws %zu)\n", n_in, out_size, ws_size); grid_blocks = -1; return; }
        int dev = 0, cus = 0, per_cu = 0;
        hipGetDevice(&dev);
        hipDeviceGetAttribute(&cus, hipDeviceAttributeMultiprocessorCount, dev);
        hipFuncSetAttribute((const void*)fwd_megakernel, hipFuncAttributeMaxDynamicSharedMemorySize, LDS_BYTES);
        hipOccupancyMaxActiveBlocksPerMultiprocessor(&per_cu, (const void*)fwd_megakernel, 512, LDS_BYTES);
        if (per_cu < 1) { fprintf(stderr, "kernel_launch: occupancy query reports %d blocks per CU\n", per_cu); grid_blocks = -1; return; }
        if (per_cu > 1) per_cu = 1;
        grid_blocks = cus * per_cu;
    }
    if (grid_blocks < 0) return;
    Params p{};
    for (int i = 0; i < 25; ++i) p.in[i] = (const float*)d_in[i];
    p.out = (float*)d_out; p.ws = (unsigned char*)d_ws;
    void* args[] = {&p};
    hipError_t e = hipLaunchCooperativeKernel((const void*)fwd_megakernel, dim3(grid_blocks), dim3(512), args, LDS_BYTES, stream);
    if (e != hipSuccess) fprintf(stderr, "cooperative launch failed: %s (grid %d)\n", hipGetErrorString(e), grid_blocks);
}
```

```cpp
#include <hip/hip_runtime.h>
#include <hip/hip_cooperative_groups.h>
#include <cstdio>
namespace cg = cooperative_groups;

#define LAS __attribute__((address_space(3)))
typedef unsigned short bf16_t;
typedef short bf16x8 __attribute__((ext_vector_type(8)));
typedef float f32x4 __attribute__((ext_vector_type(4)));
typedef unsigned u32x4 __attribute__((ext_vector_type(4)));
typedef unsigned u32x2 __attribute__((ext_vector_type(2)));

constexpr int NTOK = 49152, NTOK_P = 32768, DM = 1024, SEQL = 4096, NBATCH = 12;
constexpr int HCOLS = 1536, RCOLS = 2048, DFF = 2816, UPC = 5632;
constexpr int GROUP_TOK = 16384;
constexpr size_t MiB = 1u << 20;
constexpr size_t WS_WIN = 0, WS_WOUT = 7 * MiB, WS_WUP = 9 * MiB, WS_WDN = 20 * MiB;
constexpr size_t WS_A = 26 * MiB;
constexpr size_t WS_B = 122 * MiB;
constexpr size_t WS_C = 250 * MiB;
constexpr size_t WS_D = 394 * MiB;
constexpr size_t WS_S = 466 * MiB;
constexpr size_t WS_RS1 = WS_S, WS_CS = WS_S + 1 * MiB, WS_H3T = WS_S + 2 * MiB, WS_P2 = WS_S + 3 * MiB, WS_P3 = WS_S + 6 * MiB, WS_BAR = WS_S + 9 * MiB, WS_END = 492 * MiB;
constexpr size_t WS_W4T = WS_S + 9 * MiB + 4096;
constexpr size_t WS_KV = WS_B + 32 * MiB;
constexpr size_t WS_Y1 = 386 * MiB, WS_Y2 = 476 * MiB; constexpr int Y_SPLIT = 40960;
constexpr int LDS_BYTES = 139264;
constexpr float EPS = 1e-6f;
#ifndef USE_CG_SYNC
#define USE_CG_SYNC 1
#endif
#ifndef PROBE
#define PROBE 0
#endif
#ifndef DIAG
#define DIAG 0
#endif

struct Params { const float* in[25]; float* out; unsigned char* ws; };

typedef __bf16 bf16v2 __attribute__((ext_vector_type(2)));
typedef float f32v2 __attribute__((ext_vector_type(2)));
__device__ __forceinline__ unsigned pk2(float lo, float hi) { f32v2 v = {lo, hi}; bf16v2 b = __builtin_convertvector(v, bf16v2); return __builtin_bit_cast(unsigned, b); }
__device__ __forceinline__ float bflo(unsigned u) { return __uint_as_float(u << 16); }
__device__ __forceinline__ float bfhi(unsigned u) { return __uint_as_float(u & 0xffff0000u); }
__device__ __forceinline__ float bf1(bf16_t b) { return __uint_as_float(((unsigned)b) << 16); }
__device__ __forceinline__ float wave_sum(float v) {
#pragma unroll
    for (int o = 1; o < 64; o <<= 1) v += __shfl_xor(v, o);
    return v;
}
__device__ __forceinline__ int opaque_tid() { int t = threadIdx.x; asm volatile("" : "+v"(t)); return t; }
template <int CTRL> __device__ __forceinline__ float dppf(float x) { return __builtin_bit_cast(float, __builtin_amdgcn_update_dpp(0, __builtin_bit_cast(int, x), CTRL, 0xF, 0xF, false)); }
__device__ __forceinline__ bf16_t* y_row(unsigned char* ws, int row) { return (row < Y_SPLIT) ? (bf16_t*)(ws + WS_Y1) + (size_t)row * DM : (bf16_t*)(ws + WS_Y2) + (size_t)(row - Y_SPLIT) * DM; }
#define LDS_WAIT() asm volatile("s_waitcnt lgkmcnt(0)" ::: "memory")

namespace pg8 {
constexpr int BM = 256, BK = 64, HALF = 128, HTB = HALF * BK * 2, NXCD = 8, WGM = 4;
__device__ __forceinline__ int lds_byte(int r, int c) { const int st = (r >> 4) * 2 + (c >> 5), rr = r & 15, cc = c & 31, ob = rr * 64 + cc * 2; return st * 1024 + (ob ^ (((ob >> 9) & 1) << 5)); }
__device__ __forceinline__ void stage_rc(int b, int& R, int& C) { const int st = b / 1024, sb = b % 1024, swz = sb ^ (((sb >> 9) & 1) << 5); R = (st >> 1) * 16 + swz / 64; C = (st & 1) * 32 + (swz % 64) / 2; }
__device__ __forceinline__ int perm32(int rho) { const int n = rho >> 4, i = rho & 15; return 8 * (i >> 2) + 4 * n + (i & 3); }
struct Unit { int pm, pn; };
struct Gemm { const bf16_t* A; const bf16_t* Bt; int M, N, K; int mtps; };
__device__ __forceinline__ long a_row0(const Gemm& g, int pm) { return g.mtps ? ((long)(pm / g.mtps) * 4096 + (long)(pm % g.mtps) * 254 - 1) : (long)pm * 256; }
struct StaticOrder {
    int nM, nN, nwg, G, c;
    __device__ void init(int M, int N, int G_, int c_) { nM = M / BM; nN = N / BM; nwg = nM * nN; G = G_; c = c_; }
    __device__ bool next(int i, Unit& u) const {
        const long L = (long)i * G + c; if (L >= nwg) return false;
        int wgid = (int)L; { const int q = nwg / NXCD, r = nwg % NXCD, xcd = wgid % NXCD, off = wgid / NXCD; wgid = (xcd < r ? xcd * (q + 1) : r * (q + 1) + (xcd - r) * q) + off; }
        const int nig = WGM * nN, gid = wgid / nig, fm = gid * WGM, gsz = (nM - fm) < WGM ? (nM - fm) : WGM;
        u.pm = fm + ((wgid % nig) % gsz); u.pn = (wgid % nig) / gsz; return true;
    }
};
template <class Epi>
__device__ __forceinline__ void gemm_phase(LAS unsigned char* lds, const Gemm g, const StaticOrder& S, const Epi& E) {
    const int tid = opaque_tid(), wid = __builtin_amdgcn_readfirstlane(tid >> 6), lane = tid & 63, wr = wid >> 2, wc = wid & 3, fr = lane & 15, fq = lane >> 4;
    const int K = g.K, nt = K / BK;
    unsigned voffA[2]; int voffB[2], voffB1[2];
#pragma unroll
    for (int i = 0; i < 2; ++i) { int R, C; stage_rc(tid * 16 + i * 8192, R, C);
        int Rb = R, Rb1 = R;
        if (Epi::BMAP == 1) { Rb = (R & ~31) + perm32(R & 31); Rb1 = Rb; }
        if (Epi::BMAP == 2) { Rb = (R & ~0x30) | ((R & 0x10) << 1) | ((R & 0x20) >> 1); Rb1 = Rb; }
        if (Epi::BMAP == 3) { Rb = 64 * (R >> 5) + perm32(R & 31); Rb1 = Rb + 32 - 128; }
        voffA[i] = (unsigned)(R * K + C) * 2u; voffB[i] = (Rb * K + C) * 2; voffB1[i] = (Rb1 * K + C) * 2; }
    const size_t kstep = (size_t)(BK * 2);
    const size_t hstep = (size_t)HALF * K * 2;
    const size_t tstep = 2 * hstep;
    const unsigned ldsw = (unsigned)wid * 1024u;
    const int aoff = lds_byte(wr * 64 + fr, fq * 8), boff = lds_byte(wc * 32 + fr, fq * 8);
#define PG8_SA(b, h) (((b) * 2 + (h)) * HTB)
#define PG8_SB(b, h) ((4 + (b) * 2 + (h)) * HTB)
#define PG8_STAGE(bufoff, gbase, voff) do { _Pragma("unroll") for (int _i = 0; _i < 2; ++_i) \
        __builtin_amdgcn_global_load_lds((const unsigned*)((const char*)(gbase) + (long)(voff)[_i]), (LAS unsigned*)(lds + (bufoff) + ldsw + _i * 8192), 16, 0, 0); } while (0)
#define PG8_LDA(dst, b, h) do { _Pragma("unroll") for (int m = 0; m < 4; ++m) _Pragma("unroll") for (int k = 0; k < 2; ++k) dst[m][k] = *(const LAS bf16x8*)(lds + PG8_SA(b, h) + aoff + m * 2048 + k * 1024); } while (0)
#define PG8_LDB(dst, b, h) do { _Pragma("unroll") for (int n = 0; n < 2; ++n) _Pragma("unroll") for (int k = 0; k < 2; ++k) dst[n][k] = *(const LAS bf16x8*)(lds + PG8_SB(b, h) + boff + n * 2048 + k * 1024); } while (0)
#define PG8_MMA(ai, bj, At, Bt) do { __builtin_amdgcn_s_setprio(1); _Pragma("unroll") for (int m = 0; m < 4; ++m) _Pragma("unroll") for (int n = 0; n < 2; ++n) _Pragma("unroll") for (int k = 0; k < 2; ++k) \
        acc[ai][bj][m][n] = __builtin_amdgcn_mfma_f32_16x16x32_bf16(Bt[n][k], At[m][k], acc[ai][bj][m][n], 0, 0, 0); __builtin_amdgcn_s_setprio(0); } while (0)
#define PG8_WAIT_V(n) asm volatile("s_waitcnt vmcnt(" #n ")" ::: "memory")
#define PG8_WAIT_L(n) asm volatile("s_waitcnt lgkmcnt(" #n ")" ::: "memory")
#define PG8_BAR __builtin_amdgcn_s_barrier()
#define PG8_SCHED __builtin_amdgcn_sched_barrier(0)
    Unit cur, nxt; int ui = 0;
    if (!S.next(0, cur)) return;
    f32x4 acc[2][2][4][2];
#pragma unroll
    for (int a = 0; a < 2; ++a)
#pragma unroll
        for (int b = 0; b < 2; ++b)
#pragma unroll
            for (int m = 0; m < 4; ++m)
#pragma unroll
                for (int n = 0; n < 2; ++n) acc[a][b][m][n] = (f32x4){0.f, 0.f, 0.f, 0.f};
    bf16x8 At[4][2], B0[2][2], B1[2][2];
    const char* cA = (const char*)g.A + a_row0(g, cur.pm) * (long)K * 2; const char* cB = (const char*)g.Bt + (size_t)cur.pn * tstep;
    PG8_STAGE(PG8_SB(0, 0), cB, voffB); PG8_STAGE(PG8_SA(0, 0), cA, voffA); PG8_STAGE(PG8_SB(0, 1), cB + hstep, voffB1); PG8_STAGE(PG8_SA(0, 1), cA + hstep, voffA);
    if (wr == 1) PG8_BAR;
    PG8_WAIT_V(4); PG8_BAR;
    PG8_STAGE(PG8_SB(1, 0), cB + kstep, voffB); PG8_STAGE(PG8_SA(1, 0), cA + kstep, voffA); PG8_STAGE(PG8_SB(1, 1), cB + hstep + kstep, voffB1);
    PG8_WAIT_V(6); PG8_BAR;
    for (;;) {
        const bool has_next = S.next(ui + 1, nxt);
        const char* nA = has_next ? (const char*)g.A + a_row0(g, nxt.pm) * (long)K * 2 : cA; const char* nB = has_next ? (const char*)g.Bt + (size_t)nxt.pn * tstep : cB;
        for (int t = 0; t < nt; t += 2) {
            const bool last = (t == nt - 2);
            const char* a1 = cA + (size_t)(t + 1) * kstep;
            const char* a2 = last ? nA : cA + (size_t)(t + 2) * kstep; const char* b2 = last ? nB : cB + (size_t)(t + 2) * kstep;
            const char* a3 = a2 + kstep; const char* b3 = b2 + kstep;
            PG8_LDB(B0, 0, 0); PG8_SCHED; PG8_LDA(At, 0, 0); PG8_STAGE(PG8_SA(1, 1), a1 + hstep, voffA);
            PG8_WAIT_L(8); PG8_BAR; PG8_WAIT_L(0); PG8_MMA(0, 0, At, B0); PG8_BAR; PG8_SCHED;
            PG8_LDB(B1, 0, 1); PG8_STAGE(PG8_SB(0, 0), b2, voffB);
            PG8_BAR; PG8_WAIT_L(0); PG8_MMA(0, 1, At, B1); PG8_BAR;
            PG8_LDA(At, 0, 1); PG8_STAGE(PG8_SA(0, 0), a2, voffA);
            PG8_BAR; PG8_WAIT_L(0); PG8_MMA(1, 0, At, B0); PG8_BAR; PG8_SCHED;
            PG8_STAGE(PG8_SB(0, 1), b2 + hstep, voffB1);
            PG8_WAIT_V(6); PG8_BAR; PG8_MMA(1, 1, At, B1); PG8_BAR;
            PG8_LDB(B0, 1, 0); PG8_SCHED; PG8_LDA(At, 1, 0); PG8_STAGE(PG8_SA(0, 1), a2 + hstep, voffA);
            PG8_WAIT_L(8); PG8_BAR; PG8_WAIT_L(0); PG8_MMA(0, 0, At, B0); PG8_BAR; PG8_SCHED;
            PG8_LDB(B1, 1, 1); PG8_STAGE(PG8_SB(1, 0), b3, voffB);
            PG8_BAR; PG8_WAIT_L(0); PG8_MMA(0, 1, At, B1); PG8_BAR;
            PG8_LDA(At, 1, 1); PG8_STAGE(PG8_SA(1, 0), a3, voffA);
            PG8_BAR; PG8_WAIT_L(0); PG8_MMA(1, 0, At, B0); PG8_BAR; PG8_SCHED;
            PG8_STAGE(PG8_SB(1, 1), b3 + hstep, voffB1);
            PG8_WAIT_V(6); PG8_BAR; PG8_MMA(1, 1, At, B1); PG8_BAR;
        }
        if (wr == 0) PG8_BAR;
        E(acc, cur, wr, wc, fr, fq);
        if (wr == 1) PG8_BAR;
        if (!has_next) break;
#pragma unroll
        for (int a = 0; a < 2; ++a)
#pragma unroll
            for (int b = 0; b < 2; ++b)
#pragma unroll
                for (int m = 0; m < 4; ++m)
#pragma unroll
                    for (int n = 0; n < 2; ++n) acc[a][b][m][n] = (f32x4){0.f, 0.f, 0.f, 0.f};
        cur = nxt; cA = nA; cB = nB; ++ui;
    }
    PG8_WAIT_V(0);
    if (wr == 0) PG8_BAR;
    PG8_BAR;
#undef PG8_SA
#undef PG8_SB
#undef PG8_STAGE
#undef PG8_LDA
#undef PG8_LDB
#undef PG8_MMA
#undef PG8_WAIT_V
#undef PG8_WAIT_L
#undef PG8_BAR
#undef PG8_SCHED
}
}
using pg8::Unit; using pg8::HALF; using pg8::BM;

struct EpiHy {
    static constexpr int BMAP = 1;
    bf16_t* O; const float* rs1;
    __device__ __forceinline__ void operator()(f32x4 (&acc)[2][2][4][2], const Unit& u, int wr, int wc, int fr, int fq) const {
        const int row0 = u.pm * BM + wr * 64 + fr, col0 = u.pn * BM + wc * 32 + 8 * fq;
        f32x4 sc[2][2];
#pragma unroll
        for (int bj = 0; bj < 2; ++bj) { sc[bj][0] = *(const f32x4*)(rs1 + col0 + bj * HALF); sc[bj][1] = *(const f32x4*)(rs1 + col0 + bj * HALF + 4); }
#pragma unroll
        for (int bj = 0; bj < 2; ++bj) {
#pragma unroll
            for (int ai = 0; ai < 2; ++ai)
#pragma unroll
                for (int m = 0; m < 4; ++m) {
                    const f32x4 v0 = acc[ai][bj][m][0] * sc[bj][0], v1 = acc[ai][bj][m][1] * sc[bj][1];
                    u32x4 o; o.x = pk2(v0[0], v0[1]); o.y = pk2(v0[2], v0[3]); o.z = pk2(v1[0], v1[1]); o.w = pk2(v1[2], v1[3]);
                    *(u32x4*)(O + (size_t)(row0 + ai * HALF + m * 16) * NTOK + col0 + bj * HALF) = o;
                }
        }
    }
};
struct EpiRet {
    static constexpr int BMAP = 3;
    bf16_t* O; const float* rs1; const float* cs;
    __device__ __forceinline__ void operator()(f32x4 (&acc)[2][2][4][2], const Unit& u, int wr, int wc, int fr, int fq) const {
        const int row0 = u.pm * BM + wr * 64 + fr;
        const bool rot = u.pn < 4; const float ksc = (u.pn >= 2 && u.pn < 4) ? 0.125f : 1.0f;
#pragma unroll
        for (int ai = 0; ai < 2; ++ai) {
            f32x4 cv[4][2], sv[4][2]; float rsv[4];
#pragma unroll
            for (int m = 0; m < 4; ++m) {
                const int row = row0 + ai * HALF + m * 16;
                rsv[m] = rs1[row];
                const float* cp = cs + (size_t)(row & (SEQL - 1)) * 64 + 8 * fq;
                cv[m][0] = *(const f32x4*)cp; cv[m][1] = *(const f32x4*)(cp + 4); sv[m][0] = *(const f32x4*)(cp + 32); sv[m][1] = *(const f32x4*)(cp + 36);
            }
            if (!rot) {
#pragma unroll
                for (int m = 0; m < 4; ++m) { cv[m][0] = cv[m][1] = (f32x4){1.f, 1.f, 1.f, 1.f}; sv[m][0] = sv[m][1] = (f32x4){0.f, 0.f, 0.f, 0.f}; }
            }
#pragma unroll
            for (int m = 0; m < 4; ++m) {
                const int row = row0 + ai * HALF + m * 16;
                const float rs = rsv[m] * ksc;
                u32x4 a, b2;
                {
                    const f32x4 x1 = acc[ai][0][m][0] * rs, x2 = acc[ai][1][m][0] * rs;
                    const f32x4 o1 = x1 * cv[m][0] - x2 * sv[m][0], o2 = x2 * cv[m][0] + x1 * sv[m][0];
                    a.x = pk2(o1[0], o1[1]); a.y = pk2(o1[2], o1[3]); b2.x = pk2(o2[0], o2[1]); b2.y = pk2(o2[2], o2[3]);
                }
                {
                    const f32x4 x1 = acc[ai][0][m][1] * rs, x2 = acc[ai][1][m][1] * rs;
                    const f32x4 o1 = x1 * cv[m][1] - x2 * sv[m][1], o2 = x2 * cv[m][1] + x1 * sv[m][1];
                    a.z = pk2(o1[0], o1[1]); a.w = pk2(o1[2], o1[3]); b2.z = pk2(o2[0], o2[1]); b2.w = pk2(o2[2], o2[3]);
                }
                bf16_t* pp = O + (size_t)row * RCOLS + u.pn * BM + 64 * wc + 8 * fq;
                *(u32x4*)pp = a; *(u32x4*)(pp + 32) = b2;
            }
        }
    }
};
struct EpiOut {
    static constexpr int BMAP = 1;
    bf16_t* O; float* part; LAS float* X;
    __device__ __forceinline__ void operator()(f32x4 (&acc)[2][2][4][2], const Unit& u, int wr, int wc, int fr, int fq) const {
        const int row0 = u.pm * BM + wr * 64 + fr, col0 = u.pn * BM + wc * 32 + 8 * fq;
#pragma unroll
        for (int ai = 0; ai < 2; ++ai) {
            u32x4 xr4[4][2];
#pragma unroll
            for (int m = 0; m < 4; ++m)
#pragma unroll
                for (int bj = 0; bj < 2; ++bj) xr4[m][bj] = *(const u32x4*)(O + (size_t)(row0 + ai * HALF + m * 16) * DM + col0 + bj * HALF);
#pragma unroll
            for (int m = 0; m < 4; ++m) {
                const int row = row0 + ai * HALF + m * 16;
                float ss = 0.f;
#pragma unroll
                for (int bj = 0; bj < 2; ++bj) {
                    u32x4* px = (u32x4*)(O + (size_t)row * DM + col0 + bj * HALF);
                    const u32x4 xr = xr4[m][bj];
                    f32x4 v0 = acc[ai][bj][m][0], v1 = acc[ai][bj][m][1];
                    v0[0] += bflo(xr.x); v0[1] += bfhi(xr.x); v0[2] += bflo(xr.y); v0[3] += bfhi(xr.y);
                    v1[0] += bflo(xr.z); v1[1] += bfhi(xr.z); v1[2] += bflo(xr.w); v1[3] += bfhi(xr.w);
                    ss += v0[0] * v0[0] + v0[1] * v0[1] + v0[2] * v0[2] + v0[3] * v0[3] + v1[0] * v1[0] + v1[1] * v1[1] + v1[2] * v1[2] + v1[3] * v1[3];
                    u32x4 o; o.x = pk2(v0[0], v0[1]); o.y = pk2(v0[2], v0[3]); o.z = pk2(v1[0], v1[1]); o.w = pk2(v1[2], v1[3]);
                    *px = o;
                }
                ss += __shfl_xor(ss, 16); ss += __shfl_xor(ss, 32);
                if (fq == 0) X[(ai * HALF + wr * 64 + m * 16 + fr) * 4 + wc] = ss;
            }
        }
        LDS_WAIT(); __builtin_amdgcn_s_barrier(); asm volatile("" ::: "memory");
        if (wr == 0) {
            const int r = wc * 64 + fq * 16 + fr;
            const f32x4 v = *(LAS const f32x4*)(X + r * 4);
            part[(size_t)(u.pm * BM + r) * 4 + u.pn] = (v[0] + v[1]) + (v[2] + v[3]);
        }
    }
};
struct EpiUp {
    static constexpr int BMAP = 1;
    bf16_t* O; const float* part; int row_base;
    __device__ __forceinline__ void operator()(f32x4 (&acc)[2][2][4][2], const Unit& u, int wr, int wc, int fr, int fq) const {
        const int row0 = u.pm * BM + wr * 64 + fr, col0 = u.pn * BM + wc * 32 + 8 * fq;
#pragma unroll
        for (int ai = 0; ai < 2; ++ai)
#pragma unroll
            for (int m = 0; m < 4; ++m) {
                const int row = row0 + ai * HALF + m * 16;
                const f32x4* pp = (const f32x4*)(part + (size_t)(row + row_base) * 16);
                const f32x4 p0 = pp[0], p1 = pp[1], p2 = pp[2], p3 = pp[3];
                const float ss = ((p0[0] + p0[1]) + (p0[2] + p0[3])) + ((p1[0] + p1[1]) + (p1[2] + p1[3])) + ((p2[0] + p2[1]) + (p2[2] + p2[3])) + ((p3[0] + p3[1]) + (p3[2] + p3[3]));
                const float rs = 1.0f / sqrtf(ss * (1.0f / DM) + EPS);
#pragma unroll
                for (int bj = 0; bj < 2; ++bj) {
                    const f32x4 v0 = acc[ai][bj][m][0] * rs, v1 = acc[ai][bj][m][1] * rs;
                    u32x4 o; o.x = pk2(v0[0], v0[1]); o.y = pk2(v0[2], v0[3]); o.z = pk2(v1[0], v1[1]); o.w = pk2(v1[2], v1[3]);
                    *(u32x4*)(O + (size_t)row * UPC + col0 + bj * HALF) = o;
                }
            }
    }
};

template <int CTRL> __device__ __forceinline__ f32x4 dpp4(f32x4 v) { f32x4 r; r[0] = dppf<CTRL>(v[0]); r[1] = dppf<CTRL>(v[1]); r[2] = dppf<CTRL>(v[2]); r[3] = dppf<CTRL>(v[3]); return r; }
__device__ __forceinline__ f32x4 gelu_fast4(f32x4 x) {
    f32x4 t = x * x; t = t * (-0.10294324f) + (-2.3022082f); t = t * x;
    f32x4 e; e[0] = __builtin_amdgcn_exp2f(t[0]); e[1] = __builtin_amdgcn_exp2f(t[1]); e[2] = __builtin_amdgcn_exp2f(t[2]); e[3] = __builtin_amdgcn_exp2f(t[3]);
    e = e + 1.0f;
    f32x4 r; r[0] = __builtin_amdgcn_rcpf(e[0]); r[1] = __builtin_amdgcn_rcpf(e[1]); r[2] = __builtin_amdgcn_rcpf(e[2]); r[3] = __builtin_amdgcn_rcpf(e[3]);
    return x * r;
}
__device__ __forceinline__ float gelu_fast(float x) {
    const float e = __builtin_amdgcn_exp2f(x * (-2.3022082f + -0.10294324f * x * x));
    return x * __builtin_amdgcn_rcpf(1.0f + e);
}
struct EpiFfn {
    static constexpr int BMAP = 1;
    bf16_t* Gout; const float* part; const float* cw; const float* cb; LAS float* X;
    __device__ __forceinline__ void operator()(f32x4 (&acc)[2][2][4][2], const Unit& u, int wr, int wc, int fr, int fq) const {
        const int seq = u.pm / 17, tbase = (u.pm % 17) * 254 - 1;
        const int colh = u.pn * 128 + wc * 32 + 8 * fq;
        f32x4 pq[2][4];
#pragma unroll
        for (int ai = 0; ai < 2; ++ai)
#pragma unroll
            for (int m = 0; m < 4; ++m) {
                const int t = tbase + 128 * ai + 64 * wr + 16 * m + fr;
                const int tc = t < 0 ? 0 : (t >= SEQL ? SEQL - 1 : t);
                pq[ai][m] = *(const f32x4*)(part + (size_t)(seq * SEQL + tc) * 4);
            }
#pragma unroll
        for (int ai = 0; ai < 2; ++ai)
#pragma unroll
            for (int m = 0; m < 4; ++m) {
                const int t = tbase + 128 * ai + 64 * wr + 16 * m + fr;
                const float ss = (pq[ai][m][0] + pq[ai][m][1]) + (pq[ai][m][2] + pq[ai][m][3]);
                const float rs = (t >= 0 && t < SEQL) ? __builtin_amdgcn_rsqf(ss * (1.0f / DM) + EPS) : 0.f;
#pragma unroll
                for (int bj = 0; bj < 2; ++bj)
#pragma unroll
                    for (int n = 0; n < 2; ++n) acc[ai][bj][m][n] = acc[ai][bj][m][n] * rs;
            }
#pragma unroll
        for (int ai = 0; ai < 2; ++ai)
#pragma unroll
            for (int bj = 0; bj < 2; ++bj)
#pragma unroll
                for (int n = 0; n < 2; ++n) {
                    LAS float* xb = X + ((2 * ai + wr) * 2) * 256 + bj * 128 + wc * 32 + 8 * fq + 4 * n;
                    if (fr == 0) *(LAS f32x4*)xb = acc[ai][bj][0][n];
                    if (fr == 15) *(LAS f32x4*)(xb + 256) = acc[ai][bj][3][n];
                }
        LDS_WAIT(); __builtin_amdgcn_s_barrier(); asm volatile("" ::: "memory");
#pragma unroll
        for (int n = 0; n < 2; ++n) {
            const int ca = colh + 4 * n;
            f32x4 wa[3], wb[3];
#pragma unroll
            for (int k = 0; k < 3; ++k) { wa[k] = *(const f32x4*)(cw + k * UPC + ca); wb[k] = *(const f32x4*)(cw + k * UPC + DFF + ca); }
            const f32x4 ba = *(const f32x4*)(cb + ca), bb = *(const f32x4*)(cb + DFF + ca);
#pragma unroll
            for (int ai = 0; ai < 2; ++ai) {
                const int strip = 2 * ai + wr;
                f32x4 xp[2], xn[2];
#pragma unroll
                for (int bj = 0; bj < 2; ++bj) {
                    LAS const float* xb = X + bj * 128 + wc * 32 + 8 * fq + 4 * n;
                    xp[bj] = (strip > 0) ? *(LAS const f32x4*)(xb + ((strip - 1) * 2 + 1) * 256) : (f32x4){0.f, 0.f, 0.f, 0.f};
                    xn[bj] = (strip < 3) ? *(LAS const f32x4*)(xb + ((strip + 1) * 2) * 256) : (f32x4){0.f, 0.f, 0.f, 0.f};
                }
#pragma unroll
                for (int m = 0; m < 4; ++m) {
                    f32x4 y[2];
#pragma unroll
                    for (int bj = 0; bj < 2; ++bj) {
                        const f32x4 cur = acc[ai][bj][m][n];
                        const f32x4 up = (m > 0) ? acc[ai][bj][m - 1][n] : xp[bj];
                        const f32x4 dn = (m < 3) ? acc[ai][bj][m + 1][n] : xn[bj];
                        f32x4 su, sd;
#pragma unroll
                        for (int j = 0; j < 4; ++j) { su[j] = (fr == 15) ? up[j] : cur[j]; sd[j] = (fr == 0) ? dn[j] : cur[j]; }
                        const f32x4 prev = dpp4<0x121>(su);
                        const f32x4 next = dpp4<0x12F>(sd);
                        y[bj] = bj ? (wb[0] * prev + wb[1] * cur + wb[2] * next + bb) : (wa[0] * prev + wa[1] * cur + wa[2] * next + ba);
                    }
                    const int lr = 128 * ai + 64 * wr + 16 * m + fr, t = tbase + lr;
                    const f32x4 gv = gelu_fast4(y[0]) * y[1];
                    u32x2 o; o.x = pk2(gv[0], gv[1]); o.y = pk2(gv[2], gv[3]);
                    if (lr >= 1 && lr <= 254 && t < SEQL) *(u32x2*)(Gout + (size_t)(seq * SEQL + t) * DFF + ca) = o;
                }
            }
        }
    }
};
struct EpiDown {
    static constexpr int BMAP = 1;
    unsigned char* ws; const bf16_t* X1; float* part;
    __device__ __forceinline__ void operator()(f32x4 (&acc)[2][2][4][2], const Unit& u, int wr, int wc, int fr, int fq) const {
        const int row0 = u.pm * BM + wr * 64 + fr, col0 = u.pn * BM + wc * 32 + 8 * fq;
#pragma unroll
        for (int ai = 0; ai < 2; ++ai) {
            u32x4 xr4[4][2];
#pragma unroll
            for (int m = 0; m < 4; ++m)
#pragma unroll
                for (int bj = 0; bj < 2; ++bj) xr4[m][bj] = *(const u32x4*)(X1 + (size_t)(row0 + ai * HALF + m * 16) * DM + col0 + bj * HALF);
#pragma unroll
            for (int m = 0; m < 4; ++m) {
                const int row = row0 + ai * HALF + m * 16;
                bf16_t* yr = y_row(ws, row);
                float ss = 0.f;
#pragma unroll
                for (int bj = 0; bj < 2; ++bj) {
                    const int col = col0 + bj * HALF;
                    const u32x4 xr = xr4[m][bj];
                    f32x4 v0 = acc[ai][bj][m][0], v1 = acc[ai][bj][m][1];
                    v0[0] += bflo(xr.x); v0[1] += bfhi(xr.x); v0[2] += bflo(xr.y); v0[3] += bfhi(xr.y);
                    v1[0] += bflo(xr.z); v1[1] += bfhi(xr.z); v1[2] += bflo(xr.w); v1[3] += bfhi(xr.w);
                    ss += v0[0] * v0[0] + v0[1] * v0[1] + v0[2] * v0[2] + v0[3] * v0[3] + v1[0] * v1[0] + v1[1] * v1[1] + v1[2] * v1[2] + v1[3] * v1[3];
                    u32x4 o; o.x = pk2(v0[0], v0[1]); o.y = pk2(v0[2], v0[3]); o.z = pk2(v1[0], v1[1]); o.w = pk2(v1[2], v1[3]);
                    *(u32x4*)(yr + col) = o;
                }
                ss += __shfl_xor(ss, 16); ss += __shfl_xor(ss, 32);
                if (fq == 0) part[(size_t)row * 16 + u.pn * 4 + wc] = ss;
            }
        }
    }
};

struct EpiNull { static constexpr int BMAP = 1;
    __device__ __forceinline__ void operator()(f32x4 (&acc)[2][2][4][2], const Unit& u, int wr, int wc, int fr, int fq) const {
        float s = 0.f;
#pragma unroll
        for (int ai = 0; ai < 2; ++ai)
#pragma unroll
            for (int bj = 0; bj < 2; ++bj)
#pragma unroll
                for (int m = 0; m < 4; ++m)
#pragma unroll
                    for (int n = 0; n < 2; ++n) s += acc[ai][bj][m][n][0] + acc[ai][bj][m][n][1] + acc[ai][bj][m][n][2] + acc[ai][bj][m][n][3];
        if (s == 123.456f) *sink = s;
    }
    float* sink; };
template <int UPPERM>
__device__ __forceinline__ void transpose_item(const float* W, const float* gk, int K, int N, bf16_t* WT, LAS float* scr, int item, int lane) {
    const int nblk = N / 32, kb = item / nblk, nb = item % nblk, k0 = 64 * kb, n0 = 32 * nb;
#pragma unroll 16
    for (int i = 0; i < 32; ++i) { const int kk = 2 * i + (lane >> 5); const float s = gk ? gk[k0 + kk] : 1.0f; scr[kk * 33 + (lane & 31)] = W[(size_t)(k0 + kk) * N + n0 + (lane & 31)] * s; }
    LDS_WAIT();
    const int c = lane & 7;
#pragma unroll
    for (int j = 0; j < 4; ++j) { const int n = (lane >> 3) + 8 * j; const LAS float* s = scr + (8 * c) * 33 + n;
        u32x4 o; o.x = pk2(s[0 * 33], s[1 * 33]); o.y = pk2(s[2 * 33], s[3 * 33]); o.z = pk2(s[4 * 33], s[5 * 33]); o.w = pk2(s[6 * 33], s[7 * 33]);
        int nr = n0 + n;
        if (UPPERM) { const int oo = nr < DFF ? nr : nr - DFF; nr = 256 * (oo >> 7) + (oo & 127) + (nr < DFF ? 0 : 128); }
        *(u32x4*)(WT + (size_t)nr * K + k0 + 8 * c) = o; }
    LDS_WAIT();
}
__device__ __forceinline__ void phase_a(const Params& p, LAS unsigned char* lds) {
    const int tid = opaque_tid(), wave = tid >> 6, lane = tid & 63;
    const int gw = blockIdx.x * 8 + wave, NGW = gridDim.x * 8;
    unsigned char* ws = p.ws;
    LAS float* scr = (LAS float*)(lds + wave * 8704);
    constexpr int I_IN = 16 * (3584 / 32), I_OUT = 16 * 32, I_UP = 16 * (UPC / 32), I_DN = (DFF / 64) * 32;
    constexpr int I_T = I_IN + I_OUT + I_UP + I_DN, I_H3 = SEQL, I_X = NTOK;
    for (int it = gw; it < I_T + I_H3; it += NGW) {
        int r = it;
        if (r < I_IN) { transpose_item<0>(p.in[3], p.in[2], DM, 3584, (bf16_t*)(ws + WS_WIN), scr, r, lane); continue; } r -= I_IN;
        if (r < I_OUT) { transpose_item<0>(p.in[18], nullptr, DM, DM, (bf16_t*)(ws + WS_WOUT), scr, r, lane); continue; } r -= I_OUT;
        if (r < I_UP) { transpose_item<1>(p.in[20], p.in[19], DM, UPC, (bf16_t*)(ws + WS_WUP), scr, r, lane); continue; } r -= I_UP;
        if (r < I_DN) { transpose_item<0>(p.in[23], nullptr, DFF, DM, (bf16_t*)(ws + WS_WDN), scr, r, lane); continue; } r -= I_DN;
        if (r < I_H3) {
            const int l = r; const float fl = (float)l;
            float z = 0.f;
            if (lane == 0) z = fl * (1.0f / 4095.0f);
            else if (lane < 33) { const int bi = (lane - 1) & 15; const float band = 1e-4f + (float)bi * ((15.0f - 1e-4f) / 15.0f);
                const float ang = (6.283185307179586f / 4096.0f) * fl * band; z = (lane < 17) ? cosf(ang) : -sinf(ang); }
            const float fr = p.in[12][lane];
            float a = p.in[7][lane];
            for (int e = 0; e < 33; ++e) a += __shfl(z, e) * p.in[6][e * 64 + lane];
            float h = sinf(fr * a);
            a = p.in[9][lane];
            for (int e = 0; e < 64; ++e) a += __shfl(h, e) * p.in[8][e * 64 + lane];
            h = sinf(fr * a);
            a = p.in[11][lane];
            for (int e = 0; e < 64; ++e) a += __shfl(h, e) * p.in[10][e * 64 + lane];
            h = sinf(fr * a);
            ((float*)(ws + WS_H3T))[lane * SEQL + l] = h;
            continue;
        }
        (void)r;
    }
    for (int row0 = gw; row0 < I_X; row0 += 2 * NGW) {
        const int row1 = row0 + NGW; const bool has1 = row1 < I_X;
        const int rr1 = has1 ? row1 : row0;
        const float* xr0 = (row0 < NTOK_P) ? p.in[0] + (size_t)row0 * DM : p.in[1] + (size_t)(row0 - NTOK_P) * DM;
        const float* xr1 = (rr1 < NTOK_P) ? p.in[0] + (size_t)rr1 * DM : p.in[1] + (size_t)(rr1 - NTOK_P) * DM;
        f32x4 v0[4], v1[4]; float s0 = 0.f, s1 = 0.f;
#pragma unroll
        for (int j = 0; j < 4; ++j) { v0[j] = *(const f32x4*)(xr0 + 256 * j + 4 * lane); v1[j] = *(const f32x4*)(xr1 + 256 * j + 4 * lane); }
#pragma unroll
        for (int j = 0; j < 4; ++j) { s0 += v0[j][0] * v0[j][0] + v0[j][1] * v0[j][1] + v0[j][2] * v0[j][2] + v0[j][3] * v0[j][3]; s1 += v1[j][0] * v1[j][0] + v1[j][1] * v1[j][1] + v1[j][2] * v1[j][2] + v1[j][3] * v1[j][3]; }
        s0 = wave_sum(s0); s1 = wave_sum(s1);
        if (lane == 0) { ((float*)(ws + WS_RS1))[row0] = 1.0f / sqrtf(s0 * (1.0f / DM) + EPS); if (has1) ((float*)(ws + WS_RS1))[row1] = 1.0f / sqrtf(s1 * (1.0f / DM) + EPS); }
        bf16_t* xb0 = (bf16_t*)(ws + WS_A) + (size_t)row0 * DM; bf16_t* xb1 = (bf16_t*)(ws + WS_A) + (size_t)rr1 * DM;
#pragma unroll
        for (int j = 0; j < 4; ++j) { u32x2 o; o.x = pk2(v0[j][0], v0[j][1]); o.y = pk2(v0[j][2], v0[j][3]); *(u32x2*)(xb0 + 256 * j + 4 * lane) = o; }
        if (has1) {
#pragma unroll
            for (int j = 0; j < 4; ++j) { u32x2 o; o.x = pk2(v1[j][0], v1[j][1]); o.y = pk2(v1[j][2], v1[j][3]); *(u32x2*)(xb1 + 256 * j + 4 * lane) = o; }
        }
    }
    for (int e = blockIdx.x * 512 + tid; e < 64 * 2048; e += gridDim.x * 512) ((float*)(ws + WS_W4T))[e] = p.in[13][(e & 63) * 2048 + (e >> 6)];
    for (int e = blockIdx.x * 512 + tid; e < SEQL * 32; e += gridDim.x * 512) {
        const int t = e >> 5, i = e & 31;
        const float inv = powf(10000.0f, -(float)(2 * i) / 64.0f);
        const float ang = (float)t * inv;
        float* cs = (float*)(ws + WS_CS) + (size_t)t * 64;
        cs[i] = cosf(ang); cs[32 + i] = sinf(ang);
    }
}
__device__ __forceinline__ void phase_b(const Params& p) {
    const int tid = opaque_tid();
    const float* h3t = (const float*)(p.ws + WS_H3T); const float* w4 = p.in[13];
    float* hft = (float*)(p.ws + WS_D);
    for (int it = blockIdx.x; it < 256 * 8; it += gridDim.x) {
        const int cg8 = it >> 3, l = (it & 7) * 512 + tid, col0 = cg8 * 8;
        float a[8];
#pragma unroll
        for (int j = 0; j < 8; ++j) a[j] = 0.f;
        for (int k = 0; k < 64; ++k) {
            const float hv = h3t[k * SEQL + l];
            const f32x4 w0 = *(const f32x4*)(w4 + k * 2048 + col0), w1 = *(const f32x4*)(w4 + k * 2048 + col0 + 4);
            a[0] += hv * w0[0]; a[1] += hv * w0[1]; a[2] += hv * w0[2]; a[3] += hv * w0[3];
            a[4] += hv * w1[0]; a[5] += hv * w1[1]; a[6] += hv * w1[2]; a[7] += hv * w1[3];
        }
        const float tl = (float)l * (1.0f / 4095.0f);
        const float d0 = -15.350567286626973f, d1 = -3.0701134573253945f;
#pragma unroll
        for (int j = 0; j < 8; ++j) {
            const int c = (col0 + j) & 511;
            const float delta = fabsf(d0 + (float)c * ((d1 - d0) / 511.0f));
            hft[(size_t)(col0 + j) * SEQL + l] = a[j] * expf(-tl * delta);
        }
    }
}
__device__ __forceinline__ void phase_toep(const Params& p) {
    const int tid = opaque_tid();
    const float* hft = (const float*)(p.ws + WS_D); const float* bias = p.in[14];
    bf16_t* T = (bf16_t*)(p.ws + WS_B);
    for (int it = blockIdx.x; it < 2048; it += gridDim.x) {
        const int oc = it >> 1, sh = it & 1;
        const float* hf = hft + (size_t)oc * SEQL; const float* hb = hft + (size_t)(1024 + oc) * SEQL;
        const float bz = bias[oc];
        for (int up = tid; up < 1024; up += 512) {
            float v[8];
#pragma unroll
            for (int j = 0; j < 8; ++j) {
                const int m = 8 * (up - 512) + j + sh, d = -m;
                float x = 0.f;
                if (d >= 0 && d < SEQL) x = hf[d]; else if (d < 0 && d > -SEQL) x = hb[-d];
                if (d == 0) x += bz;
                v[j] = x;
            }
            u32x4 o; o.x = pk2(v[0], v[1]); o.y = pk2(v[2], v[3]); o.z = pk2(v[4], v[5]); o.w = pk2(v[6], v[7]);
            *(u32x4*)(T + ((size_t)it * 1024 + up) * 8) = o;
        }
    }
}

__device__ __forceinline__ void phase_rf(const Params& p) {
    const int tid = opaque_tid();
    const float* h3t = (const float*)(p.ws + WS_H3T); const float* w4t = (const float*)(p.ws + WS_W4T); const float* bias = p.in[14];
    bf16_t* T = (bf16_t*)(p.ws + WS_B);
    const float d0 = -15.350567286626973f, d1 = -3.0701134573253945f;
    for (int q = blockIdx.x; q < 256; q += gridDim.x) {
#pragma unroll 1
        for (int lp = 0; lp < 8; ++lp) {
            const int l = lp * 512 + tid;
            float h[64];
#pragma unroll
            for (int k = 0; k < 64; ++k) h[k] = h3t[k * SEQL + l];
            const float tl = (float)l * (1.0f / 4095.0f);
#pragma unroll 1
            for (int j = 0; j < 4; ++j) {
                const int oc = __builtin_amdgcn_readfirstlane(q * 4 + j), c = oc & 511;
                const float* wf = w4t + (size_t)oc * 64; const float* wb = w4t + (size_t)(1024 + oc) * 64;
                float af = 0.f, ab = 0.f;
#pragma unroll
                for (int k = 0; k < 64; ++k) { af += h[k] * wf[k]; ab += h[k] * wb[k]; }
                const float decay = expf(-tl * fabsf(d0 + (float)c * ((d1 - d0) / 511.0f)));
                af *= decay; ab *= decay;
                if (l == 0) af += bias[oc];
                const bf16_t vf = (bf16_t)(pk2(af, 0.f) & 0xffff), vb = (bf16_t)(pk2(ab, 0.f) & 0xffff);
                bf16_t* T0 = T + (size_t)(oc * 2) * 8192; bf16_t* T1 = T0 + 8192;
                T0[4096 - l] = vf; T1[4095 - l] = vf;
                if (l >= 1) { T0[4096 + l] = vb; T1[4095 + l] = vb; }
                else { T0[0] = 0; T1[8191] = 0; }
            }
        }
    }
}

constexpr int ZS = 4112;
#define MFMA16(a, b, c) __builtin_amdgcn_mfma_f32_16x16x32_bf16(a, b, c, 0, 0, 0)
typedef u32x4 u32x4_a4 __attribute__((aligned(4)));
__device__ __forceinline__ bf16x8 ld_filt(LAS const bf16_t* q) {
    const u32x4 v = *(LAS const u32x4_a4*)q;
    return __builtin_bit_cast(bf16x8, v);
}
__device__ __forceinline__ void hyena_group(LAS const bf16_t* Rl, LAS const bf16_t* Zl, int g, f32x4 (&acc)[16]) {
    bf16x8 Aw[16];
#pragma unroll
    for (int i = 0; i < 16; ++i) { Aw[i] = ld_filt(Rl - 16 * (16 * g + i)); acc[i] = (f32x4){0.f, 0.f, 0.f, 0.f}; }
    bf16x8 Bz = *(LAS const bf16x8*)(Zl);
    for (int q = 0; q < 16; ++q) {
#pragma unroll
        for (int e = 0; e < 8; ++e) {
            const int sg = 8 * q + e;
            const int dn = 16 * g - 2 * ((sg + 1) & 127);
            const bf16x8 Bn = *(LAS const bf16x8*)(Zl + 32 * ((sg + 1) & 127));
            const bf16x8 An0 = ld_filt(Rl - 16 * dn);
            const bf16x8 An1 = ld_filt(Rl - 16 * (dn + 1));
            __builtin_amdgcn_sched_barrier(0);
            __builtin_amdgcn_s_setprio(1);
#pragma unroll
            for (int i = 15; i >= 0; --i) acc[i] = MFMA16(Aw[(i - 2 * e) & 15], Bz, acc[i]);
            __builtin_amdgcn_s_setprio(0);
            __builtin_amdgcn_sched_barrier(0);
            Aw[(14 - 2 * e) & 15] = An0;
            Aw[(15 - 2 * e) & 15] = An1;
            Bz = Bn;
        }
    }
}
__device__ __forceinline__ f32x4 gate4(const bf16_t* raw, int t, float w0, float w1, float w2, float cb) {
    const u32x2 x = *(const u32x2*)(raw + t);
    const float xm0 = bf1(raw[t > 0 ? t - 1 : 0]), xp0 = bf1(raw[t + 4 < SEQL ? t + 4 : SEQL - 1]);
    const float xm = (t > 0) ? xm0 : 0.f, xp = (t + 4 < SEQL) ? xp0 : 0.f;
    const float x0 = bflo(x.x), x1 = bfhi(x.x), x2 = bflo(x.y), x3 = bfhi(x.y);
    f32x4 g;
    g[0] = w0 * xm + w1 * x0 + w2 * x1 + cb; g[1] = w0 * x0 + w1 * x1 + w2 * x2 + cb;
    g[2] = w0 * x1 + w1 * x2 + w2 * x3 + cb; g[3] = w0 * x2 + w1 * x3 + w2 * xp + cb;
    return g;
}
template <int FAKE>
__device__ __forceinline__ void hyena_channel(const Params& p, LAS unsigned char* lds, int c) {
    const int tid = opaque_tid(), wave = tid >> 6, lane = tid & 63, fr = lane & 15, fq = lane >> 4;
    const bf16_t* PhT = (const bf16_t*)(p.ws + WS_C);
    const bf16_t* RFg = (const bf16_t*)(p.ws + WS_B);
    bf16_t* Z2T = (bf16_t*)(p.ws + WS_D);
    const float* cw = p.in[4]; const float* cbv = p.in[5];
    LAS bf16_t* Z = (LAS bf16_t*)lds;
    LAS bf16_t* RF = (LAS bf16_t*)(lds + NBATCH * ZS * 2);
    __syncthreads();
    for (int i = tid; i < 2048; i += 512) *(LAS u32x4*)(RF + 8 * i) = *(const u32x4*)(RFg + (size_t)(0 * 512 + c) * 16384 + 8 * i);
    {
        const float w0 = cw[c], w1 = cw[HCOLS + c], w2 = cw[2 * HCOLS + c], cb = cbv[c];
#pragma unroll 1
        for (int h6 = 0; h6 < 12; h6 += 6) {
        u32x4 xv[6]; bf16_t xm[6], xp[6];
#pragma unroll
        for (int it = 0; it < 6; ++it) {
            const int idx = tid + 512 * (it + h6), b = idx >> 9, t8 = (idx & 511) * 8;
            const bf16_t* base = PhT + (size_t)c * NTOK + b * SEQL + t8;
            xv[it] = *(const u32x4*)base; xm[it] = base[t8 > 0 ? -1 : 0]; xp[it] = base[t8 + 8 < SEQL ? 8 : 7];
        }
#pragma unroll
        for (int it = 0; it < 6; ++it) {
            const int idx = tid + 512 * (it + h6), b = idx >> 9, t8 = (idx & 511) * 8;
            const u32x4 x = xv[it];
            float v[10];
            v[0] = (t8 > 0) ? bf1(xm[it]) : 0.f; v[9] = (t8 + 8 < SEQL) ? bf1(xp[it]) : 0.f;
            v[1] = bflo(x.x); v[2] = bfhi(x.x); v[3] = bflo(x.y); v[4] = bfhi(x.y); v[5] = bflo(x.z); v[6] = bfhi(x.z); v[7] = bflo(x.w); v[8] = bfhi(x.w);
            float o[8];
#pragma unroll
            for (int j = 0; j < 8; ++j) o[j] = w0 * v[j] + w1 * v[j + 1] + w2 * v[j + 2] + cb;
            u32x4 ov; ov.x = pk2(o[0], o[1]); ov.y = pk2(o[2], o[3]); ov.z = pk2(o[4], o[5]); ov.w = pk2(o[6], o[7]);
            *(LAS u32x4*)(Z + b * ZS + t8) = ov;
        }
        }
    }
    __syncthreads();
    const int bb = (fr < NBATCH) ? fr : fr - NBATCH;
    LAS const bf16_t* Rl = (fr & 1) ? RF + 8192 + 4096 + 8 * fq - fr - 1 : RF + 4096 + 8 * fq - fr;
    if (FAKE) Rl = RF + 4096 + 8 * fq - 16;
    LAS const bf16_t* Zl = Z + bb * ZS + 8 * fq;
    f32x4 acc[16];
    {
        const int gc = 512 + c;
        const float w0 = cw[gc], w1 = cw[HCOLS + gc], w2 = cw[2 * HCOLS + gc], cb = cbv[gc];
        const bf16_t* raw = PhT + (size_t)gc * NTOK + bb * SEQL;
#pragma unroll 1
        for (int gi = 0; gi < 2; ++gi) {
            const int g = wave + 8 * gi;
            hyena_group(Rl, Zl, g, acc);
            f32x4 gts[16];
#pragma unroll
            for (int i = 0; i < 16; ++i) gts[i] = gate4(raw, 256 * g + 16 * i + 4 * fq, w0, w1, w2, cb);
#pragma unroll
            for (int i = 0; i < 16; ++i) {
                const int t = 256 * g + 16 * i + 4 * fq;
                const f32x4 zz = gts[i] * acc[i];
                u32x2 o; o.x = pk2(zz[0], zz[1]); o.y = pk2(zz[2], zz[3]);
                if (fr < NBATCH && (!FAKE || zz[0] == 123.4567f)) *(u32x2*)(Z2T + (size_t)c * NTOK + fr * SEQL + t) = o;
            }
        }
    }
    __threadfence();
    __syncthreads();
    for (int i = tid; i < 2048; i += 512) *(LAS u32x4*)(RF + 8 * i) = *(const u32x4*)(RFg + (size_t)(1 * 512 + c) * 16384 + 8 * i);
#pragma unroll 1
    for (int h6 = 0; h6 < 12; h6 += 6) {
        u32x4 zv[6];
#pragma unroll
        for (int it = 0; it < 6; ++it) { const int idx = tid + 512 * (it + h6), b = idx >> 9, t8 = (idx & 511) * 8;
            zv[it] = __builtin_nontemporal_load((const u32x4*)(Z2T + (size_t)c * NTOK + b * SEQL + t8)); }
#pragma unroll
        for (int it = 0; it < 6; ++it) { const int idx = tid + 512 * (it + h6), b = idx >> 9, t8 = (idx & 511) * 8; *(LAS u32x4*)(Z + b * ZS + t8) = zv[it]; }
    }
    __syncthreads();
    {
        const int gc = 1024 + c;
        const float w0 = cw[gc], w1 = cw[HCOLS + gc], w2 = cw[2 * HCOLS + gc], cb = cbv[gc];
        const bf16_t* raw = PhT + (size_t)gc * NTOK + bb * SEQL;
#pragma unroll 1
        for (int gi = 0; gi < 2; ++gi) {
            const int g = wave + 8 * gi;
            hyena_group(Rl, Zl, g, acc);
            f32x4 gts[16];
#pragma unroll
            for (int i = 0; i < 16; ++i) gts[i] = gate4(raw, 256 * g + 16 * i + 4 * fq, w0, w1, w2, cb);
#pragma unroll
            for (int i = 0; i < 16; ++i) {
                const int t = 256 * g + 16 * i + 4 * fq;
                const f32x4 zz = gts[i] * acc[i];
                u32x2 o; o.x = pk2(zz[0], zz[1]); o.y = pk2(zz[2], zz[3]);
                if (fr < NBATCH && (!FAKE || zz[0] == 123.4567f)) *(u32x2*)(Z2T + (size_t)c * NTOK + fr * SEQL + t) = o;
            }
        }
    }
}
__device__ __forceinline__ float lg2f_fwd(int h) { return log2f(1.0f - exp2f(-5.0f - (float)h)); }
__device__ __forceinline__ float lg2f_bwd(int h) { return log2f(1.0f - exp2f(-5.5f - (float)h)); }
constexpr int TS = 136;
struct KvRegs { u32x4 kx[2], vx[2]; };
__device__ __forceinline__ void ret_kv_load(const Params& p, int item, int tid, KvRegs& r) {
    const int bh = item >> 5, n = item & 31, b = bh >> 3, h = bh & 7;
    const bf16_t* Pr = (const bf16_t*)p.out;
    const size_t tok0 = (size_t)b * SEQL + n * 128;
#pragma unroll
    for (int q = 0; q < 2; ++q) {
        const int idx = tid + 512 * q, i = idx >> 3, dc = idx & 7;
        r.kx[q] = *(const u32x4*)(Pr + (tok0 + i) * RCOLS + 512 + 64 * h + 8 * dc);
        r.vx[q] = *(const u32x4*)(Pr + (tok0 + i) * RCOLS + 1024 + 64 * h + 8 * dc);
    }
}
__device__ __forceinline__ void ret_kv_item(const Params& p, LAS unsigned char* lds, int item, KvRegs& cur, int nxt_item) {
    const int tid = opaque_tid(), wave = tid >> 6, lane = tid & 63, fr = lane & 15, fq = lane >> 4;
    const int bh = item >> 5, n = item & 31, h = bh & 7;
    bf16_t* KV = (bf16_t*)(p.ws + WS_KV);
    LAS bf16_t* KfT = (LAS bf16_t*)lds; LAS bf16_t* KbT = KfT + 64 * TS; LAS bf16_t* VT = KbT + 64 * TS;
    const float lf = lg2f_fwd(h), lb = lg2f_bwd(h);
    __syncthreads();
#pragma unroll
    for (int q = 0; q < 2; ++q) {
        const int idx = tid + 512 * q, i = idx >> 3, dc = idx & 7;
        const u32x4 kx = cur.kx[q], vx = cur.vx[q];
        const float df = __builtin_amdgcn_exp2f((float)(127 - i) * lf), db = __builtin_amdgcn_exp2f((float)i * lb);
        const unsigned kk[4] = {kx.x, kx.y, kx.z, kx.w}, vv[4] = {vx.x, vx.y, vx.z, vx.w};
#pragma unroll
        for (int j = 0; j < 4; ++j) {
            const float k0 = bflo(kk[j]), k1 = bfhi(kk[j]);
            const unsigned f = pk2(k0 * df, k1 * df), bw = pk2(k0 * db, k1 * db);
            KfT[(8 * dc + 2 * j) * TS + i] = (bf16_t)(f & 0xffff); KfT[(8 * dc + 2 * j + 1) * TS + i] = (bf16_t)(f >> 16);
            KbT[(8 * dc + 2 * j) * TS + i] = (bf16_t)(bw & 0xffff); KbT[(8 * dc + 2 * j + 1) * TS + i] = (bf16_t)(bw >> 16);
            VT[(8 * dc + 2 * j) * TS + i] = (bf16_t)(vv[j] & 0xffff); VT[(8 * dc + 2 * j + 1) * TS + i] = (bf16_t)(vv[j] >> 16);
        }
    }
    if (nxt_item >= 0) ret_kv_load(p, nxt_item, tid, cur);
    __syncthreads();
    const int dir = wave >> 2, dt = wave & 3;
    LAS const bf16_t* KT = dir ? KbT : KfT;
    bf16x8 A[4];
#pragma unroll
    for (int kk = 0; kk < 4; ++kk) A[kk] = *(LAS const bf16x8*)(KT + (16 * dt + fr) * TS + 32 * kk + 8 * fq);
    bf16_t* dst = KV + ((size_t)(bh * 32 + n) * 2 + dir) * 4096;
#pragma unroll
    for (int et = 0; et < 4; ++et) {
        f32x4 o = (f32x4){0.f, 0.f, 0.f, 0.f};
#pragma unroll
        for (int kk = 0; kk < 4; ++kk) { const bf16x8 B = *(LAS const bf16x8*)(VT + (16 * et + fr) * TS + 32 * kk + 8 * fq); o = MFMA16(A[kk], B, o); }
        u32x2 w; w.x = pk2(o[0], o[1]); w.y = pk2(o[2], o[3]);
        *(u32x2*)(dst + (16 * et + fr) * 64 + 16 * dt + 4 * fq) = w;
    }
}

__device__ __forceinline__ void ret_kv_item_simple(const Params& p, int item) {
    const int bh = item >> 5, n = item & 31, b = bh >> 3, h = bh & 7;
    const bf16_t* Pr = (const bf16_t*)p.out;
    bf16_t* KV = (bf16_t*)(p.ws + WS_KV);
    const float lf = lg2f_fwd(h), lb = lg2f_bwd(h);
    const size_t tok0 = (size_t)b * SEQL + n * 128;
    for (int o = threadIdx.x; o < 8192; o += 512) {
        const int dir = o >> 12, e = (o >> 6) & 63, d = o & 63;
        float a = 0.f;
        for (int i = 0; i < 128; ++i) {
            const float dec = dir ? exp2f((float)i * lb) : exp2f((float)(127 - i) * lf);
            const float kq = bf1((bf16_t)(pk2(bf1(Pr[(tok0 + i) * RCOLS + 512 + 64 * h + d]) * dec, 0.f) & 0xffff));
            a += kq * bf1(Pr[(tok0 + i) * RCOLS + 1024 + 64 * h + e]);
        }
        KV[((size_t)(bh * 32 + n) * 2 + dir) * 4096 + e * 64 + d] = (bf16_t)(pk2(a, 0.f) & 0xffff);
    }
}
__device__ __forceinline__ void phase_d(const Params& p, LAS unsigned char* lds) {
    if (DIAG != 45 && DIAG != 47 && DIAG != 46) {
#pragma unroll 1
        for (int c = blockIdx.x; c < 512; c += gridDim.x) hyena_channel<0>(p, lds, c);
        if (PROBE == 6) { for (int c = blockIdx.x; c < 512; c += gridDim.x) hyena_channel<1>(p, lds, c); }
        if (PROBE == 1) { for (int c = blockIdx.x; c < 512; c += gridDim.x) hyena_channel<0>(p, lds, c); }
    }
    if (DIAG == 46) { for (int it = blockIdx.x; it < 96 * 32; it += gridDim.x) ret_kv_item_simple(p, it); return; }
    {
        KvRegs kr;
        if ((int)blockIdx.x < 96 * 32) ret_kv_load(p, blockIdx.x, opaque_tid(), kr);
#pragma unroll 1
        for (int it = blockIdx.x; it < 96 * 32; it += gridDim.x) { const int nx = it + (int)gridDim.x; ret_kv_item(p, lds, it, kr, nx < 96 * 32 ? nx : -1); }
    }
}

__device__ __forceinline__ void phase_e(const Params& p, LAS unsigned char* lds) {
    const int tid = opaque_tid(), wave = tid >> 6, lane = tid & 63;
    {
        bf16_t* KV = (bf16_t*)(p.ws + WS_KV);
        for (int id = blockIdx.x * 512 + tid; id < 96 * 2 * 512; id += gridDim.x * 512) {
            const int e8 = id & 511, dir = (id >> 9) & 1, bh = id >> 10, h = bh & 7;
            const float cd = exp2f(128.0f * (dir ? lg2f_bwd(h) : lg2f_fwd(h)));
            float s[8];
#pragma unroll
            for (int j = 0; j < 8; ++j) s[j] = 0.f;
            bf16_t* basep = KV + ((size_t)(bh * 32) * 2 + dir) * 4096 + e8 * 8;
#pragma unroll 1
            for (int q0 = 0; q0 < 32; q0 += 8) {
                u32x4 kvv[8];
#pragma unroll
                for (int j = 0; j < 8; ++j) { const int n = dir ? 31 - (q0 + j) : (q0 + j); kvv[j] = *(const u32x4*)(basep + (size_t)n * 8192); }
#pragma unroll
                for (int j = 0; j < 8; ++j) {
                    const int n = dir ? 31 - (q0 + j) : (q0 + j);
                    u32x4 o; o.x = pk2(s[0], s[1]); o.y = pk2(s[2], s[3]); o.z = pk2(s[4], s[5]); o.w = pk2(s[6], s[7]);
                    *(u32x4*)(basep + (size_t)n * 8192) = o;
                    const u32x4 kv = kvv[j];
                    s[0] = s[0] * cd + bflo(kv.x); s[1] = s[1] * cd + bfhi(kv.x); s[2] = s[2] * cd + bflo(kv.y); s[3] = s[3] * cd + bfhi(kv.y);
                    s[4] = s[4] * cd + bflo(kv.z); s[5] = s[5] * cd + bfhi(kv.z); s[6] = s[6] * cd + bflo(kv.w); s[7] = s[7] * cd + bfhi(kv.w);
                }
            }
        }
    }
    {
        const bf16_t* Z2T = (const bf16_t*)(p.ws + WS_D);
        bf16_t* Yc = (bf16_t*)(p.ws + WS_C);
        const float* og = p.in[15];
        LAS unsigned* Tl = (LAS unsigned*)lds;
        for (int it = blockIdx.x; it < NTOK / 64; it += gridDim.x) {
            const int tok0 = it * 64;
            __syncthreads();
            {
                const bf16_t* src = Z2T + (size_t)tid * NTOK + tok0;
#pragma unroll
                for (int q = 0; q < 8; ++q) { const u32x4 x = *(const u32x4*)(src + 8 * q);
                    Tl[tid * 33 + 4 * q] = x.x; Tl[tid * 33 + 4 * q + 1] = x.y; Tl[tid * 33 + 4 * q + 2] = x.z; Tl[tid * 33 + 4 * q + 3] = x.w; }
            }
            __syncthreads();
            LAS const bf16_t* Tb = (LAS const bf16_t*)lds;
            float ogv[8];
#pragma unroll
            for (int j = 0; j < 8; ++j) ogv[j] = og[lane + 64 * j];
#pragma unroll 4
            for (int q = 0; q < 8; ++q) {
                const int tt = wave * 8 + q;
                float v[8]; float ss = 0.f;
#pragma unroll
                for (int j = 0; j < 8; ++j) { v[j] = bf1(Tb[(lane + 64 * j) * 66 + tt]); ss += v[j] * v[j]; }
                ss = wave_sum(ss);
                const float rs = 1.0f / sqrtf(ss * (1.0f / 512.0f) + EPS);
#pragma unroll
                for (int j = 0; j < 8; ++j) { const float o = v[j] * rs * ogv[j]; Yc[(size_t)(tok0 + tt) * DM + lane + 64 * j] = (bf16_t)(pk2(o, 0.f) & 0xffff); }
            }
        }
    }
}

struct RoRegs { bf16x8 q[2][2]; u32x4 vx[2][2], kx[2][2], sx[2][2]; };
__device__ __forceinline__ void ret_out_load(const Params& p, int pair, int tid, RoRegs& r) {
    const int wave = tid >> 6, lane = tid & 63, fr = lane & 15, fq = lane >> 4;
    const int bh = pair >> 4, n0 = (pair & 15) * 2, b = bh >> 3, h = bh & 7, t0 = 16 * wave;
    const bf16_t* Pr = (const bf16_t*)p.out;
    const bf16_t* KV = (const bf16_t*)(p.ws + WS_KV);
#pragma unroll
    for (int sub = 0; sub < 2; ++sub) {
        const size_t tok0 = (size_t)b * SEQL + (n0 + sub) * 128;
        const bf16_t* Sf = KV + ((size_t)(bh * 32 + n0 + sub) * 2 + 0) * 4096;
#pragma unroll
        for (int kk = 0; kk < 2; ++kk) r.q[sub][kk] = *(const bf16x8*)(Pr + (tok0 + t0 + fr) * RCOLS + 64 * h + 32 * kk + 8 * fq);
#pragma unroll
        for (int it2 = 0; it2 < 2; ++it2) {
            const int idx = tid + 512 * it2, i = idx >> 3, dc = idx & 7;
            r.vx[sub][it2] = *(const u32x4*)(Pr + (tok0 + i) * RCOLS + 1024 + 64 * h + 8 * dc);
            r.kx[sub][it2] = *(const u32x4*)(Pr + (tok0 + i) * RCOLS + 512 + 64 * h + 8 * dc);
            r.sx[sub][it2] = *(const u32x4*)(Sf + (size_t)idx * 8);
        }
    }
}
__device__ __forceinline__ void ret_out_pair(const Params& p, LAS unsigned char* lds, int pair, RoRegs& cur, int nxt_pair) {
    const int tid = opaque_tid(), wave = tid >> 6, lane = tid & 63, fr = lane & 15, fq = lane >> 4;
    const int bh = pair >> 4, n0 = (pair & 15) * 2, b = bh >> 3, h = bh & 7;
    const bf16_t* Pr = (const bf16_t*)p.out;
    bf16_t* Yc = (bf16_t*)(p.ws + WS_C);
    constexpr int KS = 72;
    constexpr int IMG = 64 * TS + 128 * KS + 128 * KS;
    const float lf = lg2f_fwd(h), lb = lg2f_bwd(h);
    const int t0 = 16 * wave;
    bf16x8 qr2[2][2];
#pragma unroll
    for (int sub = 0; sub < 2; ++sub)
#pragma unroll
        for (int kk = 0; kk < 2; ++kk) qr2[sub][kk] = cur.q[sub][kk];
    __syncthreads();
#pragma unroll
    for (int sub = 0; sub < 2; ++sub) {
        LAS bf16_t* VT = (LAS bf16_t*)lds + sub * IMG; LAS bf16_t* KL = VT + 64 * TS; LAS bf16_t* SL = KL + 128 * KS;
#pragma unroll
        for (int it2 = 0; it2 < 2; ++it2) {
            const int idx = tid + 512 * it2, i = idx >> 3, dc = idx & 7;
            const u32x4 vx = cur.vx[sub][it2];
            *(LAS u32x4*)(KL + i * KS + 8 * dc) = cur.kx[sub][it2];
            *(LAS u32x4*)(SL + (idx >> 3) * KS + 8 * dc) = cur.sx[sub][it2];
            const unsigned vv[4] = {vx.x, vx.y, vx.z, vx.w};
#pragma unroll
            for (int j = 0; j < 4; ++j) { VT[(8 * dc + 2 * j) * TS + i] = (bf16_t)(vv[j] & 0xffff); VT[(8 * dc + 2 * j + 1) * TS + i] = (bf16_t)(vv[j] >> 16); }
        }
    }
    if (nxt_pair >= 0) ret_out_load(p, nxt_pair, tid, cur);
    __syncthreads();
#pragma unroll 1
    for (int sub = 0; sub < 2; ++sub) {
    const size_t tok0 = (size_t)b * SEQL + (n0 + sub) * 128;
    LAS const bf16_t* VT = (LAS const bf16_t*)lds + sub * IMG; LAS const bf16_t* KL = VT + 64 * TS; LAS const bf16_t* SL = KL + 128 * KS;
    bf16x8 qr[2]; qr[0] = sub ? qr2[1][0] : qr2[0][0]; qr[1] = sub ? qr2[1][1] : qr2[0][1];
    bf16_t gates[4][4];
#pragma unroll
    for (int r = 0; r < 4; ++r)
#pragma unroll
        for (int et = 0; et < 4; ++et) gates[r][et] = Pr[(tok0 + t0 + 4 * fq + r) * RCOLS + 1536 + 64 * h + 16 * et + fr];
    f32x4 st[8];
#pragma unroll
    for (int a = 0; a < 8; ++a) {
        st[a] = (f32x4){0.f, 0.f, 0.f, 0.f};
#pragma unroll
        for (int kk = 0; kk < 2; ++kk) { const bf16x8 kr = *(LAS const bf16x8*)(KL + (16 * a + fr) * KS + 32 * kk + 8 * fq); st[a] = MFMA16(kr, qr[kk], st[a]); }
        const int it = t0 + fr;
#pragma unroll
        for (int r = 0; r < 4; ++r) { const int is = 16 * a + 4 * fq + r; const int diff = it - is;
            const float dm = __builtin_amdgcn_exp2f((diff >= 0) ? (float)diff * lf : (float)(-diff) * lb); st[a][r] *= dm; }
    }
    f32x4 oi[4], of[4], ob[4];
#pragma unroll
    for (int et = 0; et < 4; ++et) { oi[et] = (f32x4){0.f, 0.f, 0.f, 0.f}; of[et] = oi[et]; ob[et] = oi[et]; }
#pragma unroll
    for (int kb = 0; kb < 4; ++kb) {
        bf16x8 pa;
        { const unsigned a0 = pk2(st[2 * kb][0], st[2 * kb][1]), a1 = pk2(st[2 * kb][2], st[2 * kb][3]), a2 = pk2(st[2 * kb + 1][0], st[2 * kb + 1][1]), a3 = pk2(st[2 * kb + 1][2], st[2 * kb + 1][3]);
          u32x4 t; t.x = a0; t.y = a1; t.z = a2; t.w = a3; pa = __builtin_bit_cast(bf16x8, t); }
#pragma unroll
        for (int et = 0; et < 4; ++et) {
            const u32x2 v0 = *(LAS const u32x2*)(VT + (16 * et + fr) * TS + 32 * kb + 4 * fq);
            const u32x2 v1 = *(LAS const u32x2*)(VT + (16 * et + fr) * TS + 32 * kb + 16 + 4 * fq);
            u32x4 t; t.x = v0.x; t.y = v0.y; t.z = v1.x; t.w = v1.y;
            oi[et] = MFMA16(pa, __builtin_bit_cast(bf16x8, t), oi[et]);
        }
    }
#pragma unroll
    for (int et = 0; et < 4; ++et)
#pragma unroll
        for (int kk = 0; kk < 2; ++kk) {
            const bf16x8 sf = *(LAS const bf16x8*)(SL + (16 * et + fr) * KS + 32 * kk + 8 * fq);
            const bf16x8 sb = *(LAS const bf16x8*)(SL + (64 + 16 * et + fr) * KS + 32 * kk + 8 * fq);
            of[et] = MFMA16(qr[kk], sf, of[et]); ob[et] = MFMA16(qr[kk], sb, ob[et]);
        }
    const float* gg = p.in[16] + 64 * h; const float* gb = p.in[17] + 64 * h;
#pragma unroll
    for (int r = 0; r < 4; ++r) {
        const int i = t0 + 4 * fq + r;
        const float qdf = __builtin_amdgcn_exp2f((float)(i + 1) * lf), qdb = __builtin_amdgcn_exp2f((float)(128 - i) * lb);
        float o[4]; float s = 0.f;
#pragma unroll
        for (int et = 0; et < 4; ++et) { o[et] = oi[et][r] + qdf * of[et][r] + qdb * ob[et][r]; s += o[et]; }
        s += dppf<0x128>(s); s += dppf<0x124>(s); s += dppf<0x122>(s); s += dppf<0x121>(s);
        const float mu = s * (1.0f / 64.0f);
        float vs = 0.f;
#pragma unroll
        for (int et = 0; et < 4; ++et) { o[et] -= mu; vs += o[et] * o[et]; }
        vs += dppf<0x128>(vs); vs += dppf<0x124>(vs); vs += dppf<0x122>(vs); vs += dppf<0x121>(vs);
        const float rstd = __builtin_amdgcn_rsqf(vs * (1.0f / 64.0f) + EPS);
        const size_t tok = tok0 + i;
#pragma unroll
        for (int et = 0; et < 4; ++et) {
            const int e = 16 * et + fr;
            const float gate = bf1(gates[r][et]);
            const float y = (o[et] * rstd * gg[e] + gb[e]) * (gate * __builtin_amdgcn_rcpf(1.0f + __builtin_amdgcn_exp2f(-1.4426950409f * gate)));
            Yc[tok * DM + 512 + 64 * h + e] = (bf16_t)(pk2(y, 0.f) & 0xffff);
        }
    }
    }
}
__device__ __forceinline__ float gelu_tanh(float x) {
    const float u = 0.7978845608028654f * (x + 0.044715f * x * x * x);
    return x / (1.0f + __expf(-2.0f * u));
}
__device__ __forceinline__ void unpack8(const u32x4 x, float (&v)[8]) {
    v[0] = bflo(x.x); v[1] = bfhi(x.x); v[2] = bflo(x.y); v[3] = bfhi(x.y); v[4] = bflo(x.z); v[5] = bfhi(x.z); v[6] = bflo(x.w); v[7] = bfhi(x.w);
}
__device__ __forceinline__ void phase_i(const Params& p, int g0) {
    const bf16_t* U = (const bf16_t*)p.out;
    bf16_t* G = (bf16_t*)(p.ws + WS_B);
    const float* cw = p.in[21]; const float* cb = p.in[22];
    constexpr int NCH = DFF / 4, RUN = 8;
    const int tid = opaque_tid();
    for (int id = blockIdx.x * 512 + tid; id < (GROUP_TOK / RUN) * NCH; id += gridDim.x * 512) {
        const int cc = id % NCH, run = id / NCH, ca = 4 * cc, cbcol = DFF + 4 * cc;
        const int l0 = run * RUN;
        const int t0 = (g0 + l0) & (SEQL - 1);
        u32x2 ra[RUN + 2], rb[RUN + 2];
#pragma unroll
        for (int q = 0; q < RUN + 2; ++q) {
            const bool valid = (q == 0) ? (t0 > 0) : ((q == RUN + 1) ? (t0 + RUN < SEQL) : true);
            ra[q] = (u32x2){0u, 0u}; rb[q] = (u32x2){0u, 0u};
            if (valid) { const bf16_t* rowp = U + (size_t)(l0 - 1 + q) * UPC; ra[q] = *(const u32x2*)(rowp + ca); rb[q] = *(const u32x2*)(rowp + cbcol); }
        }
        f32x4 wa[3], wb[3];
#pragma unroll
        for (int k = 0; k < 3; ++k) { wa[k] = *(const f32x4*)(cw + k * UPC + ca); wb[k] = *(const f32x4*)(cw + k * UPC + cbcol); }
        const f32x4 ba = *(const f32x4*)(cb + ca), bb = *(const f32x4*)(cb + cbcol);
#pragma unroll
        for (int q = 0; q < RUN; ++q) {
            f32x4 pa, ca_, na, pb, cb_, nb;
            pa[0] = bflo(ra[q].x); pa[1] = bfhi(ra[q].x); pa[2] = bflo(ra[q].y); pa[3] = bfhi(ra[q].y);
            ca_[0] = bflo(ra[q + 1].x); ca_[1] = bfhi(ra[q + 1].x); ca_[2] = bflo(ra[q + 1].y); ca_[3] = bfhi(ra[q + 1].y);
            na[0] = bflo(ra[q + 2].x); na[1] = bfhi(ra[q + 2].x); na[2] = bflo(ra[q + 2].y); na[3] = bfhi(ra[q + 2].y);
            pb[0] = bflo(rb[q].x); pb[1] = bfhi(rb[q].x); pb[2] = bflo(rb[q].y); pb[3] = bfhi(rb[q].y);
            cb_[0] = bflo(rb[q + 1].x); cb_[1] = bfhi(rb[q + 1].x); cb_[2] = bflo(rb[q + 1].y); cb_[3] = bfhi(rb[q + 1].y);
            nb[0] = bflo(rb[q + 2].x); nb[1] = bfhi(rb[q + 2].x); nb[2] = bflo(rb[q + 2].y); nb[3] = bfhi(rb[q + 2].y);
            const f32x4 av = wa[0] * pa + wa[1] * ca_ + wa[2] * na + ba;
            const f32x4 bv = wb[0] * pb + wb[1] * cb_ + wb[2] * nb + bb;
            u32x2 ov; ov.x = pk2(gelu_tanh(av[0]) * bv[0], gelu_tanh(av[1]) * bv[1]); ov.y = pk2(gelu_tanh(av[2]) * bv[2], gelu_tanh(av[3]) * bv[3]);
            *(u32x2*)(G + (size_t)(g0 + l0 + q) * DFF + ca) = ov;
        }
    }
}
__device__ __forceinline__ void phase_k(const Params& p) {
    const int tid = opaque_tid(), wave = tid >> 6, lane = tid & 63;
    const float* part = (const float*)(p.ws + WS_P3); const float* fg = p.in[24];
    f32x4 g[4];
#pragma unroll
    for (int j = 0; j < 4; ++j) g[j] = *(const f32x4*)(fg + 256 * j + 4 * lane);
    const int NGW = gridDim.x * 8;
    for (int row0 = blockIdx.x * 8 + wave; row0 < NTOK; row0 += 2 * NGW) {
        const int row1 = (row0 + NGW < NTOK) ? row0 + NGW : row0;
        float ss0 = (lane < 16) ? part[(size_t)row0 * 16 + lane] : 0.f, ss1 = (lane < 16) ? part[(size_t)row1 * 16 + lane] : 0.f;
        const bf16_t* y0 = y_row(p.ws, row0); const bf16_t* y1 = y_row(p.ws, row1);
        u32x2 v0[4], v1[4];
#pragma unroll
        for (int j = 0; j < 4; ++j) { v0[j] = *(const u32x2*)(y0 + 256 * j + 4 * lane); v1[j] = *(const u32x2*)(y1 + 256 * j + 4 * lane); }
        ss0 = wave_sum(ss0); ss1 = wave_sum(ss1);
        const float rs0 = 1.0f / sqrtf(ss0 * (1.0f / DM) + EPS), rs1 = 1.0f / sqrtf(ss1 * (1.0f / DM) + EPS);
        float* o0 = p.out + (size_t)row0 * DM; float* o1 = p.out + (size_t)row1 * DM;
#pragma unroll
        for (int j = 0; j < 4; ++j) { f32x4 v; v[0] = bflo(v0[j].x); v[1] = bfhi(v0[j].x); v[2] = bflo(v0[j].y); v[3] = bfhi(v0[j].y); *(f32x4*)(o0 + 256 * j + 4 * lane) = v * g[j] * rs0; }
        if (row1 != row0) {
#pragma unroll
            for (int j = 0; j < 4; ++j) { f32x4 v; v[0] = bflo(v1[j].x); v[1] = bfhi(v1[j].x); v[2] = bflo(v1[j].y); v[3] = bfhi(v1[j].y); *(f32x4*)(o1 + 256 * j + 4 * lane) = v * g[j] * rs1; }
        }
    }
}


__device__ __forceinline__ void diag_dump_bf16(const Params& p, const bf16_t* src) {
    for (size_t i = (size_t)blockIdx.x * 512 + threadIdx.x; i < (size_t)NTOK * DM; i += (size_t)gridDim.x * 512) p.out[i] = bf1(src[i]);
}
__device__ __forceinline__ void diag_dump_c(const Params& p) {
    const bf16_t* PhT = (const bf16_t*)(p.ws + WS_C);
    for (size_t i = (size_t)blockIdx.x * 512 + threadIdx.x; i < (size_t)NTOK * DM; i += (size_t)gridDim.x * 512) {
        const unsigned u = ((const unsigned*)p.out)[i]; const size_t tok = i >> 10; const int c = (int)(i & 1023);
        p.out[i] = bflo(u) + bfhi(u) + bf1(PhT[(size_t)c * NTOK + tok]) + bf1(PhT[(size_t)(c + 512) * NTOK + tok]);
    }
}

__device__ __forceinline__ void gsync(const Params& p, int k) {
#if USE_CG_SYNC
    cg::this_grid().sync();
#else
    __syncthreads();
    if (threadIdx.x == 0) {
        unsigned* bar = (unsigned*)(p.ws + WS_BAR);
        const unsigned gen = (unsigned)k * gridDim.x;
        __hip_atomic_fetch_add(bar, 1u, __ATOMIC_RELEASE, __HIP_MEMORY_SCOPE_AGENT);
        while (__hip_atomic_load(bar, __ATOMIC_ACQUIRE, __HIP_MEMORY_SCOPE_AGENT) < gen) __builtin_amdgcn_s_sleep(2);
    }
    __syncthreads();
#endif
}
__global__ void __launch_bounds__(512, 2) fwd_megakernel(Params p) {
    extern __shared__ __attribute__((aligned(16))) unsigned char shm[];
    LAS unsigned char* lds = (LAS unsigned char*)shm;
    unsigned char* ws = p.ws;
    pg8::StaticOrder S;
    const int G = gridDim.x, c = blockIdx.x;

    phase_a(p, lds);
    if (PROBE == 5) { __syncthreads(); phase_a(p, lds); }
    gsync(p, 1);
    phase_rf(p);
    __syncthreads();
#pragma unroll 1
    for (int rep = 0; rep < (PROBE == 2 ? 2 : 1); ++rep) {
    {
        pg8::Gemm g{(const bf16_t*)(ws + WS_WIN), (const bf16_t*)(ws + WS_A), HCOLS, NTOK, DM, 0};
        EpiHy E{(bf16_t*)(ws + WS_C), (const float*)(ws + WS_RS1)};
        S.init(g.M, g.N, G, c); pg8::gemm_phase(lds, g, S, E);
    }
    {
        pg8::Gemm g{(const bf16_t*)(ws + WS_A), (const bf16_t*)(ws + WS_WIN) + (size_t)HCOLS * DM, NTOK, RCOLS, DM, 0};
        EpiRet E{(bf16_t*)p.out, (const float*)(ws + WS_RS1), (const float*)(ws + WS_CS)};
        S.init(g.M, g.N, G, c); pg8::gemm_phase(lds, g, S, E);
    }
    }
    if (PROBE == 7) {
        EpiNull E{(float*)(ws + WS_BAR + 512)};
        pg8::Gemm g{(const bf16_t*)(ws + WS_A), (const bf16_t*)(ws + WS_WUP), 16384, 3072, DM, 0}; S.init(g.M, g.N, G, c); pg8::gemm_phase(lds, g, S, E);
    }
    if (PROBE == 4) {
        EpiNull E{(float*)(ws + WS_BAR + 512)};
        { pg8::Gemm g{(const bf16_t*)(ws + WS_WIN), (const bf16_t*)(ws + WS_A), HCOLS, NTOK, DM, 0}; S.init(g.M, g.N, G, c); pg8::gemm_phase(lds, g, S, E); }
        { pg8::Gemm g{(const bf16_t*)(ws + WS_A), (const bf16_t*)(ws + WS_WIN) + (size_t)HCOLS * DM, NTOK, RCOLS, DM, 0}; S.init(g.M, g.N, G, c); pg8::gemm_phase(lds, g, S, E); }
    }
    gsync(p, 3);
    if (DIAG == 3) { diag_dump_c(p); return; }
    if (DIAG == 32) {
        const bf16_t* Pr = (const bf16_t*)p.out; float* scr = (float*)(ws + WS_D);
        for (int i = blockIdx.x * 512 + threadIdx.x; i < 384 * 2048; i += gridDim.x * 512) {
            const int n = i >> 11, col = i & 2047; float a = 0.f;
            for (int r = 0; r < 128; ++r) a += bf1(Pr[(size_t)(n * 128 + r) * RCOLS + col]) * (float)(1 + (r & 3));
            scr[i] = a; }
        gsync(p, 4);
        for (size_t i = (size_t)blockIdx.x * 512 + threadIdx.x; i < (size_t)NTOK * DM; i += (size_t)gridDim.x * 512) p.out[i] = (i < 384 * 2048) ? scr[i] : 0.f;
        return; }
    phase_d(p, lds);
    gsync(p, 4);
    if (DIAG == 47) { const unsigned* KVu = (const unsigned*)(ws + WS_A);
        for (size_t i = (size_t)blockIdx.x * 512 + threadIdx.x; i < (size_t)NTOK * DM; i += (size_t)gridDim.x * 512) {
            float v = 0.f;
            if (i < (size_t)96 * 32 * 4096) { const unsigned u = __hip_atomic_load(KVu + i, __ATOMIC_RELAXED, __HIP_MEMORY_SCOPE_AGENT); v = bflo(u) + 2.0f * bfhi(u); }
            p.out[i] = v; }
        return; }
    if (DIAG == 44 || DIAG == 45 || DIAG == 46) { const bf16_t* KV = (const bf16_t*)(ws + WS_A);
        for (size_t i = (size_t)blockIdx.x * 512 + threadIdx.x; i < (size_t)NTOK * DM; i += (size_t)gridDim.x * 512) p.out[i] = (i < (size_t)96 * 32 * 2 * 4096) ? bf1(KV[i]) : 0.f;
        return; }
    phase_e(p, lds);
    gsync(p, 5);
    if (DIAG == 5) { const bf16_t* Yc = (const bf16_t*)(ws + WS_C);
        for (size_t i = (size_t)blockIdx.x * 512 + threadIdx.x; i < (size_t)NTOK * DM; i += (size_t)gridDim.x * 512) p.out[i] = bf1(Yc[(i & ~(size_t)1023) + (i & 511)]);
        return; }
    if (DIAG == 55) { const bf16_t* KV = (const bf16_t*)(ws + WS_A);
        for (size_t i = (size_t)blockIdx.x * 512 + threadIdx.x; i < (size_t)NTOK * DM; i += (size_t)gridDim.x * 512) p.out[i] = (i < (size_t)96 * 32 * 2 * 4096) ? bf1(KV[i]) : 0.f;
        return; }
    {
        RoRegs rr;
        if ((int)blockIdx.x < 96 * 16) ret_out_load(p, blockIdx.x, opaque_tid(), rr);
#pragma unroll 1
        for (int it = blockIdx.x; it < 96 * 16; it += gridDim.x) { const int nx = it + (int)gridDim.x; ret_out_pair(p, lds, it, rr, nx < 96 * 16 ? nx : -1); }
    }
    gsync(p, 6);
    if (DIAG == 6) { diag_dump_bf16(p, (const bf16_t*)(ws + WS_C)); return; }
    {
        pg8::Gemm g{(const bf16_t*)(ws + WS_C), (const bf16_t*)(ws + WS_WOUT), NTOK, DM, DM, 0};
        EpiOut E{(bf16_t*)(ws + WS_A), (float*)(ws + WS_P2), (LAS float*)(lds + 131072)};
        S.init(g.M, g.N, G, c); pg8::gemm_phase(lds, g, S, E);
    }
    gsync(p, 7);
    if (DIAG == 7) { diag_dump_bf16(p, (const bf16_t*)(ws + WS_A)); return; }
    {
        pg8::Gemm g{(const bf16_t*)(ws + WS_A), (const bf16_t*)(ws + WS_WUP), 12 * 17 * 256, UPC, DM, 17};
        EpiFfn E{(bf16_t*)(ws + WS_B), (const float*)(ws + WS_P2), p.in[21], p.in[22], (LAS float*)(lds + 131072)};
        S.init(g.M, g.N, G, c); pg8::gemm_phase(lds, g, S, E);
    }
    gsync(p, 8);
    {
        pg8::Gemm g{(const bf16_t*)(ws + WS_B), (const bf16_t*)(ws + WS_WDN), NTOK, DM, DFF, 0};
        EpiDown E{ws, (const bf16_t*)(ws + WS_A), (float*)(ws + WS_P3)};
        S.init(g.M, g.N, G, c); pg8::gemm_phase(lds, g, S, E);
    }
    gsync(p, 9);
    phase_k(p);
}

extern "C" void kernel_launch(void* const* d_in, const int* in_sizes, int n_in, void* d_out, int out_size, void* d_ws, size_t ws_size, hipStream_t stream) {
    static int grid_blocks = 0;
    if (grid_blocks == 0) {
        if (n_in != 25 || out_size != NTOK * DM || ws_size < WS_END) { fprintf(stderr, "kernel_launch: unexpected shapes (n_in %d out %d ws %zu)\n", n_in, out_size, ws_size); grid_blocks = -1; return; }
        int dev = 0, cus = 0, per_cu = 0;
        hipGetDevice(&dev);
        hipDeviceGetAttribute(&cus, hipDeviceAttributeMultiprocessorCount, dev);
        hipFuncSetAttribute((const void*)fwd_megakernel, hipFuncAttributeMaxDynamicSharedMemorySize, LDS_BYTES);
        hipOccupancyMaxActiveBlocksPerMultiprocessor(&per_cu, (const void*)fwd_megakernel, 512, LDS_BYTES);
        if (per_cu < 1) { fprintf(stderr, "kernel_launch: occupancy query reports %d blocks per CU\n", per_cu); grid_blocks = -1; return; }
        if (per_cu > 1) per_cu = 1;
        grid_blocks = cus * per_cu;
    }
    if (grid_blocks < 0) return;
    Params p{};
    for (int i = 0; i < 25; ++i) p.in[i] = (const float*)d_in[i];
    p.out = (float*)d_out; p.ws = (unsigned char*)d_ws;
    void* args[] = {&p};
    hipError_t e = hipLaunchCooperativeKernel((const void*)fwd_megakernel, dim3(grid_blocks), dim3(512), args, LDS_BYTES, stream);
    if (e != hipSuccess) fprintf(stderr, "cooperative launch failed: %s (grid %d)\n", hipGetErrorString(e), grid_blocks);
}
```

```cpp
#include <hip/hip_runtime.h>
#include <hip/hip_cooperative_groups.h>
#include <cstdio>
namespace cg = cooperative_groups;

#define LAS __attribute__((address_space(3)))
typedef unsigned short bf16_t;
typedef short bf16x8 __attribute__((ext_vector_type(8)));
typedef float f32x4 __attribute__((ext_vector_type(4)));
typedef unsigned u32x4 __attribute__((ext_vector_type(4)));
typedef unsigned u32x2 __attribute__((ext_vector_type(2)));

constexpr int NTOK = 49152, NTOK_P = 32768, DM = 1024, SEQL = 4096, NBATCH = 12;
constexpr int HCOLS = 1536, RCOLS = 2048, DFF = 2816, UPC = 5632;
constexpr int GROUP_TOK = 16384;
constexpr size_t MiB = 1u << 20;
constexpr size_t WS_WIN = 0, WS_WOUT = 7 * MiB, WS_WUP = 9 * MiB, WS_WDN = 20 * MiB;
constexpr size_t WS_A = 26 * MiB;
constexpr size_t WS_B = 122 * MiB;
constexpr size_t WS_C = 250 * MiB;
constexpr size_t WS_D = 394 * MiB;
constexpr size_t WS_S = 466 * MiB;
constexpr size_t WS_RS1 = WS_S, WS_CS = WS_S + 1 * MiB, WS_H3T = WS_S + 2 * MiB, WS_P2 = WS_S + 3 * MiB, WS_P3 = WS_S + 6 * MiB, WS_BAR = WS_S + 9 * MiB, WS_END = 492 * MiB;
constexpr size_t WS_W4T = WS_S + 9 * MiB + 4096;
constexpr size_t WS_KV = WS_B + 32 * MiB;
constexpr size_t WS_Y1 = 386 * MiB, WS_Y2 = 476 * MiB; constexpr int Y_SPLIT = 40960;
constexpr int LDS_BYTES = 139264;
constexpr float EPS = 1e-6f;
#ifndef USE_CG_SYNC
#define USE_CG_SYNC 1
#endif
#ifndef PROBE
#define PROBE 0
#endif
#ifndef DIAG
#define DIAG 0
#endif

struct Params { const float* in[25]; float* out; unsigned char* ws; };

typedef __bf16 bf16v2 __attribute__((ext_vector_type(2)));
typedef float f32v2 __attribute__((ext_vector_type(2)));
__device__ __forceinline__ unsigned pk2(float lo, float hi) { f32v2 v = {lo, hi}; bf16v2 b = __builtin_convertvector(v, bf16v2); return __builtin_bit_cast(unsigned, b); }
__device__ __forceinline__ float bflo(unsigned u) { return __uint_as_float(u << 16); }
__device__ __forceinline__ float bfhi(unsigned u) { return __uint_as_float(u & 0xffff0000u); }
__device__ __forceinline__ float bf1(bf16_t b) { return __uint_as_float(((unsigned)b) << 16); }
__device__ __forceinline__ float wave_sum(float v) {
#pragma unroll
    for (int o = 1; o < 64; o <<= 1) v += __shfl_xor(v, o);
    return v;
}
__device__ __forceinline__ int opaque_tid() { int t = threadIdx.x; asm volatile("" : "+v"(t)); return t; }
template <int CTRL> __device__ __forceinline__ float dppf(float x) { return __builtin_bit_cast(float, __builtin_amdgcn_update_dpp(0, __builtin_bit_cast(int, x), CTRL, 0xF, 0xF, false)); }
__device__ __forceinline__ bf16_t* y_row(unsigned char* ws, int row) { return (row < Y_SPLIT) ? (bf16_t*)(ws + WS_Y1) + (size_t)row * DM : (bf16_t*)(ws + WS_Y2) + (size_t)(row - Y_SPLIT) * DM; }
#define LDS_WAIT() asm volatile("s_waitcnt lgkmcnt(0)" ::: "memory")

namespace pg8 {
constexpr int BM = 256, BK = 64, HALF = 128, HTB = HALF * BK * 2, NXCD = 8, WGM = 4;
__device__ __forceinline__ int lds_byte(int r, int c) { const int st = (r >> 4) * 2 + (c >> 5), rr = r & 15, cc = c & 31, ob = rr * 64 + cc * 2; return st * 1024 + (ob ^ (((ob >> 9) & 1) << 5)); }
__device__ __forceinline__ void stage_rc(int b, int& R, int& C) { const int st = b / 1024, sb = b % 1024, swz = sb ^ (((sb >> 9) & 1) << 5); R = (st >> 1) * 16 + swz / 64; C = (st & 1) * 32 + (swz % 64) / 2; }
__device__ __forceinline__ int perm32(int rho) { const int n = rho >> 4, i = rho & 15; return 8 * (i >> 2) + 4 * n + (i & 3); }
struct Unit { int pm, pn; };
struct Gemm { const bf16_t* A; const bf16_t* Bt; int M, N, K; int mtps; };
__device__ __forceinline__ long a_row0(const Gemm& g, int pm) { return g.mtps ? ((long)(pm / g.mtps) * 4096 + (long)(pm % g.mtps) * 254 - 1) : (long)pm * 256; }
struct StaticOrder {
    int nM, nN, nwg, G, c, wgm;
    __device__ void init(int M, int N, int G_, int c_, int wgm_ = WGM) { nM = M / BM; nN = N / BM; nwg = nM * nN; G = G_; c = c_; wgm = wgm_; }
    __device__ bool next(int i, Unit& u) const {
        const long L = (long)i * G + c; if (L >= nwg) return false;
        int wgid = (int)L; { const int q = nwg / NXCD, r = nwg % NXCD, xcd = wgid % NXCD, off = wgid / NXCD; wgid = (xcd < r ? xcd * (q + 1) : r * (q + 1) + (xcd - r) * q) + off; }
        const int nig = wgm * nN, gid = wgid / nig, fm = gid * wgm, gsz = (nM - fm) < wgm ? (nM - fm) : wgm;
        u.pm = fm + ((wgid % nig) % gsz); u.pn = (wgid % nig) / gsz; return true;
    }
};
template <class Epi>
__device__ __forceinline__ void gemm_phase(LAS unsigned char* lds, const Gemm g, const StaticOrder& S, const Epi& E) {
    const int tid = opaque_tid(), wid = __builtin_amdgcn_readfirstlane(tid >> 6), lane = tid & 63, wr = wid >> 2, wc = wid & 3, fr = lane & 15, fq = lane >> 4;
    const int K = g.K, nt = K / BK;
    unsigned voffA[2]; int voffB[2], voffB1[2];
#pragma unroll
    for (int i = 0; i < 2; ++i) { int R, C; stage_rc(tid * 16 + i * 8192, R, C);
        int Rb = R, Rb1 = R;
        if (Epi::BMAP == 1) { Rb = (R & ~31) + perm32(R & 31); Rb1 = Rb; }
        if (Epi::BMAP == 2) { Rb = (R & ~0x30) | ((R & 0x10) << 1) | ((R & 0x20) >> 1); Rb1 = Rb; }
        if (Epi::BMAP == 3) { Rb = 64 * (R >> 5) + perm32(R & 31); Rb1 = Rb + 32 - 128; }
        voffA[i] = (unsigned)(R * K + C) * 2u; voffB[i] = (Rb * K + C) * 2; voffB1[i] = (Rb1 * K + C) * 2; }
    const size_t kstep = (size_t)(BK * 2);
    const size_t hstep = (size_t)HALF * K * 2;
    const size_t tstep = 2 * hstep;
    const unsigned ldsw = (unsigned)wid * 1024u;
    const int aoff = lds_byte(wr * 64 + fr, fq * 8), boff = lds_byte(wc * 32 + fr, fq * 8);
#define PG8_SA(b, h) (((b) * 2 + (h)) * HTB)
#define PG8_SB(b, h) ((4 + (b) * 2 + (h)) * HTB)
#define PG8_STAGE(bufoff, gbase, voff) do { _Pragma("unroll") for (int _i = 0; _i < 2; ++_i) \
        __builtin_amdgcn_global_load_lds((const unsigned*)((const char*)(gbase) + (long)(voff)[_i]), (LAS unsigned*)(lds + (bufoff) + ldsw + _i * 8192), 16, 0, 0); } while (0)
#define PG8_LDA(dst, b, h) do { _Pragma("unroll") for (int m = 0; m < 4; ++m) _Pragma("unroll") for (int k = 0; k < 2; ++k) dst[m][k] = *(const LAS bf16x8*)(lds + PG8_SA(b, h) + aoff + m * 2048 + k * 1024); } while (0)
#define PG8_LDB(dst, b, h) do { _Pragma("unroll") for (int n = 0; n < 2; ++n) _Pragma("unroll") for (int k = 0; k < 2; ++k) dst[n][k] = *(const LAS bf16x8*)(lds + PG8_SB(b, h) + boff + n * 2048 + k * 1024); } while (0)
#define PG8_MMA(ai, bj, At, Bt) do { __builtin_amdgcn_s_setprio(1); _Pragma("unroll") for (int m = 0; m < 4; ++m) _Pragma("unroll") for (int n = 0; n < 2; ++n) _Pragma("unroll") for (int k = 0; k < 2; ++k) \
        acc[ai][bj][m][n] = __builtin_amdgcn_mfma_f32_16x16x32_bf16(Bt[n][k], At[m][k], acc[ai][bj][m][n], 0, 0, 0); __builtin_amdgcn_s_setprio(0); } while (0)
#define PG8_WAIT_V(n) asm volatile("s_waitcnt vmcnt(" #n ")" ::: "memory")
#define PG8_WAIT_L(n) asm volatile("s_waitcnt lgkmcnt(" #n ")" ::: "memory")
#define PG8_BAR __builtin_amdgcn_s_barrier()
#define PG8_SCHED __builtin_amdgcn_sched_barrier(0)
    Unit cur, nxt; int ui = 0;
    if (!S.next(0, cur)) return;
    f32x4 acc[2][2][4][2];
#pragma unroll
    for (int a = 0; a < 2; ++a)
#pragma unroll
        for (int b = 0; b < 2; ++b)
#pragma unroll
            for (int m = 0; m < 4; ++m)
#pragma unroll
                for (int n = 0; n < 2; ++n) acc[a][b][m][n] = (f32x4){0.f, 0.f, 0.f, 0.f};
    bf16x8 At[4][2], B0[2][2], B1[2][2];
    const char* cA = (const char*)g.A + a_row0(g, cur.pm) * (long)K * 2; const char* cB = (const char*)g.Bt + (size_t)cur.pn * tstep;
    PG8_STAGE(PG8_SB(0, 0), cB, voffB); PG8_STAGE(PG8_SA(0, 0), cA, voffA); PG8_STAGE(PG8_SB(0, 1), cB + hstep, voffB1); PG8_STAGE(PG8_SA(0, 1), cA + hstep, voffA);
    if (wr == 1) PG8_BAR;
    PG8_WAIT_V(4); PG8_BAR;
    PG8_STAGE(PG8_SB(1, 0), cB + kstep, voffB); PG8_STAGE(PG8_SA(1, 0), cA + kstep, voffA); PG8_STAGE(PG8_SB(1, 1), cB + hstep + kstep, voffB1);
    PG8_WAIT_V(6); PG8_BAR;
    for (;;) {
        const bool has_next = S.next(ui + 1, nxt);
        const char* nA = has_next ? (const char*)g.A + a_row0(g, nxt.pm) * (long)K * 2 : cA; const char* nB = has_next ? (const char*)g.Bt + (size_t)nxt.pn * tstep : cB;
        for (int t = 0; t < nt; t += 2) {
            const bool last = (t == nt - 2);
            const char* a1 = cA + (size_t)(t + 1) * kstep;
            const char* a2 = last ? nA : cA + (size_t)(t + 2) * kstep; const char* b2 = last ? nB : cB + (size_t)(t + 2) * kstep;
            const char* a3 = a2 + kstep; const char* b3 = b2 + kstep;
            PG8_LDB(B0, 0, 0); PG8_SCHED; PG8_LDA(At, 0, 0); PG8_STAGE(PG8_SA(1, 1), a1 + hstep, voffA);
            PG8_WAIT_L(8); PG8_BAR; PG8_WAIT_L(0); PG8_MMA(0, 0, At, B0); PG8_BAR; PG8_SCHED;
            PG8_LDB(B1, 0, 1); PG8_STAGE(PG8_SB(0, 0), b2, voffB);
            PG8_BAR; PG8_WAIT_L(0); PG8_MMA(0, 1, At, B1); PG8_BAR;
            PG8_LDA(At, 0, 1); PG8_STAGE(PG8_SA(0, 0), a2, voffA);
            PG8_BAR; PG8_WAIT_L(0); PG8_MMA(1, 0, At, B0); PG8_BAR; PG8_SCHED;
            PG8_STAGE(PG8_SB(0, 1), b2 + hstep, voffB1);
            PG8_WAIT_V(6); PG8_BAR; PG8_MMA(1, 1, At, B1); PG8_BAR;
            PG8_LDB(B0, 1, 0); PG8_SCHED; PG8_LDA(At, 1, 0); PG8_STAGE(PG8_SA(0, 1), a2 + hstep, voffA);
            PG8_WAIT_L(8); PG8_BAR; PG8_WAIT_L(0); PG8_MMA(0, 0, At, B0); PG8_BAR; PG8_SCHED;
            PG8_LDB(B1, 1, 1); PG8_STAGE(PG8_SB(1, 0), b3, voffB);
            PG8_BAR; PG8_WAIT_L(0); PG8_MMA(0, 1, At, B1); PG8_BAR;
            PG8_LDA(At, 1, 1); PG8_STAGE(PG8_SA(1, 0), a3, voffA);
            PG8_BAR; PG8_WAIT_L(0); PG8_MMA(1, 0, At, B0); PG8_BAR; PG8_SCHED;
            PG8_STAGE(PG8_SB(1, 1), b3 + hstep, voffB1);
            PG8_WAIT_V(6); PG8_BAR; PG8_MMA(1, 1, At, B1); PG8_BAR;
        }
        if (wr == 0) PG8_BAR;
        E(acc, cur, wr, wc, fr, fq);
        if (wr == 1) PG8_BAR;
        if (!has_next) break;
#pragma unroll
        for (int a = 0; a < 2; ++a)
#pragma unroll
            for (int b = 0; b < 2; ++b)
#pragma unroll
                for (int m = 0; m < 4; ++m)
#pragma unroll
                    for (int n = 0; n < 2; ++n) acc[a][b][m][n] = (f32x4){0.f, 0.f, 0.f, 0.f};
        cur = nxt; cA = nA; cB = nB; ++ui;
    }
    PG8_WAIT_V(0);
    if (wr == 0) PG8_BAR;
    PG8_BAR;
#undef PG8_SA
#undef PG8_SB
#undef PG8_STAGE
#undef PG8_LDA
#undef PG8_LDB
#undef PG8_MMA
#undef PG8_WAIT_V
#undef PG8_WAIT_L
#undef PG8_BAR
#undef PG8_SCHED
}
}
using pg8::Unit; using pg8::HALF; using pg8::BM;

struct EpiHy {
    static constexpr int BMAP = 1;
    bf16_t* O; const float* rs1;
    __device__ __forceinline__ void operator()(f32x4 (&acc)[2][2][4][2], const Unit& u, int wr, int wc, int fr, int fq) const {
        const int row0 = u.pm * BM + wr * 64 + fr, col0 = u.pn * BM + wc * 32 + 8 * fq;
        f32x4 sc[2][2];
#pragma unroll
        for (int bj = 0; bj < 2; ++bj) { sc[bj][0] = *(const f32x4*)(rs1 + col0 + bj * HALF); sc[bj][1] = *(const f32x4*)(rs1 + col0 + bj * HALF + 4); }
#pragma unroll
        for (int bj = 0; bj < 2; ++bj) {
#pragma unroll
            for (int ai = 0; ai < 2; ++ai)
#pragma unroll
                for (int m = 0; m < 4; ++m) {
                    const f32x4 v0 = acc[ai][bj][m][0] * sc[bj][0], v1 = acc[ai][bj][m][1] * sc[bj][1];
                    u32x4 o; o.x = pk2(v0[0], v0[1]); o.y = pk2(v0[2], v0[3]); o.z = pk2(v1[0], v1[1]); o.w = pk2(v1[2], v1[3]);
                    *(u32x4*)(O + (size_t)(row0 + ai * HALF + m * 16) * NTOK + col0 + bj * HALF) = o;
                }
        }
    }
};
struct EpiRet {
    static constexpr int BMAP = 3;
    bf16_t* O; const float* rs1; const float* cs;
    __device__ __forceinline__ void operator()(f32x4 (&acc)[2][2][4][2], const Unit& u, int wr, int wc, int fr, int fq) const {
        const int row0 = u.pm * BM + wr * 64 + fr;
        const bool rot = u.pn < 4; const float ksc = (u.pn >= 2 && u.pn < 4) ? 0.125f : 1.0f;
#pragma unroll
        for (int ai = 0; ai < 2; ++ai) {
            f32x4 cv[4][2], sv[4][2]; float rsv[4];
#pragma unroll
            for (int m = 0; m < 4; ++m) {
                const int row = row0 + ai * HALF + m * 16;
                rsv[m] = rs1[row];
                const float* cp = cs + (size_t)(row & (SEQL - 1)) * 64 + 8 * fq;
                cv[m][0] = *(const f32x4*)cp; cv[m][1] = *(const f32x4*)(cp + 4); sv[m][0] = *(const f32x4*)(cp + 32); sv[m][1] = *(const f32x4*)(cp + 36);
            }
            if (!rot) {
#pragma unroll
                for (int m = 0; m < 4; ++m) { cv[m][0] = cv[m][1] = (f32x4){1.f, 1.f, 1.f, 1.f}; sv[m][0] = sv[m][1] = (f32x4){0.f, 0.f, 0.f, 0.f}; }
            }
#pragma unroll
            for (int m = 0; m < 4; ++m) {
                const int row = row0 + ai * HALF + m * 16;
                const float rs = rsv[m] * ksc;
                u32x4 a, b2;
                {
                    const f32x4 x1 = acc[ai][0][m][0] * rs, x2 = acc[ai][1][m][0] * rs;
                    const f32x4 o1 = x1 * cv[m][0] - x2 * sv[m][0], o2 = x2 * cv[m][0] + x1 * sv[m][0];
                    a.x = pk2(o1[0], o1[1]); a.y = pk2(o1[2], o1[3]); b2.x = pk2(o2[0], o2[1]); b2.y = pk2(o2[2], o2[3]);
                }
                {
                    const f32x4 x1 = acc[ai][0][m][1] * rs, x2 = acc[ai][1][m][1] * rs;
                    const f32x4 o1 = x1 * cv[m][1] - x2 * sv[m][1], o2 = x2 * cv[m][1] + x1 * sv[m][1];
                    a.z = pk2(o1[0], o1[1]); a.w = pk2(o1[2], o1[3]); b2.z = pk2(o2[0], o2[1]); b2.w = pk2(o2[2], o2[3]);
                }
                bf16_t* pp = O + (size_t)row * RCOLS + u.pn * BM + 64 * wc + 8 * fq;
                *(u32x4*)pp = a; *(u32x4*)(pp + 32) = b2;
            }
        }
    }
};
struct EpiOut {
    static constexpr int BMAP = 1;
    bf16_t* O; float* part; LAS float* X;
    __device__ __forceinline__ void operator()(f32x4 (&acc)[2][2][4][2], const Unit& u, int wr, int wc, int fr, int fq) const {
        const int row0 = u.pm * BM + wr * 64 + fr, col0 = u.pn * BM + wc * 32 + 8 * fq;
#pragma unroll
        for (int ai = 0; ai < 2; ++ai) {
            u32x4 xr4[4][2];
#pragma unroll
            for (int m = 0; m < 4; ++m)
#pragma unroll
                for (int bj = 0; bj < 2; ++bj) xr4[m][bj] = *(const u32x4*)(O + (size_t)(row0 + ai * HALF + m * 16) * DM + col0 + bj * HALF);
#pragma unroll
            for (int m = 0; m < 4; ++m) {
                const int row = row0 + ai * HALF + m * 16;
                float ss = 0.f;
#pragma unroll
                for (int bj = 0; bj < 2; ++bj) {
                    u32x4* px = (u32x4*)(O + (size_t)row * DM + col0 + bj * HALF);
                    const u32x4 xr = xr4[m][bj];
                    f32x4 v0 = acc[ai][bj][m][0], v1 = acc[ai][bj][m][1];
                    v0[0] += bflo(xr.x); v0[1] += bfhi(xr.x); v0[2] += bflo(xr.y); v0[3] += bfhi(xr.y);
                    v1[0] += bflo(xr.z); v1[1] += bfhi(xr.z); v1[2] += bflo(xr.w); v1[3] += bfhi(xr.w);
                    ss += v0[0] * v0[0] + v0[1] * v0[1] + v0[2] * v0[2] + v0[3] * v0[3] + v1[0] * v1[0] + v1[1] * v1[1] + v1[2] * v1[2] + v1[3] * v1[3];
                    u32x4 o; o.x = pk2(v0[0], v0[1]); o.y = pk2(v0[2], v0[3]); o.z = pk2(v1[0], v1[1]); o.w = pk2(v1[2], v1[3]);
                    *px = o;
                }
                ss += __shfl_xor(ss, 16); ss += __shfl_xor(ss, 32);
                if (fq == 0) X[(ai * HALF + wr * 64 + m * 16 + fr) * 4 + wc] = ss;
            }
        }
        LDS_WAIT(); __builtin_amdgcn_s_barrier(); asm volatile("" ::: "memory");
        if (wr == 0) {
            const int r = wc * 64 + fq * 16 + fr;
            const f32x4 v = *(LAS const f32x4*)(X + r * 4);
            part[(size_t)(u.pm * BM + r) * 4 + u.pn] = (v[0] + v[1]) + (v[2] + v[3]);
        }
    }
};
struct EpiUp {
    static constexpr int BMAP = 1;
    bf16_t* O; const float* part; int row_base;
    __device__ __forceinline__ void operator()(f32x4 (&acc)[2][2][4][2], const Unit& u, int wr, int wc, int fr, int fq) const {
        const int row0 = u.pm * BM + wr * 64 + fr, col0 = u.pn * BM + wc * 32 + 8 * fq;
#pragma unroll
        for (int ai = 0; ai < 2; ++ai)
#pragma unroll
            for (int m = 0; m < 4; ++m) {
                const int row = row0 + ai * HALF + m * 16;
                const f32x4* pp = (const f32x4*)(part + (size_t)(row + row_base) * 16);
                const f32x4 p0 = pp[0], p1 = pp[1], p2 = pp[2], p3 = pp[3];
                const float ss = ((p0[0] + p0[1]) + (p0[2] + p0[3])) + ((p1[0] + p1[1]) + (p1[2] + p1[3])) + ((p2[0] + p2[1]) + (p2[2] + p2[3])) + ((p3[0] + p3[1]) + (p3[2] + p3[3]));
                const float rs = 1.0f / sqrtf(ss * (1.0f / DM) + EPS);
#pragma unroll
                for (int bj = 0; bj < 2; ++bj) {
                    const f32x4 v0 = acc[ai][bj][m][0] * rs, v1 = acc[ai][bj][m][1] * rs;
                    u32x4 o; o.x = pk2(v0[0], v0[1]); o.y = pk2(v0[2], v0[3]); o.z = pk2(v1[0], v1[1]); o.w = pk2(v1[2], v1[3]);
                    *(u32x4*)(O + (size_t)row * UPC + col0 + bj * HALF) = o;
                }
            }
    }
};

template <int CTRL> __device__ __forceinline__ f32x4 dpp4(f32x4 v) { f32x4 r; r[0] = dppf<CTRL>(v[0]); r[1] = dppf<CTRL>(v[1]); r[2] = dppf<CTRL>(v[2]); r[3] = dppf<CTRL>(v[3]); return r; }
__device__ __forceinline__ f32x4 gelu_fast4(f32x4 x) {
    f32x4 t = x * x; t = t * (-0.10294324f) + (-2.3022082f); t = t * x;
    f32x4 e; e[0] = __builtin_amdgcn_exp2f(t[0]); e[1] = __builtin_amdgcn_exp2f(t[1]); e[2] = __builtin_amdgcn_exp2f(t[2]); e[3] = __builtin_amdgcn_exp2f(t[3]);
    e = e + 1.0f;
    f32x4 r; r[0] = __builtin_amdgcn_rcpf(e[0]); r[1] = __builtin_amdgcn_rcpf(e[1]); r[2] = __builtin_amdgcn_rcpf(e[2]); r[3] = __builtin_amdgcn_rcpf(e[3]);
    return x * r;
}
__device__ __forceinline__ float gelu_fast(float x) {
    const float e = __builtin_amdgcn_exp2f(x * (-2.3022082f + -0.10294324f * x * x));
    return x * __builtin_amdgcn_rcpf(1.0f + e);
}
struct EpiFfn {
    static constexpr int BMAP = 1;
    bf16_t* Gout; const float* part; const float* cw; const float* cb; LAS float* X;
    __device__ __forceinline__ void operator()(f32x4 (&acc)[2][2][4][2], const Unit& u, int wr, int wc, int fr, int fq) const {
        const int seq = u.pm / 17, tbase = (u.pm % 17) * 254 - 1;
        const int colh = u.pn * 128 + wc * 32 + 8 * fq;
        f32x4 pq[2][4];
#pragma unroll
        for (int ai = 0; ai < 2; ++ai)
#pragma unroll
            for (int m = 0; m < 4; ++m) {
                const int t = tbase + 128 * ai + 64 * wr + 16 * m + fr;
                const int tc = t < 0 ? 0 : (t >= SEQL ? SEQL - 1 : t);
                pq[ai][m] = *(const f32x4*)(part + (size_t)(seq * SEQL + tc) * 4);
            }
#pragma unroll
        for (int ai = 0; ai < 2; ++ai)
#pragma unroll
            for (int m = 0; m < 4; ++m) {
                const int t = tbase + 128 * ai + 64 * wr + 16 * m + fr;
                const float ss = (pq[ai][m][0] + pq[ai][m][1]) + (pq[ai][m][2] + pq[ai][m][3]);
                const float rs = (t >= 0 && t < SEQL) ? __builtin_amdgcn_rsqf(ss * (1.0f / DM) + EPS) : 0.f;
#pragma unroll
                for (int bj = 0; bj < 2; ++bj)
#pragma unroll
                    for (int n = 0; n < 2; ++n) acc[ai][bj][m][n] = acc[ai][bj][m][n] * rs;
            }
#pragma unroll
        for (int ai = 0; ai < 2; ++ai)
#pragma unroll
            for (int bj = 0; bj < 2; ++bj)
#pragma unroll
                for (int n = 0; n < 2; ++n) {
                    LAS float* xb = X + ((2 * ai + wr) * 2) * 256 + bj * 128 + wc * 32 + 8 * fq + 4 * n;
                    if (fr == 0) *(LAS f32x4*)xb = acc[ai][bj][0][n];
                    if (fr == 15) *(LAS f32x4*)(xb + 256) = acc[ai][bj][3][n];
                }
        LDS_WAIT(); __builtin_amdgcn_s_barrier(); asm volatile("" ::: "memory");
#pragma unroll
        for (int n = 0; n < 2; ++n) {
            const int ca = colh + 4 * n;
            f32x4 wa[3], wb[3];
#pragma unroll
            for (int k = 0; k < 3; ++k) { wa[k] = *(const f32x4*)(cw + k * UPC + ca); wb[k] = *(const f32x4*)(cw + k * UPC + DFF + ca); }
            const f32x4 ba = *(const f32x4*)(cb + ca), bb = *(const f32x4*)(cb + DFF + ca);
#pragma unroll
            for (int ai = 0; ai < 2; ++ai) {
                const int strip = 2 * ai + wr;
                f32x4 xp[2], xn[2];
#pragma unroll
                for (int bj = 0; bj < 2; ++bj) {
                    LAS const float* xb = X + bj * 128 + wc * 32 + 8 * fq + 4 * n;
                    xp[bj] = (strip > 0) ? *(LAS const f32x4*)(xb + ((strip - 1) * 2 + 1) * 256) : (f32x4){0.f, 0.f, 0.f, 0.f};
                    xn[bj] = (strip < 3) ? *(LAS const f32x4*)(xb + ((strip + 1) * 2) * 256) : (f32x4){0.f, 0.f, 0.f, 0.f};
                }
#pragma unroll
                for (int m = 0; m < 4; ++m) {
                    f32x4 y[2];
#pragma unroll
                    for (int bj = 0; bj < 2; ++bj) {
                        const f32x4 cur = acc[ai][bj][m][n];
                        const f32x4 up = (m > 0) ? acc[ai][bj][m - 1][n] : xp[bj];
                        const f32x4 dn = (m < 3) ? acc[ai][bj][m + 1][n] : xn[bj];
                        f32x4 su, sd;
#pragma unroll
                        for (int j = 0; j < 4; ++j) { su[j] = (fr == 15) ? up[j] : cur[j]; sd[j] = (fr == 0) ? dn[j] : cur[j]; }
                        const f32x4 prev = dpp4<0x121>(su);
                        const f32x4 next = dpp4<0x12F>(sd);
                        y[bj] = bj ? (wb[0] * prev + wb[1] * cur + wb[2] * next + bb) : (wa[0] * prev + wa[1] * cur + wa[2] * next + ba);
                    }
                    const int lr = 128 * ai + 64 * wr + 16 * m + fr, t = tbase + lr;
                    const f32x4 gv = gelu_fast4(y[0]) * y[1];
                    u32x2 o; o.x = pk2(gv[0], gv[1]); o.y = pk2(gv[2], gv[3]);
                    if (lr >= 1 && lr <= 254 && t < SEQL) *(u32x2*)(Gout + (size_t)(seq * SEQL + t) * DFF + ca) = o;
                }
            }
        }
    }
};
struct EpiDown {
    static constexpr int BMAP = 1;
    unsigned char* ws; const bf16_t* X1; float* part;
    __device__ __forceinline__ void operator()(f32x4 (&acc)[2][2][4][2], const Unit& u, int wr, int wc, int fr, int fq) const {
        const int row0 = u.pm * BM + wr * 64 + fr, col0 = u.pn * BM + wc * 32 + 8 * fq;
#pragma unroll
        for (int ai = 0; ai < 2; ++ai) {
            u32x4 xr4[4][2];
#pragma unroll
            for (int m = 0; m < 4; ++m)
#pragma unroll
                for (int bj = 0; bj < 2; ++bj) xr4[m][bj] = *(const u32x4*)(X1 + (size_t)(row0 + ai * HALF + m * 16) * DM + col0 + bj * HALF);
#pragma unroll
            for (int m = 0; m < 4; ++m) {
                const int row = row0 + ai * HALF + m * 16;
                bf16_t* yr = y_row(ws, row);
                float ss = 0.f;
#pragma unroll
                for (int bj = 0; bj < 2; ++bj) {
                    const int col = col0 + bj * HALF;
                    const u32x4 xr = xr4[m][bj];
                    f32x4 v0 = acc[ai][bj][m][0], v1 = acc[ai][bj][m][1];
                    v0[0] += bflo(xr.x); v0[1] += bfhi(xr.x); v0[2] += bflo(xr.y); v0[3] += bfhi(xr.y);
                    v1[0] += bflo(xr.z); v1[1] += bfhi(xr.z); v1[2] += bflo(xr.w); v1[3] += bfhi(xr.w);
                    ss += v0[0] * v0[0] + v0[1] * v0[1] + v0[2] * v0[2] + v0[3] * v0[3] + v1[0] * v1[0] + v1[1] * v1[1] + v1[2] * v1[2] + v1[3] * v1[3];
                    u32x4 o; o.x = pk2(v0[0], v0[1]); o.y = pk2(v0[2], v0[3]); o.z = pk2(v1[0], v1[1]); o.w = pk2(v1[2], v1[3]);
                    *(u32x4*)(yr + col) = o;
                }
                ss += __shfl_xor(ss, 16); ss += __shfl_xor(ss, 32);
                if (fq == 0) part[(size_t)row * 16 + u.pn * 4 + wc] = ss;
            }
        }
    }
};

struct EpiNull { static constexpr int BMAP = 1;
    __device__ __forceinline__ void operator()(f32x4 (&acc)[2][2][4][2], const Unit& u, int wr, int wc, int fr, int fq) const {
        float s = 0.f;
#pragma unroll
        for (int ai = 0; ai < 2; ++ai)
#pragma unroll
            for (int bj = 0; bj < 2; ++bj)
#pragma unroll
                for (int m = 0; m < 4; ++m)
#pragma unroll
                    for (int n = 0; n < 2; ++n) s += acc[ai][bj][m][n][0] + acc[ai][bj][m][n][1] + acc[ai][bj][m][n][2] + acc[ai][bj][m][n][3];
        if (s == 123.456f) *sink = s;
    }
    float* sink; };
template <int UPPERM>
__device__ __forceinline__ void transpose_item(const float* W, const float* gk, int K, int N, bf16_t* WT, LAS float* scr, int item, int lane) {
    const int nblk = N / 32, kb = item / nblk, nb = item % nblk, k0 = 64 * kb, n0 = 32 * nb;
#pragma unroll 16
    for (int i = 0; i < 32; ++i) { const int kk = 2 * i + (lane >> 5); const float s = gk ? gk[k0 + kk] : 1.0f; scr[kk * 33 + (lane & 31)] = W[(size_t)(k0 + kk) * N + n0 + (lane & 31)] * s; }
    LDS_WAIT();
    const int c = lane & 7;
#pragma unroll
    for (int j = 0; j < 4; ++j) { const int n = (lane >> 3) + 8 * j; const LAS float* s = scr + (8 * c) * 33 + n;
        u32x4 o; o.x = pk2(s[0 * 33], s[1 * 33]); o.y = pk2(s[2 * 33], s[3 * 33]); o.z = pk2(s[4 * 33], s[5 * 33]); o.w = pk2(s[6 * 33], s[7 * 33]);
        int nr = n0 + n;
        if (UPPERM) { const int oo = nr < DFF ? nr : nr - DFF; nr = 256 * (oo >> 7) + (oo & 127) + (nr < DFF ? 0 : 128); }
        *(u32x4*)(WT + (size_t)nr * K + k0 + 8 * c) = o; }
    LDS_WAIT();
}
__device__ __forceinline__ void phase_a(const Params& p, LAS unsigned char* lds) {
    const int tid = opaque_tid(), wave = tid >> 6, lane = tid & 63;
    const int gw = blockIdx.x * 8 + wave, NGW = gridDim.x * 8;
    unsigned char* ws = p.ws;
    LAS float* scr = (LAS float*)(lds + wave * 8704);
    constexpr int I_IN = 16 * (3584 / 32), I_OUT = 16 * 32, I_UP = 16 * (UPC / 32), I_DN = (DFF / 64) * 32;
    constexpr int I_T = I_IN + I_OUT + I_UP + I_DN, I_H3 = SEQL, I_X = NTOK;
    for (int it = gw; it < I_T + I_H3; it += NGW) {
        int r = it;
        if (r < I_IN) { transpose_item<0>(p.in[3], p.in[2], DM, 3584, (bf16_t*)(ws + WS_WIN), scr, r, lane); continue; } r -= I_IN;
        if (r < I_OUT) { transpose_item<0>(p.in[18], nullptr, DM, DM, (bf16_t*)(ws + WS_WOUT), scr, r, lane); continue; } r -= I_OUT;
        if (r < I_UP) { transpose_item<1>(p.in[20], p.in[19], DM, UPC, (bf16_t*)(ws + WS_WUP), scr, r, lane); continue; } r -= I_UP;
        if (r < I_DN) { transpose_item<0>(p.in[23], nullptr, DFF, DM, (bf16_t*)(ws + WS_WDN), scr, r, lane); continue; } r -= I_DN;
        if (r < I_H3) {
            const int l = r; const float fl = (float)l;
            float z = 0.f;
            if (lane == 0) z = fl * (1.0f / 4095.0f);
            else if (lane < 33) { const int bi = (lane - 1) & 15; const float band = 1e-4f + (float)bi * ((15.0f - 1e-4f) / 15.0f);
                const float ang = (6.283185307179586f / 4096.0f) * fl * band; z = (lane < 17) ? cosf(ang) : -sinf(ang); }
            const float fr = p.in[12][lane];
            float a = p.in[7][lane];
            for (int e = 0; e < 33; ++e) a += __shfl(z, e) * p.in[6][e * 64 + lane];
            float h = sinf(fr * a);
            a = p.in[9][lane];
            for (int e = 0; e < 64; ++e) a += __shfl(h, e) * p.in[8][e * 64 + lane];
            h = sinf(fr * a);
            a = p.in[11][lane];
            for (int e = 0; e < 64; ++e) a += __shfl(h, e) * p.in[10][e * 64 + lane];
            h = sinf(fr * a);
            ((float*)(ws + WS_H3T))[lane * SEQL + l] = h;
            continue;
        }
        (void)r;
    }
    for (int row0 = gw; row0 < I_X; row0 += 2 * NGW) {
        const int row1 = row0 + NGW; const bool has1 = row1 < I_X;
        const int rr1 = has1 ? row1 : row0;
        const float* xr0 = (row0 < NTOK_P) ? p.in[0] + (size_t)row0 * DM : p.in[1] + (size_t)(row0 - NTOK_P) * DM;
        const float* xr1 = (rr1 < NTOK_P) ? p.in[0] + (size_t)rr1 * DM : p.in[1] + (size_t)(rr1 - NTOK_P) * DM;
        f32x4 v0[4], v1[4]; float s0 = 0.f, s1 = 0.f;
#pragma unroll
        for (int j = 0; j < 4; ++j) { v0[j] = *(const f32x4*)(xr0 + 256 * j + 4 * lane); v1[j] = *(const f32x4*)(xr1 + 256 * j + 4 * lane); }
#pragma unroll
        for (int j = 0; j < 4; ++j) { s0 += v0[j][0] * v0[j][0] + v0[j][1] * v0[j][1] + v0[j][2] * v0[j][2] + v0[j][3] * v0[j][3]; s1 += v1[j][0] * v1[j][0] + v1[j][1] * v1[j][1] + v1[j][2] * v1[j][2] + v1[j][3] * v1[j][3]; }
        s0 = wave_sum(s0); s1 = wave_sum(s1);
        if (lane == 0) { ((float*)(ws + WS_RS1))[row0] = 1.0f / sqrtf(s0 * (1.0f / DM) + EPS); if (has1) ((float*)(ws + WS_RS1))[row1] = 1.0f / sqrtf(s1 * (1.0f / DM) + EPS); }
        bf16_t* xb0 = (bf16_t*)(ws + WS_A) + (size_t)row0 * DM; bf16_t* xb1 = (bf16_t*)(ws + WS_A) + (size_t)rr1 * DM;
#pragma unroll
        for (int j = 0; j < 4; ++j) { u32x2 o; o.x = pk2(v0[j][0], v0[j][1]); o.y = pk2(v0[j][2], v0[j][3]); *(u32x2*)(xb0 + 256 * j + 4 * lane) = o; }
        if (has1) {
#pragma unroll
            for (int j = 0; j < 4; ++j) { u32x2 o; o.x = pk2(v1[j][0], v1[j][1]); o.y = pk2(v1[j][2], v1[j][3]); *(u32x2*)(xb1 + 256 * j + 4 * lane) = o; }
        }
    }
    for (int e = blockIdx.x * 512 + tid; e < 64 * 2048; e += gridDim.x * 512) ((float*)(ws + WS_W4T))[e] = p.in[13][(e & 63) * 2048 + (e >> 6)];
    for (int e = blockIdx.x * 512 + tid; e < SEQL * 32; e += gridDim.x * 512) {
        const int t = e >> 5, i = e & 31;
        const float inv = powf(10000.0f, -(float)(2 * i) / 64.0f);
        const float ang = (float)t * inv;
        float* cs = (float*)(ws + WS_CS) + (size_t)t * 64;
        cs[i] = cosf(ang); cs[32 + i] = sinf(ang);
    }
}
__device__ __forceinline__ void phase_b(const Params& p) {
    const int tid = opaque_tid();
    const float* h3t = (const float*)(p.ws + WS_H3T); const float* w4 = p.in[13];
    float* hft = (float*)(p.ws + WS_D);
    for (int it = blockIdx.x; it < 256 * 8; it += gridDim.x) {
        const int cg8 = it >> 3, l = (it & 7) * 512 + tid, col0 = cg8 * 8;
        float a[8];
#pragma unroll
        for (int j = 0; j < 8; ++j) a[j] = 0.f;
        for (int k = 0; k < 64; ++k) {
            const float hv = h3t[k * SEQL + l];
            const f32x4 w0 = *(const f32x4*)(w4 + k * 2048 + col0), w1 = *(const f32x4*)(w4 + k * 2048 + col0 + 4);
            a[0] += hv * w0[0]; a[1] += hv * w0[1]; a[2] += hv * w0[2]; a[3] += hv * w0[3];
            a[4] += hv * w1[0]; a[5] += hv * w1[1]; a[6] += hv * w1[2]; a[7] += hv * w1[3];
        }
        const float tl = (float)l * (1.0f / 4095.0f);
        const float d0 = -15.350567286626973f, d1 = -3.0701134573253945f;
#pragma unroll
        for (int j = 0; j < 8; ++j) {
            const int c = (col0 + j) & 511;
            const float delta = fabsf(d0 + (float)c * ((d1 - d0) / 511.0f));
            hft[(size_t)(col0 + j) * SEQL + l] = a[j] * expf(-tl * delta);
        }
    }
}
__device__ __forceinline__ void phase_toep(const Params& p) {
    const int tid = opaque_tid();
    const float* hft = (const float*)(p.ws + WS_D); const float* bias = p.in[14];
    bf16_t* T = (bf16_t*)(p.ws + WS_B);
    for (int it = blockIdx.x; it < 2048; it += gridDim.x) {
        const int oc = it >> 1, sh = it & 1;
        const float* hf = hft + (size_t)oc * SEQL; const float* hb = hft + (size_t)(1024 + oc) * SEQL;
        const float bz = bias[oc];
        for (int up = tid; up < 1024; up += 512) {
            float v[8];
#pragma unroll
            for (int j = 0; j < 8; ++j) {
                const int m = 8 * (up - 512) + j + sh, d = -m;
                float x = 0.f;
                if (d >= 0 && d < SEQL) x = hf[d]; else if (d < 0 && d > -SEQL) x = hb[-d];
                if (d == 0) x += bz;
                v[j] = x;
            }
            u32x4 o; o.x = pk2(v[0], v[1]); o.y = pk2(v[2], v[3]); o.z = pk2(v[4], v[5]); o.w = pk2(v[6], v[7]);
            *(u32x4*)(T + ((size_t)it * 1024 + up) * 8) = o;
        }
    }
}

__device__ __forceinline__ void phase_rf(const Params& p) {
    const int tid = opaque_tid();
    const float* h3t = (const float*)(p.ws + WS_H3T); const float* w4t = (const float*)(p.ws + WS_W4T); const float* bias = p.in[14];
    bf16_t* T = (bf16_t*)(p.ws + WS_B);
    const float d0 = -15.350567286626973f, d1 = -3.0701134573253945f;
    for (int q = blockIdx.x; q < 256; q += gridDim.x) {
#pragma unroll 1
        for (int lp = 0; lp < 8; ++lp) {
            const int l = lp * 512 + tid;
            float h[64];
#pragma unroll
            for (int k = 0; k < 64; ++k) h[k] = h3t[k * SEQL + l];
            const float tl = (float)l * (1.0f / 4095.0f);
#pragma unroll 1
            for (int j = 0; j < 4; ++j) {
                const int oc = __builtin_amdgcn_readfirstlane(q * 4 + j), c = oc & 511;
                const float* wf = w4t + (size_t)oc * 64; const float* wb = w4t + (size_t)(1024 + oc) * 64;
                float af = 0.f, ab = 0.f;
#pragma unroll
                for (int k = 0; k < 64; ++k) { af += h[k] * wf[k]; ab += h[k] * wb[k]; }
                const float decay = expf(-tl * fabsf(d0 + (float)c * ((d1 - d0) / 511.0f)));
                af *= decay; ab *= decay;
                if (l == 0) af += bias[oc];
                const bf16_t vf = (bf16_t)(pk2(af, 0.f) & 0xffff), vb = (bf16_t)(pk2(ab, 0.f) & 0xffff);
                bf16_t* T0 = T + (size_t)(oc * 2) * 8192; bf16_t* T1 = T0 + 8192;
                T0[4096 - l] = vf; T1[4095 - l] = vf;
                if (l >= 1) { T0[4096 + l] = vb; T1[4095 + l] = vb; }
                else { T0[0] = 0; T1[8191] = 0; }
            }
        }
    }
}

constexpr int ZS = 4112;
#define MFMA16(a, b, c) __builtin_amdgcn_mfma_f32_16x16x32_bf16(a, b, c, 0, 0, 0)
typedef u32x4 u32x4_a4 __attribute__((aligned(4)));
__device__ __forceinline__ bf16x8 ld_filt(LAS const bf16_t* q) {
    const u32x4 v = *(LAS const u32x4_a4*)q;
    return __builtin_bit_cast(bf16x8, v);
}
__device__ __forceinline__ void hyena_group(LAS const bf16_t* Rl, LAS const bf16_t* Zl, int g, f32x4 (&acc)[16]) {
    bf16x8 Aw[16];
#pragma unroll
    for (int i = 0; i < 16; ++i) { Aw[i] = ld_filt(Rl - 16 * (16 * g + i)); acc[i] = (f32x4){0.f, 0.f, 0.f, 0.f}; }
    bf16x8 Bz = *(LAS const bf16x8*)(Zl);
    for (int q = 0; q < 16; ++q) {
#pragma unroll
        for (int e = 0; e < 8; ++e) {
            const int sg = 8 * q + e;
            const int dn = 16 * g - 2 * ((sg + 1) & 127);
            const bf16x8 Bn = *(LAS const bf16x8*)(Zl + 32 * ((sg + 1) & 127));
            const bf16x8 An0 = ld_filt(Rl - 16 * dn);
            const bf16x8 An1 = ld_filt(Rl - 16 * (dn + 1));
            __builtin_amdgcn_sched_barrier(0);
            __builtin_amdgcn_s_setprio(1);
#pragma unroll
            for (int i = 15; i >= 0; --i) acc[i] = MFMA16(Aw[(i - 2 * e) & 15], Bz, acc[i]);
            __builtin_amdgcn_s_setprio(0);
            __builtin_amdgcn_sched_barrier(0);
            Aw[(14 - 2 * e) & 15] = An0;
            Aw[(15 - 2 * e) & 15] = An1;
            Bz = Bn;
        }
    }
}
__device__ __forceinline__ f32x4 gate4(const bf16_t* raw, int t, float w0, float w1, float w2, float cb) {
    const u32x2 x = *(const u32x2*)(raw + t);
    const float xm0 = bf1(raw[t > 0 ? t - 1 : 0]), xp0 = bf1(raw[t + 4 < SEQL ? t + 4 : SEQL - 1]);
    const float xm = (t > 0) ? xm0 : 0.f, xp = (t + 4 < SEQL) ? xp0 : 0.f;
    const float x0 = bflo(x.x), x1 = bfhi(x.x), x2 = bflo(x.y), x3 = bfhi(x.y);
    f32x4 g;
    g[0] = w0 * xm + w1 * x0 + w2 * x1 + cb; g[1] = w0 * x0 + w1 * x1 + w2 * x2 + cb;
    g[2] = w0 * x1 + w1 * x2 + w2 * x3 + cb; g[3] = w0 * x2 + w1 * x3 + w2 * xp + cb;
    return g;
}
template <int FAKE>
__device__ __forceinline__ void hyena_channel(const Params& p, LAS unsigned char* lds, int c) {
    const int tid = opaque_tid(), wave = tid >> 6, lane = tid & 63, fr = lane & 15, fq = lane >> 4;
    const bf16_t* PhT = (const bf16_t*)(p.ws + WS_C);
    const bf16_t* RFg = (const bf16_t*)(p.ws + WS_B);
    bf16_t* Z2T = (bf16_t*)(p.ws + WS_D);
    const float* cw = p.in[4]; const float* cbv = p.in[5];
    LAS bf16_t* Z = (LAS bf16_t*)lds;
    LAS bf16_t* RF = (LAS bf16_t*)(lds + NBATCH * ZS * 2);
    __syncthreads();
    for (int i = tid; i < 2048; i += 512) *(LAS u32x4*)(RF + 8 * i) = *(const u32x4*)(RFg + (size_t)(0 * 512 + c) * 16384 + 8 * i);
    {
        const float w0 = cw[c], w1 = cw[HCOLS + c], w2 = cw[2 * HCOLS + c], cb = cbv[c];
#pragma unroll 1
        for (int h6 = 0; h6 < 12; h6 += 6) {
        u32x4 xv[6]; bf16_t xm[6], xp[6];
#pragma unroll
        for (int it = 0; it < 6; ++it) {
            const int idx = tid + 512 * (it + h6), b = idx >> 9, t8 = (idx & 511) * 8;
            const bf16_t* base = PhT + (size_t)c * NTOK + b * SEQL + t8;
            xv[it] = *(const u32x4*)base; xm[it] = base[t8 > 0 ? -1 : 0]; xp[it] = base[t8 + 8 < SEQL ? 8 : 7];
        }
#pragma unroll
        for (int it = 0; it < 6; ++it) {
            const int idx = tid + 512 * (it + h6), b = idx >> 9, t8 = (idx & 511) * 8;
            const u32x4 x = xv[it];
            float v[10];
            v[0] = (t8 > 0) ? bf1(xm[it]) : 0.f; v[9] = (t8 + 8 < SEQL) ? bf1(xp[it]) : 0.f;
            v[1] = bflo(x.x); v[2] = bfhi(x.x); v[3] = bflo(x.y); v[4] = bfhi(x.y); v[5] = bflo(x.z); v[6] = bfhi(x.z); v[7] = bflo(x.w); v[8] = bfhi(x.w);
            float o[8];
#pragma unroll
            for (int j = 0; j < 8; ++j) o[j] = w0 * v[j] + w1 * v[j + 1] + w2 * v[j + 2] + cb;
            u32x4 ov; ov.x = pk2(o[0], o[1]); ov.y = pk2(o[2], o[3]); ov.z = pk2(o[4], o[5]); ov.w = pk2(o[6], o[7]);
            *(LAS u32x4*)(Z + b * ZS + t8) = ov;
        }
        }
    }
    __syncthreads();
    const int bb = (fr < NBATCH) ? fr : fr - NBATCH;
    LAS const bf16_t* Rl = (fr & 1) ? RF + 8192 + 4096 + 8 * fq - fr - 1 : RF + 4096 + 8 * fq - fr;
    if (FAKE) Rl = RF + 4096 + 8 * fq - 16;
    LAS const bf16_t* Zl = Z + bb * ZS + 8 * fq;
    f32x4 acc[16];
    {
        const int gc = 512 + c;
        const float w0 = cw[gc], w1 = cw[HCOLS + gc], w2 = cw[2 * HCOLS + gc], cb = cbv[gc];
        const bf16_t* raw = PhT + (size_t)gc * NTOK + bb * SEQL;
#pragma unroll 1
        for (int gi = 0; gi < 2; ++gi) {
            const int g = wave + 8 * gi;
            hyena_group(Rl, Zl, g, acc);
            f32x4 gts[16];
#pragma unroll
            for (int i = 0; i < 16; ++i) gts[i] = gate4(raw, 256 * g + 16 * i + 4 * fq, w0, w1, w2, cb);
#pragma unroll
            for (int i = 0; i < 16; ++i) {
                const int t = 256 * g + 16 * i + 4 * fq;
                const f32x4 zz = gts[i] * acc[i];
                u32x2 o; o.x = pk2(zz[0], zz[1]); o.y = pk2(zz[2], zz[3]);
                if (fr < NBATCH && (!FAKE || zz[0] == 123.4567f)) *(u32x2*)(Z2T + (size_t)c * NTOK + fr * SEQL + t) = o;
            }
        }
    }
    __threadfence();
    __syncthreads();
    for (int i = tid; i < 2048; i += 512) *(LAS u32x4*)(RF + 8 * i) = *(const u32x4*)(RFg + (size_t)(1 * 512 + c) * 16384 + 8 * i);
#pragma unroll 1
    for (int h6 = 0; h6 < 12; h6 += 6) {
        u32x4 zv[6];
#pragma unroll
        for (int it = 0; it < 6; ++it) { const int idx = tid + 512 * (it + h6), b = idx >> 9, t8 = (idx & 511) * 8;
            zv[it] = __builtin_nontemporal_load((const u32x4*)(Z2T + (size_t)c * NTOK + b * SEQL + t8)); }
#pragma unroll
        for (int it = 0; it < 6; ++it) { const int idx = tid + 512 * (it + h6), b = idx >> 9, t8 = (idx & 511) * 8; *(LAS u32x4*)(Z + b * ZS + t8) = zv[it]; }
    }
    __syncthreads();
    {
        const int gc = 1024 + c;
        const float w0 = cw[gc], w1 = cw[HCOLS + gc], w2 = cw[2 * HCOLS + gc], cb = cbv[gc];
        const bf16_t* raw = PhT + (size_t)gc * NTOK + bb * SEQL;
#pragma unroll 1
        for (int gi = 0; gi < 2; ++gi) {
            const int g = wave + 8 * gi;
            hyena_group(Rl, Zl, g, acc);
            f32x4 gts[16];
#pragma unroll
            for (int i = 0; i < 16; ++i) gts[i] = gate4(raw, 256 * g + 16 * i + 4 * fq, w0, w1, w2, cb);
#pragma unroll
            for (int i = 0; i < 16; ++i) {
                const int t = 256 * g + 16 * i + 4 * fq;
                const f32x4 zz = gts[i] * acc[i];
                u32x2 o; o.x = pk2(zz[0], zz[1]); o.y = pk2(zz[2], zz[3]);
                if (fr < NBATCH && (!FAKE || zz[0] == 123.4567f)) *(u32x2*)(Z2T + (size_t)c * NTOK + fr * SEQL + t) = o;
            }
        }
    }
}
__device__ __forceinline__ float lg2f_fwd(int h) { return log2f(1.0f - exp2f(-5.0f - (float)h)); }
__device__ __forceinline__ float lg2f_bwd(int h) { return log2f(1.0f - exp2f(-5.5f - (float)h)); }
constexpr int TS = 136;
struct KvRegs { u32x4 kx[2], vx[2]; };
__device__ __forceinline__ void ret_kv_load(const Params& p, int item, int tid, KvRegs& r) {
    const int bh = item >> 5, n = item & 31, b = bh >> 3, h = bh & 7;
    const bf16_t* Pr = (const bf16_t*)p.out;
    const size_t tok0 = (size_t)b * SEQL + n * 128;
#pragma unroll
    for (int q = 0; q < 2; ++q) {
        const int idx = tid + 512 * q, i = idx >> 3, dc = idx & 7;
        r.kx[q] = *(const u32x4*)(Pr + (tok0 + i) * RCOLS + 512 + 64 * h + 8 * dc);
        r.vx[q] = *(const u32x4*)(Pr + (tok0 + i) * RCOLS + 1024 + 64 * h + 8 * dc);
    }
}
__device__ __forceinline__ void ret_kv_item(const Params& p, LAS unsigned char* lds, int item, KvRegs& cur, int nxt_item) {
    const int tid = opaque_tid(), wave = tid >> 6, lane = tid & 63, fr = lane & 15, fq = lane >> 4;
    const int bh = item >> 5, n = item & 31, h = bh & 7;
    bf16_t* KV = (bf16_t*)(p.ws + WS_KV);
    LAS bf16_t* KfT = (LAS bf16_t*)lds; LAS bf16_t* KbT = KfT + 64 * TS; LAS bf16_t* VT = KbT + 64 * TS;
    const float lf = lg2f_fwd(h), lb = lg2f_bwd(h);
    __syncthreads();
#pragma unroll
    for (int q = 0; q < 2; ++q) {
        const int idx = tid + 512 * q, i = idx >> 3, dc = idx & 7;
        const u32x4 kx = cur.kx[q], vx = cur.vx[q];
        const float df = __builtin_amdgcn_exp2f((float)(127 - i) * lf), db = __builtin_amdgcn_exp2f((float)i * lb);
        const unsigned kk[4] = {kx.x, kx.y, kx.z, kx.w}, vv[4] = {vx.x, vx.y, vx.z, vx.w};
#pragma unroll
        for (int j = 0; j < 4; ++j) {
            const float k0 = bflo(kk[j]), k1 = bfhi(kk[j]);
            const unsigned f = pk2(k0 * df, k1 * df), bw = pk2(k0 * db, k1 * db);
            KfT[(8 * dc + 2 * j) * TS + i] = (bf16_t)(f & 0xffff); KfT[(8 * dc + 2 * j + 1) * TS + i] = (bf16_t)(f >> 16);
            KbT[(8 * dc + 2 * j) * TS + i] = (bf16_t)(bw & 0xffff); KbT[(8 * dc + 2 * j + 1) * TS + i] = (bf16_t)(bw >> 16);
            VT[(8 * dc + 2 * j) * TS + i] = (bf16_t)(vv[j] & 0xffff); VT[(8 * dc + 2 * j + 1) * TS + i] = (bf16_t)(vv[j] >> 16);
        }
    }
    if (nxt_item >= 0) ret_kv_load(p, nxt_item, tid, cur);
    __syncthreads();
    const int dir = wave >> 2, dt = wave & 3;
    LAS const bf16_t* KT = dir ? KbT : KfT;
    bf16x8 A[4];
#pragma unroll
    for (int kk = 0; kk < 4; ++kk) A[kk] = *(LAS const bf16x8*)(KT + (16 * dt + fr) * TS + 32 * kk + 8 * fq);
    bf16_t* dst = KV + ((size_t)(bh * 32 + n) * 2 + dir) * 4096;
#pragma unroll
    for (int et = 0; et < 4; ++et) {
        f32x4 o = (f32x4){0.f, 0.f, 0.f, 0.f};
#pragma unroll
        for (int kk = 0; kk < 4; ++kk) { const bf16x8 B = *(LAS const bf16x8*)(VT + (16 * et + fr) * TS + 32 * kk + 8 * fq); o = MFMA16(A[kk], B, o); }
        u32x2 w; w.x = pk2(o[0], o[1]); w.y = pk2(o[2], o[3]);
        *(u32x2*)(dst + (16 * et + fr) * 64 + 16 * dt + 4 * fq) = w;
    }
}

__device__ __forceinline__ void ret_kv_item_simple(const Params& p, int item) {
    const int bh = item >> 5, n = item & 31, b = bh >> 3, h = bh & 7;
    const bf16_t* Pr = (const bf16_t*)p.out;
    bf16_t* KV = (bf16_t*)(p.ws + WS_KV);
    const float lf = lg2f_fwd(h), lb = lg2f_bwd(h);
    const size_t tok0 = (size_t)b * SEQL + n * 128;
    for (int o = threadIdx.x; o < 8192; o += 512) {
        const int dir = o >> 12, e = (o >> 6) & 63, d = o & 63;
        float a = 0.f;
        for (int i = 0; i < 128; ++i) {
            const float dec = dir ? exp2f((float)i * lb) : exp2f((float)(127 - i) * lf);
            const float kq = bf1((bf16_t)(pk2(bf1(Pr[(tok0 + i) * RCOLS + 512 + 64 * h + d]) * dec, 0.f) & 0xffff));
            a += kq * bf1(Pr[(tok0 + i) * RCOLS + 1024 + 64 * h + e]);
        }
        KV[((size_t)(bh * 32 + n) * 2 + dir) * 4096 + e * 64 + d] = (bf16_t)(pk2(a, 0.f) & 0xffff);
    }
}
__device__ __forceinline__ void phase_d(const Params& p, LAS unsigned char* lds) {
    if (DIAG != 45 && DIAG != 47 && DIAG != 46) {
#pragma unroll 1
        for (int c = blockIdx.x; c < 512; c += gridDim.x) hyena_channel<0>(p, lds, c);
        if (PROBE == 6) { for (int c = blockIdx.x; c < 512; c += gridDim.x) hyena_channel<1>(p, lds, c); }
        if (PROBE == 1) { for (int c = blockIdx.x; c < 512; c += gridDim.x) hyena_channel<0>(p, lds, c); }
    }
    if (DIAG == 46) { for (int it = blockIdx.x; it < 96 * 32; it += gridDim.x) ret_kv_item_simple(p, it); return; }
    {
        KvRegs kr;
        if ((int)blockIdx.x < 96 * 32) ret_kv_load(p, blockIdx.x, opaque_tid(), kr);
#pragma unroll 1
        for (int it = blockIdx.x; it < 96 * 32; it += gridDim.x) { const int nx = it + (int)gridDim.x; ret_kv_item(p, lds, it, kr, nx < 96 * 32 ? nx : -1); }
    }
}

__device__ __forceinline__ void phase_e(const Params& p, LAS unsigned char* lds) {
    const int tid = opaque_tid(), wave = tid >> 6, lane = tid & 63;
    {
        bf16_t* KV = (bf16_t*)(p.ws + WS_KV);
        for (int id = blockIdx.x * 512 + tid; id < 96 * 2 * 512; id += gridDim.x * 512) {
            const int e8 = id & 511, dir = (id >> 9) & 1, bh = id >> 10, h = bh & 7;
            const float cd = exp2f(128.0f * (dir ? lg2f_bwd(h) : lg2f_fwd(h)));
            float s[8];
#pragma unroll
            for (int j = 0; j < 8; ++j) s[j] = 0.f;
            bf16_t* basep = KV + ((size_t)(bh * 32) * 2 + dir) * 4096 + e8 * 8;
#pragma unroll 1
            for (int q0 = 0; q0 < 32; q0 += 8) {
                u32x4 kvv[8];
#pragma unroll
                for (int j = 0; j < 8; ++j) { const int n = dir ? 31 - (q0 + j) : (q0 + j); kvv[j] = *(const u32x4*)(basep + (size_t)n * 8192); }
#pragma unroll
                for (int j = 0; j < 8; ++j) {
                    const int n = dir ? 31 - (q0 + j) : (q0 + j);
                    u32x4 o; o.x = pk2(s[0], s[1]); o.y = pk2(s[2], s[3]); o.z = pk2(s[4], s[5]); o.w = pk2(s[6], s[7]);
                    *(u32x4*)(basep + (size_t)n * 8192) = o;
                    const u32x4 kv = kvv[j];
                    s[0] = s[0] * cd + bflo(kv.x); s[1] = s[1] * cd + bfhi(kv.x); s[2] = s[2] * cd + bflo(kv.y); s[3] = s[3] * cd + bfhi(kv.y);
                    s[4] = s[4] * cd + bflo(kv.z); s[5] = s[5] * cd + bfhi(kv.z); s[6] = s[6] * cd + bflo(kv.w); s[7] = s[7] * cd + bfhi(kv.w);
                }
            }
        }
    }
    {
        const bf16_t* Z2T = (const bf16_t*)(p.ws + WS_D);
        bf16_t* Yc = (bf16_t*)(p.ws + WS_C);
        const float* og = p.in[15];
        LAS unsigned* Tl = (LAS unsigned*)lds;
        for (int it = blockIdx.x; it < NTOK / 64; it += gridDim.x) {
            const int tok0 = it * 64;
            __syncthreads();
            {
                const bf16_t* src = Z2T + (size_t)tid * NTOK + tok0;
#pragma unroll
                for (int q = 0; q < 8; ++q) { const u32x4 x = *(const u32x4*)(src + 8 * q);
                    Tl[tid * 33 + 4 * q] = x.x; Tl[tid * 33 + 4 * q + 1] = x.y; Tl[tid * 33 + 4 * q + 2] = x.z; Tl[tid * 33 + 4 * q + 3] = x.w; }
            }
            __syncthreads();
            LAS const bf16_t* Tb = (LAS const bf16_t*)lds;
            float ogv[8];
#pragma unroll
            for (int j = 0; j < 8; ++j) ogv[j] = og[lane + 64 * j];
#pragma unroll 4
            for (int q = 0; q < 8; ++q) {
                const int tt = wave * 8 + q;
                float v[8]; float ss = 0.f;
#pragma unroll
                for (int j = 0; j < 8; ++j) { v[j] = bf1(Tb[(lane + 64 * j) * 66 + tt]); ss += v[j] * v[j]; }
                ss = wave_sum(ss);
                const float rs = 1.0f / sqrtf(ss * (1.0f / 512.0f) + EPS);
#pragma unroll
                for (int j = 0; j < 8; ++j) { const float o = v[j] * rs * ogv[j]; Yc[(size_t)(tok0 + tt) * DM + lane + 64 * j] = (bf16_t)(pk2(o, 0.f) & 0xffff); }
            }
        }
    }
}

struct RoRegs { bf16x8 q[2][2]; u32x4 vx[2][2], kx[2][2], sx[2][2]; };
__device__ __forceinline__ void ret_out_load(const Params& p, int pair, int tid, RoRegs& r) {
    const int wave = tid >> 6, lane = tid & 63, fr = lane & 15, fq = lane >> 4;
    const int bh = pair >> 4, n0 = (pair & 15) * 2, b = bh >> 3, h = bh & 7, t0 = 16 * wave;
    const bf16_t* Pr = (const bf16_t*)p.out;
    const bf16_t* KV = (const bf16_t*)(p.ws + WS_KV);
#pragma unroll
    for (int sub = 0; sub < 2; ++sub) {
        const size_t tok0 = (size_t)b * SEQL + (n0 + sub) * 128;
        const bf16_t* Sf = KV + ((size_t)(bh * 32 + n0 + sub) * 2 + 0) * 4096;
#pragma unroll
        for (int kk = 0; kk < 2; ++kk) r.q[sub][kk] = *(const bf16x8*)(Pr + (tok0 + t0 + fr) * RCOLS + 64 * h + 32 * kk + 8 * fq);
#pragma unroll
        for (int it2 = 0; it2 < 2; ++it2) {
            const int idx = tid + 512 * it2, i = idx >> 3, dc = idx & 7;
            r.vx[sub][it2] = *(const u32x4*)(Pr + (tok0 + i) * RCOLS + 1024 + 64 * h + 8 * dc);
            r.kx[sub][it2] = *(const u32x4*)(Pr + (tok0 + i) * RCOLS + 512 + 64 * h + 8 * dc);
            r.sx[sub][it2] = *(const u32x4*)(Sf + (size_t)idx * 8);
        }
    }
}
__device__ __forceinline__ void ret_out_pair(const Params& p, LAS unsigned char* lds, int pair, RoRegs& cur, int nxt_pair) {
    const int tid = opaque_tid(), wave = tid >> 6, lane = tid & 63, fr = lane & 15, fq = lane >> 4;
    const int bh = pair >> 4, n0 = (pair & 15) * 2, b = bh >> 3, h = bh & 7;
    const bf16_t* Pr = (const bf16_t*)p.out;
    bf16_t* Yc = (bf16_t*)(p.ws + WS_C);
    constexpr int KS = 72;
    constexpr int IMG = 64 * TS + 128 * KS + 128 * KS;
    const float lf = lg2f_fwd(h), lb = lg2f_bwd(h);
    const int t0 = 16 * wave;
    bf16x8 qr2[2][2];
#pragma unroll
    for (int sub = 0; sub < 2; ++sub)
#pragma unroll
        for (int kk = 0; kk < 2; ++kk) qr2[sub][kk] = cur.q[sub][kk];
    __syncthreads();
#pragma unroll
    for (int sub = 0; sub < 2; ++sub) {
        LAS bf16_t* VT = (LAS bf16_t*)lds + sub * IMG; LAS bf16_t* KL = VT + 64 * TS; LAS bf16_t* SL = KL + 128 * KS;
#pragma unroll
        for (int it2 = 0; it2 < 2; ++it2) {
            const int idx = tid + 512 * it2, i = idx >> 3, dc = idx & 7;
            const u32x4 vx = cur.vx[sub][it2];
            *(LAS u32x4*)(KL + i * KS + 8 * dc) = cur.kx[sub][it2];
            *(LAS u32x4*)(SL + (idx >> 3) * KS + 8 * dc) = cur.sx[sub][it2];
            const unsigned vv[4] = {vx.x, vx.y, vx.z, vx.w};
#pragma unroll
            for (int j = 0; j < 4; ++j) { VT[(8 * dc + 2 * j) * TS + i] = (bf16_t)(vv[j] & 0xffff); VT[(8 * dc + 2 * j + 1) * TS + i] = (bf16_t)(vv[j] >> 16); }
        }
    }
    if (nxt_pair >= 0) ret_out_load(p, nxt_pair, tid, cur);
    __syncthreads();
#pragma unroll 1
    for (int sub = 0; sub < 2; ++sub) {
    const size_t tok0 = (size_t)b * SEQL + (n0 + sub) * 128;
    LAS const bf16_t* VT = (LAS const bf16_t*)lds + sub * IMG; LAS const bf16_t* KL = VT + 64 * TS; LAS const bf16_t* SL = KL + 128 * KS;
    bf16x8 qr[2]; qr[0] = sub ? qr2[1][0] : qr2[0][0]; qr[1] = sub ? qr2[1][1] : qr2[0][1];
    bf16_t gates[4][4];
#pragma unroll
    for (int r = 0; r < 4; ++r)
#pragma unroll
        for (int et = 0; et < 4; ++et) gates[r][et] = Pr[(tok0 + t0 + 4 * fq + r) * RCOLS + 1536 + 64 * h + 16 * et + fr];
    f32x4 st[8];
#pragma unroll
    for (int a = 0; a < 8; ++a) {
        st[a] = (f32x4){0.f, 0.f, 0.f, 0.f};
#pragma unroll
        for (int kk = 0; kk < 2; ++kk) { const bf16x8 kr = *(LAS const bf16x8*)(KL + (16 * a + fr) * KS + 32 * kk + 8 * fq); st[a] = MFMA16(kr, qr[kk], st[a]); }
        const int it = t0 + fr;
#pragma unroll
        for (int r = 0; r < 4; ++r) { const int is = 16 * a + 4 * fq + r; const int diff = it - is;
            const float dm = __builtin_amdgcn_exp2f((diff >= 0) ? (float)diff * lf : (float)(-diff) * lb); st[a][r] *= dm; }
    }
    f32x4 oi[4], of[4], ob[4];
#pragma unroll
    for (int et = 0; et < 4; ++et) { oi[et] = (f32x4){0.f, 0.f, 0.f, 0.f}; of[et] = oi[et]; ob[et] = oi[et]; }
#pragma unroll
    for (int kb = 0; kb < 4; ++kb) {
        bf16x8 pa;
        { const unsigned a0 = pk2(st[2 * kb][0], st[2 * kb][1]), a1 = pk2(st[2 * kb][2], st[2 * kb][3]), a2 = pk2(st[2 * kb + 1][0], st[2 * kb + 1][1]), a3 = pk2(st[2 * kb + 1][2], st[2 * kb + 1][3]);
          u32x4 t; t.x = a0; t.y = a1; t.z = a2; t.w = a3; pa = __builtin_bit_cast(bf16x8, t); }
#pragma unroll
        for (int et = 0; et < 4; ++et) {
            const u32x2 v0 = *(LAS const u32x2*)(VT + (16 * et + fr) * TS + 32 * kb + 4 * fq);
            const u32x2 v1 = *(LAS const u32x2*)(VT + (16 * et + fr) * TS + 32 * kb + 16 + 4 * fq);
            u32x4 t; t.x = v0.x; t.y = v0.y; t.z = v1.x; t.w = v1.y;
            oi[et] = MFMA16(pa, __builtin_bit_cast(bf16x8, t), oi[et]);
        }
    }
#pragma unroll
    for (int et = 0; et < 4; ++et)
#pragma unroll
        for (int kk = 0; kk < 2; ++kk) {
            const bf16x8 sf = *(LAS const bf16x8*)(SL + (16 * et + fr) * KS + 32 * kk + 8 * fq);
            const bf16x8 sb = *(LAS const bf16x8*)(SL + (64 + 16 * et + fr) * KS + 32 * kk + 8 * fq);
            of[et] = MFMA16(qr[kk], sf, of[et]); ob[et] = MFMA16(qr[kk], sb, ob[et]);
        }
    const float* gg = p.in[16] + 64 * h; const float* gb = p.in[17] + 64 * h;
#pragma unroll
    for (int r = 0; r < 4; ++r) {
        const int i = t0 + 4 * fq + r;
        const float qdf = __builtin_amdgcn_exp2f((float)(i + 1) * lf), qdb = __builtin_amdgcn_exp2f((float)(128 - i) * lb);
        float o[4]; float s = 0.f;
#pragma unroll
        for (int et = 0; et < 4; ++et) { o[et] = oi[et][r] + qdf * of[et][r] + qdb * ob[et][r]; s += o[et]; }
        s += dppf<0x128>(s); s += dppf<0x124>(s); s += dppf<0x122>(s); s += dppf<0x121>(s);
        const float mu = s * (1.0f / 64.0f);
        float vs = 0.f;
#pragma unroll
        for (int et = 0; et < 4; ++et) { o[et] -= mu; vs += o[et] * o[et]; }
        vs += dppf<0x128>(vs); vs += dppf<0x124>(vs); vs += dppf<0x122>(vs); vs += dppf<0x121>(vs);
        const float rstd = __builtin_amdgcn_rsqf(vs * (1.0f / 64.0f) + EPS);
        const size_t tok = tok0 + i;
#pragma unroll
        for (int et = 0; et < 4; ++et) {
            const int e = 16 * et + fr;
            const float gate = bf1(gates[r][et]);
            const float y = (o[et] * rstd * gg[e] + gb[e]) * (gate * __builtin_amdgcn_rcpf(1.0f + __builtin_amdgcn_exp2f(-1.4426950409f * gate)));
            Yc[tok * DM + 512 + 64 * h + e] = (bf16_t)(pk2(y, 0.f) & 0xffff);
        }
    }
    }
}
__device__ __forceinline__ float gelu_tanh(float x) {
    const float u = 0.7978845608028654f * (x + 0.044715f * x * x * x);
    return x / (1.0f + __expf(-2.0f * u));
}
__device__ __forceinline__ void unpack8(const u32x4 x, float (&v)[8]) {
    v[0] = bflo(x.x); v[1] = bfhi(x.x); v[2] = bflo(x.y); v[3] = bfhi(x.y); v[4] = bflo(x.z); v[5] = bfhi(x.z); v[6] = bflo(x.w); v[7] = bfhi(x.w);
}
__device__ __forceinline__ void phase_i(const Params& p, int g0) {
    const bf16_t* U = (const bf16_t*)p.out;
    bf16_t* G = (bf16_t*)(p.ws + WS_B);
    const float* cw = p.in[21]; const float* cb = p.in[22];
    constexpr int NCH = DFF / 4, RUN = 8;
    const int tid = opaque_tid();
    for (int id = blockIdx.x * 512 + tid; id < (GROUP_TOK / RUN) * NCH; id += gridDim.x * 512) {
        const int cc = id % NCH, run = id / NCH, ca = 4 * cc, cbcol = DFF + 4 * cc;
        const int l0 = run * RUN;
        const int t0 = (g0 + l0) & (SEQL - 1);
        u32x2 ra[RUN + 2], rb[RUN + 2];
#pragma unroll
        for (int q = 0; q < RUN + 2; ++q) {
            const bool valid = (q == 0) ? (t0 > 0) : ((q == RUN + 1) ? (t0 + RUN < SEQL) : true);
            ra[q] = (u32x2){0u, 0u}; rb[q] = (u32x2){0u, 0u};
            if (valid) { const bf16_t* rowp = U + (size_t)(l0 - 1 + q) * UPC; ra[q] = *(const u32x2*)(rowp + ca); rb[q] = *(const u32x2*)(rowp + cbcol); }
        }
        f32x4 wa[3], wb[3];
#pragma unroll
        for (int k = 0; k < 3; ++k) { wa[k] = *(const f32x4*)(cw + k * UPC + ca); wb[k] = *(const f32x4*)(cw + k * UPC + cbcol); }
        const f32x4 ba = *(const f32x4*)(cb + ca), bb = *(const f32x4*)(cb + cbcol);
#pragma unroll
        for (int q = 0; q < RUN; ++q) {
            f32x4 pa, ca_, na, pb, cb_, nb;
            pa[0] = bflo(ra[q].x); pa[1] = bfhi(ra[q].x); pa[2] = bflo(ra[q].y); pa[3] = bfhi(ra[q].y);
            ca_[0] = bflo(ra[q + 1].x); ca_[1] = bfhi(ra[q + 1].x); ca_[2] = bflo(ra[q + 1].y); ca_[3] = bfhi(ra[q + 1].y);
            na[0] = bflo(ra[q + 2].x); na[1] = bfhi(ra[q + 2].x); na[2] = bflo(ra[q + 2].y); na[3] = bfhi(ra[q + 2].y);
            pb[0] = bflo(rb[q].x); pb[1] = bfhi(rb[q].x); pb[2] = bflo(rb[q].y); pb[3] = bfhi(rb[q].y);
            cb_[0] = bflo(rb[q + 1].x); cb_[1] = bfhi(rb[q + 1].x); cb_[2] = bflo(rb[q + 1].y); cb_[3] = bfhi(rb[q + 1].y);
            nb[0] = bflo(rb[q + 2].x); nb[1] = bfhi(rb[q + 2].x); nb[2] = bflo(rb[q + 2].y); nb[3] = bfhi(rb[q + 2].y);
            const f32x4 av = wa[0] * pa + wa[1] * ca_ + wa[2] * na + ba;
            const f32x4 bv = wb[0] * pb + wb[1] * cb_ + wb[2] * nb + bb;
            u32x2 ov; ov.x = pk2(gelu_tanh(av[0]) * bv[0], gelu_tanh(av[1]) * bv[1]); ov.y = pk2(gelu_tanh(av[2]) * bv[2], gelu_tanh(av[3]) * bv[3]);
            *(u32x2*)(G + (size_t)(g0 + l0 + q) * DFF + ca) = ov;
        }
    }
}
__device__ __forceinline__ void phase_k(const Params& p) {
    const int tid = opaque_tid(), wave = tid >> 6, lane = tid & 63;
    const float* part = (const float*)(p.ws + WS_P3); const float* fg = p.in[24];
    f32x4 g[4];
#pragma unroll
    for (int j = 0; j < 4; ++j) g[j] = *(const f32x4*)(fg + 256 * j + 4 * lane);
    const int NGW = gridDim.x * 8;
    for (int row0 = blockIdx.x * 8 + wave; row0 < NTOK; row0 += 2 * NGW) {
        const int row1 = (row0 + NGW < NTOK) ? row0 + NGW : row0;
        float ss0 = (lane < 16) ? part[(size_t)row0 * 16 + lane] : 0.f, ss1 = (lane < 16) ? part[(size_t)row1 * 16 + lane] : 0.f;
        const bf16_t* y0 = y_row(p.ws, row0); const bf16_t* y1 = y_row(p.ws, row1);
        u32x2 v0[4], v1[4];
#pragma unroll
        for (int j = 0; j < 4; ++j) { v0[j] = *(const u32x2*)(y0 + 256 * j + 4 * lane); v1[j] = *(const u32x2*)(y1 + 256 * j + 4 * lane); }
        ss0 = wave_sum(ss0); ss1 = wave_sum(ss1);
        const float rs0 = 1.0f / sqrtf(ss0 * (1.0f / DM) + EPS), rs1 = 1.0f / sqrtf(ss1 * (1.0f / DM) + EPS);
        float* o0 = p.out + (size_t)row0 * DM; float* o1 = p.out + (size_t)row1 * DM;
#pragma unroll
        for (int j = 0; j < 4; ++j) { f32x4 v; v[0] = bflo(v0[j].x); v[1] = bfhi(v0[j].x); v[2] = bflo(v0[j].y); v[3] = bfhi(v0[j].y); *(f32x4*)(o0 + 256 * j + 4 * lane) = v * g[j] * rs0; }
        if (row1 != row0) {
#pragma unroll
            for (int j = 0; j < 4; ++j) { f32x4 v; v[0] = bflo(v1[j].x); v[1] = bfhi(v1[j].x); v[2] = bflo(v1[j].y); v[3] = bfhi(v1[j].y); *(f32x4*)(o1 + 256 * j + 4 * lane) = v * g[j] * rs1; }
        }
    }
}


__device__ __forceinline__ void diag_dump_bf16(const Params& p, const bf16_t* src) {
    for (size_t i = (size_t)blockIdx.x * 512 + threadIdx.x; i < (size_t)NTOK * DM; i += (size_t)gridDim.x * 512) p.out[i] = bf1(src[i]);
}
__device__ __forceinline__ void diag_dump_c(const Params& p) {
    const bf16_t* PhT = (const bf16_t*)(p.ws + WS_C);
    for (size_t i = (size_t)blockIdx.x * 512 + threadIdx.x; i < (size_t)NTOK * DM; i += (size_t)gridDim.x * 512) {
        const unsigned u = ((const unsigned*)p.out)[i]; const size_t tok = i >> 10; const int c = (int)(i & 1023);
        p.out[i] = bflo(u) + bfhi(u) + bf1(PhT[(size_t)c * NTOK + tok]) + bf1(PhT[(size_t)(c + 512) * NTOK + tok]);
    }
}

__device__ __forceinline__ void gsync(const Params& p, int k) {
#if USE_CG_SYNC
    cg::this_grid().sync();
#else
    __syncthreads();
    if (threadIdx.x == 0) {
        unsigned* bar = (unsigned*)(p.ws + WS_BAR);
        const unsigned gen = (unsigned)k * gridDim.x;
        __hip_atomic_fetch_add(bar, 1u, __ATOMIC_RELEASE, __HIP_MEMORY_SCOPE_AGENT);
        while (__hip_atomic_load(bar, __ATOMIC_ACQUIRE, __HIP_MEMORY_SCOPE_AGENT) < gen) __builtin_amdgcn_s_sleep(2);
    }
    __syncthreads();
#endif
}
__global__ void __launch_bounds__(512, 2) fwd_megakernel(Params p) {
    extern __shared__ __attribute__((aligned(16))) unsigned char shm[];
    LAS unsigned char* lds = (LAS unsigned char*)shm;
    unsigned char* ws = p.ws;
    pg8::StaticOrder S;
    const int G = gridDim.x, c = blockIdx.x;

    phase_a(p, lds);
    if (PROBE == 5) { __syncthreads(); phase_a(p, lds); }
    gsync(p, 1);
    phase_rf(p);
    __syncthreads();
#pragma unroll 1
    for (int rep = 0; rep < (PROBE == 2 ? 2 : 1); ++rep) {
    {
        pg8::Gemm g{(const bf16_t*)(ws + WS_WIN), (const bf16_t*)(ws + WS_A), HCOLS, NTOK, DM, 0};
        EpiHy E{(bf16_t*)(ws + WS_C), (const float*)(ws + WS_RS1)};
        S.init(g.M, g.N, G, c); pg8::gemm_phase(lds, g, S, E);
    }
    {
        pg8::Gemm g{(const bf16_t*)(ws + WS_A), (const bf16_t*)(ws + WS_WIN) + (size_t)HCOLS * DM, NTOK, RCOLS, DM, 0};
        EpiRet E{(bf16_t*)p.out, (const float*)(ws + WS_RS1), (const float*)(ws + WS_CS)};
        S.init(g.M, g.N, G, c); pg8::gemm_phase(lds, g, S, E);
    }
    }
    if (PROBE == 7) {
        EpiNull E{(float*)(ws + WS_BAR + 512)};
        pg8::Gemm g{(const bf16_t*)(ws + WS_A), (const bf16_t*)(ws + WS_WUP), 16384, 3072, DM, 0}; S.init(g.M, g.N, G, c); pg8::gemm_phase(lds, g, S, E);
    }
    if (PROBE == 4) {
        EpiNull E{(float*)(ws + WS_BAR + 512)};
        { pg8::Gemm g{(const bf16_t*)(ws + WS_WIN), (const bf16_t*)(ws + WS_A), HCOLS, NTOK, DM, 0}; S.init(g.M, g.N, G, c); pg8::gemm_phase(lds, g, S, E); }
        { pg8::Gemm g{(const bf16_t*)(ws + WS_A), (const bf16_t*)(ws + WS_WIN) + (size_t)HCOLS * DM, NTOK, RCOLS, DM, 0}; S.init(g.M, g.N, G, c); pg8::gemm_phase(lds, g, S, E); }
    }
    gsync(p, 3);
    if (DIAG == 3) { diag_dump_c(p); return; }
    if (DIAG == 32) {
        const bf16_t* Pr = (const bf16_t*)p.out; float* scr = (float*)(ws + WS_D);
        for (int i = blockIdx.x * 512 + threadIdx.x; i < 384 * 2048; i += gridDim.x * 512) {
            const int n = i >> 11, col = i & 2047; float a = 0.f;
            for (int r = 0; r < 128; ++r) a += bf1(Pr[(size_t)(n * 128 + r) * RCOLS + col]) * (float)(1 + (r & 3));
            scr[i] = a; }
        gsync(p, 4);
        for (size_t i = (size_t)blockIdx.x * 512 + threadIdx.x; i < (size_t)NTOK * DM; i += (size_t)gridDim.x * 512) p.out[i] = (i < 384 * 2048) ? scr[i] : 0.f;
        return; }
    phase_d(p, lds);
    gsync(p, 4);
    if (DIAG == 47) { const unsigned* KVu = (const unsigned*)(ws + WS_A);
        for (size_t i = (size_t)blockIdx.x * 512 + threadIdx.x; i < (size_t)NTOK * DM; i += (size_t)gridDim.x * 512) {
            float v = 0.f;
            if (i < (size_t)96 * 32 * 4096) { const unsigned u = __hip_atomic_load(KVu + i, __ATOMIC_RELAXED, __HIP_MEMORY_SCOPE_AGENT); v = bflo(u) + 2.0f * bfhi(u); }
            p.out[i] = v; }
        return; }
    if (DIAG == 44 || DIAG == 45 || DIAG == 46) { const bf16_t* KV = (const bf16_t*)(ws + WS_A);
        for (size_t i = (size_t)blockIdx.x * 512 + threadIdx.x; i < (size_t)NTOK * DM; i += (size_t)gridDim.x * 512) p.out[i] = (i < (size_t)96 * 32 * 2 * 4096) ? bf1(KV[i]) : 0.f;
        return; }
    phase_e(p, lds);
    gsync(p, 5);
    if (DIAG == 5) { const bf16_t* Yc = (const bf16_t*)(ws + WS_C);
        for (size_t i = (size_t)blockIdx.x * 512 + threadIdx.x; i < (size_t)NTOK * DM; i += (size_t)gridDim.x * 512) p.out[i] = bf1(Yc[(i & ~(size_t)1023) + (i & 511)]);
        return; }
    if (DIAG == 55) { const bf16_t* KV = (const bf16_t*)(ws + WS_A);
        for (size_t i = (size_t)blockIdx.x * 512 + threadIdx.x; i < (size_t)NTOK * DM; i += (size_t)gridDim.x * 512) p.out[i] = (i < (size_t)96 * 32 * 2 * 4096) ? bf1(KV[i]) : 0.f;
        return; }
    {
        RoRegs rr;
        if ((int)blockIdx.x < 96 * 16) ret_out_load(p, blockIdx.x, opaque_tid(), rr);
#pragma unroll 1
        for (int it = blockIdx.x; it < 96 * 16; it += gridDim.x) { const int nx = it + (int)gridDim.x; ret_out_pair(p, lds, it, rr, nx < 96 * 16 ? nx : -1); }
    }
    gsync(p, 6);
    if (DIAG == 6) { diag_dump_bf16(p, (const bf16_t*)(ws + WS_C)); return; }
    {
        pg8::Gemm g{(const bf16_t*)(ws + WS_C), (const bf16_t*)(ws + WS_WOUT), NTOK, DM, DM, 0};
        EpiOut E{(bf16_t*)(ws + WS_A), (float*)(ws + WS_P2), (LAS float*)(lds + 131072)};
        S.init(g.M, g.N, G, c); pg8::gemm_phase(lds, g, S, E);
    }
    gsync(p, 7);
    if (DIAG == 7) { diag_dump_bf16(p, (const bf16_t*)(ws + WS_A)); return; }
    {
        pg8::Gemm g{(const bf16_t*)(ws + WS_A), (const bf16_t*)(ws + WS_WUP), 12 * 17 * 256, UPC, DM, 17};
        EpiFfn E{(bf16_t*)(ws + WS_B), (const float*)(ws + WS_P2), p.in[21], p.in[22], (LAS float*)(lds + 131072)};
        S.init(g.M, g.N, G, c, 2); pg8::gemm_phase(lds, g, S, E);
    }
    gsync(p, 8);
    {
        pg8::Gemm g{(const bf16_t*)(ws + WS_B), (const bf16_t*)(ws + WS_WDN), NTOK, DM, DFF, 0};
        EpiDown E{ws, (const bf16_t*)(ws + WS_A), (float*)(ws + WS_P3)};
        S.init(g.M, g.N, G, c); pg8::gemm_phase(lds, g, S, E);
    }
    gsync(p, 9);
    phase_k(p);
}

extern "C" void kernel_launch(void* const* d_in, const int* in_sizes, int n_in, void* d_out, int out_size, void* d_ws, size_t ws_size, hipStream_t stream) {
    static int grid_blocks = 0;
    if (grid_blocks == 0) {
        if (n_in != 25 || out_size != NTOK * DM || ws_size < WS_END) { fprintf(stderr, "kernel_launch: unexpected shapes (n_in %d out %d ws %zu)\n", n_in, out_size, ws_size); grid_blocks = -1; return; }
        int dev = 0, cus = 0, per_cu = 0;
        hipGetDevice(&dev);
        hipDeviceGetAttribute(&cus, hipDeviceAttributeMultiprocessorCount, dev);
        hipFuncSetAttribute((const void*)fwd_megakernel, hipFuncAttributeMaxDynamicSharedMemorySize, LDS_BYTES);
        hipOccupancyMaxActiveBlocksPerMultiprocessor(&per_cu, (const void*)fwd_megakernel, 512, LDS_BYTES);
        if (per_cu < 1) { fprintf(stderr, "kernel_launch: occupancy query reports %d blocks per CU\n", per_cu); grid_blocks = -1; return; }
        if (per_cu > 1) per_cu = 1;
        grid_blocks = cus * per_cu;
    }
    if (grid_blocks < 0) return;
    Params p{};
    for (int i = 0; i < 25; ++i) p.in[i] = (const float*)d_in[i];
    p.out = (float*)d_out; p.ws = (unsigned char*)d_ws;
    void* args[] = {&p};
    hipError_t e = hipLaunchCooperativeKernel((const void*)fwd_megakernel, dim3(grid_blocks), dim3(512), args, LDS_BYTES, stream);
    if (e != hipSuccess) fprintf(stderr, "cooperative launch failed: %s (grid %d)\n", hipGetErrorString(e), grid_blocks);
}
```

```cpp
#include <hip/hip_runtime.h>
#include <hip/hip_cooperative_groups.h>
#include <cstdio>
namespace cg = cooperative_groups;

#define LAS __attribute__((address_space(3)))
typedef unsigned short bf16_t;
typedef short bf16x8 __attribute__((ext_vector_type(8)));
typedef float f32x4 __attribute__((ext_vector_type(4)));
typedef unsigned u32x4 __attribute__((ext_vector_type(4)));
typedef unsigned u32x2 __attribute__((ext_vector_type(2)));

constexpr int NTOK = 49152, NTOK_P = 32768, DM = 1024, SEQL = 4096, NBATCH = 12;
constexpr int HCOLS = 1536, RCOLS = 2048, DFF = 2816, UPC = 5632;
constexpr int GROUP_TOK = 16384;
constexpr size_t MiB = 1u << 20;
constexpr size_t WS_WIN = 0, WS_WOUT = 7 * MiB, WS_WUP = 9 * MiB, WS_WDN = 20 * MiB;
constexpr size_t WS_A = 26 * MiB;
constexpr size_t WS_B = 122 * MiB;
constexpr size_t WS_C = 250 * MiB;
constexpr size_t WS_D = 394 * MiB;
constexpr size_t WS_S = 466 * MiB;
constexpr size_t WS_RS1 = WS_S, WS_CS = WS_S + 1 * MiB, WS_H3T = WS_S + 2 * MiB, WS_P2 = WS_S + 3 * MiB, WS_P3 = WS_S + 6 * MiB, WS_BAR = WS_S + 9 * MiB, WS_END = 492 * MiB;
constexpr size_t WS_W4T = WS_S + 9 * MiB + 4096;
constexpr size_t WS_KV = WS_B + 32 * MiB;
constexpr size_t WS_Y1 = 386 * MiB, WS_Y2 = 476 * MiB; constexpr int Y_SPLIT = 40960;
constexpr int LDS_BYTES = 139264;
constexpr float EPS = 1e-6f;
#ifndef USE_CG_SYNC
#define USE_CG_SYNC 1
#endif
#ifndef PROBE
#define PROBE 0
#endif
#ifndef DIAG
#define DIAG 0
#endif

struct Params { const float* in[25]; float* out; unsigned char* ws; };

typedef __bf16 bf16v2 __attribute__((ext_vector_type(2)));
typedef float f32v2 __attribute__((ext_vector_type(2)));
__device__ __forceinline__ unsigned pk2(float lo, float hi) { f32v2 v = {lo, hi}; bf16v2 b = __builtin_convertvector(v, bf16v2); return __builtin_bit_cast(unsigned, b); }
__device__ __forceinline__ float bflo(unsigned u) { return __uint_as_float(u << 16); }
__device__ __forceinline__ float bfhi(unsigned u) { return __uint_as_float(u & 0xffff0000u); }
__device__ __forceinline__ float bf1(bf16_t b) { return __uint_as_float(((unsigned)b) << 16); }
__device__ __forceinline__ float wave_sum(float v) {
#pragma unroll
    for (int o = 1; o < 64; o <<= 1) v += __shfl_xor(v, o);
    return v;
}
__device__ __forceinline__ int opaque_tid() { int t = threadIdx.x; asm volatile("" : "+v"(t)); return t; }
template <int CTRL> __device__ __forceinline__ float dppf(float x) { return __builtin_bit_cast(float, __builtin_amdgcn_update_dpp(0, __builtin_bit_cast(int, x), CTRL, 0xF, 0xF, false)); }
__device__ __forceinline__ bf16_t* y_row(unsigned char* ws, int row) { return (row < Y_SPLIT) ? (bf16_t*)(ws + WS_Y1) + (size_t)row * DM : (bf16_t*)(ws + WS_Y2) + (size_t)(row - Y_SPLIT) * DM; }
#define LDS_WAIT() asm volatile("s_waitcnt lgkmcnt(0)" ::: "memory")

namespace pg8 {
constexpr int BM = 256, BK = 64, HALF = 128, HTB = HALF * BK * 2, NXCD = 8, WGM = 4;
__device__ __forceinline__ int lds_byte(int r, int c) { const int st = (r >> 4) * 2 + (c >> 5), rr = r & 15, cc = c & 31, ob = rr * 64 + cc * 2; return st * 1024 + (ob ^ (((ob >> 9) & 1) << 5)); }
__device__ __forceinline__ void stage_rc(int b, int& R, int& C) { const int st = b / 1024, sb = b % 1024, swz = sb ^ (((sb >> 9) & 1) << 5); R = (st >> 1) * 16 + swz / 64; C = (st & 1) * 32 + (swz % 64) / 2; }
__device__ __forceinline__ int perm32(int rho) { const int n = rho >> 4, i = rho & 15; return 8 * (i >> 2) + 4 * n + (i & 3); }
struct Unit { int pm, pn; };
struct Gemm { const bf16_t* A; const bf16_t* Bt; int M, N, K; int mtps; };
__device__ __forceinline__ long a_row0(const Gemm& g, int pm) { return g.mtps ? ((long)(pm / g.mtps) * 4096 + (long)(pm % g.mtps) * 254 - 1) : (long)pm * 256; }
struct StaticOrder {
    int nM, nN, nwg, G, c, wgm;
    __device__ void init(int M, int N, int G_, int c_, int wgm_ = WGM) { nM = M / BM; nN = N / BM; nwg = nM * nN; G = G_; c = c_; wgm = wgm_; }
    __device__ bool next(int i, Unit& u) const {
        const long L = (long)i * G + c; if (L >= nwg) return false;
        int wgid = (int)L; { const int q = nwg / NXCD, r = nwg % NXCD, xcd = wgid % NXCD, off = wgid / NXCD; wgid = (xcd < r ? xcd * (q + 1) : r * (q + 1) + (xcd - r) * q) + off; }
        const int nig = wgm * nN, gid = wgid / nig, fm = gid * wgm, gsz = (nM - fm) < wgm ? (nM - fm) : wgm;
        u.pm = fm + ((wgid % nig) % gsz); u.pn = (wgid % nig) / gsz; return true;
    }
};
template <class Epi>
__device__ __forceinline__ void gemm_phase(LAS unsigned char* lds, const Gemm g, const StaticOrder& S, const Epi& E) {
    const int tid = opaque_tid(), wid = __builtin_amdgcn_readfirstlane(tid >> 6), lane = tid & 63, wr = wid >> 2, wc = wid & 3, fr = lane & 15, fq = lane >> 4;
    const int K = g.K, nt = K / BK;
    unsigned voffA[2]; int voffB[2], voffB1[2];
#pragma unroll
    for (int i = 0; i < 2; ++i) { int R, C; stage_rc(tid * 16 + i * 8192, R, C);
        int Rb = R, Rb1 = R;
        if (Epi::BMAP == 1) { Rb = (R & ~31) + perm32(R & 31); Rb1 = Rb; }
        if (Epi::BMAP == 2) { Rb = (R & ~0x30) | ((R & 0x10) << 1) | ((R & 0x20) >> 1); Rb1 = Rb; }
        if (Epi::BMAP == 3) { Rb = 64 * (R >> 5) + perm32(R & 31); Rb1 = Rb + 32 - 128; }
        voffA[i] = (unsigned)(R * K + C) * 2u; voffB[i] = (Rb * K + C) * 2; voffB1[i] = (Rb1 * K + C) * 2; }
    const size_t kstep = (size_t)(BK * 2);
    const size_t hstep = (size_t)HALF * K * 2;
    const size_t tstep = 2 * hstep;
    const unsigned ldsw = (unsigned)wid * 1024u;
    const int aoff = lds_byte(wr * 64 + fr, fq * 8), boff = lds_byte(wc * 32 + fr, fq * 8);
#define PG8_SA(b, h) (((b) * 2 + (h)) * HTB)
#define PG8_SB(b, h) ((4 + (b) * 2 + (h)) * HTB)
#define PG8_STAGE(bufoff, gbase, voff) do { _Pragma("unroll") for (int _i = 0; _i < 2; ++_i) \
        __builtin_amdgcn_global_load_lds((const unsigned*)((const char*)(gbase) + (long)(voff)[_i]), (LAS unsigned*)(lds + (bufoff) + ldsw + _i * 8192), 16, 0, 0); } while (0)
#define PG8_LDA(dst, b, h) do { _Pragma("unroll") for (int m = 0; m < 4; ++m) _Pragma("unroll") for (int k = 0; k < 2; ++k) dst[m][k] = *(const LAS bf16x8*)(lds + PG8_SA(b, h) + aoff + m * 2048 + k * 1024); } while (0)
#define PG8_LDB(dst, b, h) do { _Pragma("unroll") for (int n = 0; n < 2; ++n) _Pragma("unroll") for (int k = 0; k < 2; ++k) dst[n][k] = *(const LAS bf16x8*)(lds + PG8_SB(b, h) + boff + n * 2048 + k * 1024); } while (0)
#define PG8_MMA(ai, bj, At, Bt) do { __builtin_amdgcn_s_setprio(1); _Pragma("unroll") for (int m = 0; m < 4; ++m) _Pragma("unroll") for (int n = 0; n < 2; ++n) _Pragma("unroll") for (int k = 0; k < 2; ++k) \
        acc[ai][bj][m][n] = __builtin_amdgcn_mfma_f32_16x16x32_bf16(Bt[n][k], At[m][k], acc[ai][bj][m][n], 0, 0, 0); __builtin_amdgcn_s_setprio(0); } while (0)
#define PG8_WAIT_V(n) asm volatile("s_waitcnt vmcnt(" #n ")" ::: "memory")
#define PG8_WAIT_L(n) asm volatile("s_waitcnt lgkmcnt(" #n ")" ::: "memory")
#define PG8_BAR __builtin_amdgcn_s_barrier()
#define PG8_SCHED __builtin_amdgcn_sched_barrier(0)
    Unit cur, nxt; int ui = 0;
    if (!S.next(0, cur)) return;
    f32x4 acc[2][2][4][2];
#pragma unroll
    for (int a = 0; a < 2; ++a)
#pragma unroll
        for (int b = 0; b < 2; ++b)
#pragma unroll
            for (int m = 0; m < 4; ++m)
#pragma unroll
                for (int n = 0; n < 2; ++n) acc[a][b][m][n] = (f32x4){0.f, 0.f, 0.f, 0.f};
    bf16x8 At[4][2], B0[2][2], B1[2][2];
    const char* cA = (const char*)g.A + a_row0(g, cur.pm) * (long)K * 2; const char* cB = (const char*)g.Bt + (size_t)cur.pn * tstep;
    PG8_STAGE(PG8_SB(0, 0), cB, voffB); PG8_STAGE(PG8_SA(0, 0), cA, voffA); PG8_STAGE(PG8_SB(0, 1), cB + hstep, voffB1); PG8_STAGE(PG8_SA(0, 1), cA + hstep, voffA);
    if (wr == 1) PG8_BAR;
    PG8_WAIT_V(4); PG8_BAR;
    PG8_STAGE(PG8_SB(1, 0), cB + kstep, voffB); PG8_STAGE(PG8_SA(1, 0), cA + kstep, voffA); PG8_STAGE(PG8_SB(1, 1), cB + hstep + kstep, voffB1);
    PG8_WAIT_V(6); PG8_BAR;
    for (;;) {
        const bool has_next = S.next(ui + 1, nxt);
        const char* nA = has_next ? (const char*)g.A + a_row0(g, nxt.pm) * (long)K * 2 : cA; const char* nB = has_next ? (const char*)g.Bt + (size_t)nxt.pn * tstep : cB;
        for (int t = 0; t < nt; t += 2) {
            const bool last = (t == nt - 2);
            const char* a1 = cA + (size_t)(t + 1) * kstep;
            const char* a2 = last ? nA : cA + (size_t)(t + 2) * kstep; const char* b2 = last ? nB : cB + (size_t)(t + 2) * kstep;
            const char* a3 = a2 + kstep; const char* b3 = b2 + kstep;
            PG8_LDB(B0, 0, 0); PG8_SCHED; PG8_LDA(At, 0, 0); PG8_STAGE(PG8_SA(1, 1), a1 + hstep, voffA);
            PG8_WAIT_L(8); PG8_BAR; PG8_WAIT_L(0); PG8_MMA(0, 0, At, B0); PG8_BAR; PG8_SCHED;
            PG8_LDB(B1, 0, 1); PG8_STAGE(PG8_SB(0, 0), b2, voffB);
            PG8_BAR; PG8_WAIT_L(0); PG8_MMA(0, 1, At, B1); PG8_BAR;
            PG8_LDA(At, 0, 1); PG8_STAGE(PG8_SA(0, 0), a2, voffA);
            PG8_BAR; PG8_WAIT_L(0); PG8_MMA(1, 0, At, B0); PG8_BAR; PG8_SCHED;
            PG8_STAGE(PG8_SB(0, 1), b2 + hstep, voffB1);
            PG8_WAIT_V(6); PG8_BAR; PG8_MMA(1, 1, At, B1); PG8_BAR;
            PG8_LDB(B0, 1, 0); PG8_SCHED; PG8_LDA(At, 1, 0); PG8_STAGE(PG8_SA(0, 1), a2 + hstep, voffA);
            PG8_WAIT_L(8); PG8_BAR; PG8_WAIT_L(0); PG8_MMA(0, 0, At, B0); PG8_BAR; PG8_SCHED;
            PG8_LDB(B1, 1, 1); PG8_STAGE(PG8_SB(1, 0), b3, voffB);
            PG8_BAR; PG8_WAIT_L(0); PG8_MMA(0, 1, At, B1); PG8_BAR;
            PG8_LDA(At, 1, 1); PG8_STAGE(PG8_SA(1, 0), a3, voffA);
            PG8_BAR; PG8_WAIT_L(0); PG8_MMA(1, 0, At, B0); PG8_BAR; PG8_SCHED;
            PG8_STAGE(PG8_SB(1, 1), b3 + hstep, voffB1);
            PG8_WAIT_V(6); PG8_BAR; PG8_MMA(1, 1, At, B1); PG8_BAR;
        }
        if (wr == 0) PG8_BAR;
        E(acc, cur, wr, wc, fr, fq);
        if (wr == 1) PG8_BAR;
        if (!has_next) break;
#pragma unroll
        for (int a = 0; a < 2; ++a)
#pragma unroll
            for (int b = 0; b < 2; ++b)
#pragma unroll
                for (int m = 0; m < 4; ++m)
#pragma unroll
                    for (int n = 0; n < 2; ++n) acc[a][b][m][n] = (f32x4){0.f, 0.f, 0.f, 0.f};
        cur = nxt; cA = nA; cB = nB; ++ui;
    }
    PG8_WAIT_V(0);
    if (wr == 0) PG8_BAR;
    PG8_BAR;
#undef PG8_SA
#undef PG8_SB
#undef PG8_STAGE
#undef PG8_LDA
#undef PG8_LDB
#undef PG8_MMA
#undef PG8_WAIT_V
#undef PG8_WAIT_L
#undef PG8_BAR
#undef PG8_SCHED
}
}
using pg8::Unit; using pg8::HALF; using pg8::BM;

struct EpiHy {
    static constexpr int BMAP = 1;
    bf16_t* O; const float* rs1;
    __device__ __forceinline__ void operator()(f32x4 (&acc)[2][2][4][2], const Unit& u, int wr, int wc, int fr, int fq) const {
        const int row0 = u.pm * BM + wr * 64 + fr, col0 = u.pn * BM + wc * 32 + 8 * fq;
        f32x4 sc[2][2];
#pragma unroll
        for (int bj = 0; bj < 2; ++bj) { sc[bj][0] = *(const f32x4*)(rs1 + col0 + bj * HALF); sc[bj][1] = *(const f32x4*)(rs1 + col0 + bj * HALF + 4); }
#pragma unroll
        for (int bj = 0; bj < 2; ++bj) {
#pragma unroll
            for (int ai = 0; ai < 2; ++ai)
#pragma unroll
                for (int m = 0; m < 4; ++m) {
                    const f32x4 v0 = acc[ai][bj][m][0] * sc[bj][0], v1 = acc[ai][bj][m][1] * sc[bj][1];
                    u32x4 o; o.x = pk2(v0[0], v0[1]); o.y = pk2(v0[2], v0[3]); o.z = pk2(v1[0], v1[1]); o.w = pk2(v1[2], v1[3]);
                    *(u32x4*)(O + (size_t)(row0 + ai * HALF + m * 16) * NTOK + col0 + bj * HALF) = o;
                }
        }
    }
};
struct EpiRet {
    static constexpr int BMAP = 3;
    bf16_t* O; const float* rs1; const float* cs;
    __device__ __forceinline__ void operator()(f32x4 (&acc)[2][2][4][2], const Unit& u, int wr, int wc, int fr, int fq) const {
        const int row0 = u.pm * BM + wr * 64 + fr;
        const bool rot = u.pn < 4; const float ksc = (u.pn >= 2 && u.pn < 4) ? 0.125f : 1.0f;
#pragma unroll
        for (int ai = 0; ai < 2; ++ai) {
            f32x4 cv[4][2], sv[4][2]; float rsv[4];
#pragma unroll
            for (int m = 0; m < 4; ++m) {
                const int row = row0 + ai * HALF + m * 16;
                rsv[m] = rs1[row];
                const float* cp = cs + (size_t)(row & (SEQL - 1)) * 64 + 8 * fq;
                cv[m][0] = *(const f32x4*)cp; cv[m][1] = *(const f32x4*)(cp + 4); sv[m][0] = *(const f32x4*)(cp + 32); sv[m][1] = *(const f32x4*)(cp + 36);
            }
            if (!rot) {
#pragma unroll
                for (int m = 0; m < 4; ++m) { cv[m][0] = cv[m][1] = (f32x4){1.f, 1.f, 1.f, 1.f}; sv[m][0] = sv[m][1] = (f32x4){0.f, 0.f, 0.f, 0.f}; }
            }
#pragma unroll
            for (int m = 0; m < 4; ++m) {
                const int row = row0 + ai * HALF + m * 16;
                const float rs = rsv[m] * ksc;
                u32x4 a, b2;
                {
                    const f32x4 x1 = acc[ai][0][m][0] * rs, x2 = acc[ai][1][m][0] * rs;
                    const f32x4 o1 = x1 * cv[m][0] - x2 * sv[m][0], o2 = x2 * cv[m][0] + x1 * sv[m][0];
                    a.x = pk2(o1[0], o1[1]); a.y = pk2(o1[2], o1[3]); b2.x = pk2(o2[0], o2[1]); b2.y = pk2(o2[2], o2[3]);
                }
                {
                    const f32x4 x1 = acc[ai][0][m][1] * rs, x2 = acc[ai][1][m][1] * rs;
                    const f32x4 o1 = x1 * cv[m][1] - x2 * sv[m][1], o2 = x2 * cv[m][1] + x1 * sv[m][1];
                    a.z = pk2(o1[0], o1[1]); a.w = pk2(o1[2], o1[3]); b2.z = pk2(o2[0], o2[1]); b2.w = pk2(o2[2], o2[3]);
                }
                bf16_t* pp = O + (size_t)row * RCOLS + u.pn * BM + 64 * wc + 8 * fq;
                *(u32x4*)pp = a; *(u32x4*)(pp + 32) = b2;
            }
        }
    }
};
struct EpiOut {
    static constexpr int BMAP = 1;
    bf16_t* O; float* part; LAS float* X;
    __device__ __forceinline__ void operator()(f32x4 (&acc)[2][2][4][2], const Unit& u, int wr, int wc, int fr, int fq) const {
        const int row0 = u.pm * BM + wr * 64 + fr, col0 = u.pn * BM + wc * 32 + 8 * fq;
#pragma unroll
        for (int ai = 0; ai < 2; ++ai) {
            u32x4 xr4[4][2];
#pragma unroll
            for (int m = 0; m < 4; ++m)
#pragma unroll
                for (int bj = 0; bj < 2; ++bj) xr4[m][bj] = *(const u32x4*)(O + (size_t)(row0 + ai * HALF + m * 16) * DM + col0 + bj * HALF);
#pragma unroll
            for (int m = 0; m < 4; ++m) {
                const int row = row0 + ai * HALF + m * 16;
                float ss = 0.f;
#pragma unroll
                for (int bj = 0; bj < 2; ++bj) {
                    u32x4* px = (u32x4*)(O + (size_t)row * DM + col0 + bj * HALF);
                    const u32x4 xr = xr4[m][bj];
                    f32x4 v0 = acc[ai][bj][m][0], v1 = acc[ai][bj][m][1];
                    v0[0] += bflo(xr.x); v0[1] += bfhi(xr.x); v0[2] += bflo(xr.y); v0[3] += bfhi(xr.y);
                    v1[0] += bflo(xr.z); v1[1] += bfhi(xr.z); v1[2] += bflo(xr.w); v1[3] += bfhi(xr.w);
                    ss += v0[0] * v0[0] + v0[1] * v0[1] + v0[2] * v0[2] + v0[3] * v0[3] + v1[0] * v1[0] + v1[1] * v1[1] + v1[2] * v1[2] + v1[3] * v1[3];
                    u32x4 o; o.x = pk2(v0[0], v0[1]); o.y = pk2(v0[2], v0[3]); o.z = pk2(v1[0], v1[1]); o.w = pk2(v1[2], v1[3]);
                    *px = o;
                }
                ss += __shfl_xor(ss, 16); ss += __shfl_xor(ss, 32);
                if (fq == 0) X[(ai * HALF + wr * 64 + m * 16 + fr) * 4 + wc] = ss;
            }
        }
        LDS_WAIT(); __builtin_amdgcn_s_barrier(); asm volatile("" ::: "memory");
        if (wr == 0) {
            const int r = wc * 64 + fq * 16 + fr;
            const f32x4 v = *(LAS const f32x4*)(X + r * 4);
            part[(size_t)(u.pm * BM + r) * 4 + u.pn] = (v[0] + v[1]) + (v[2] + v[3]);
        }
    }
};
struct EpiUp {
    static constexpr int BMAP = 1;
    bf16_t* O; const float* part; int row_base;
    __device__ __forceinline__ void operator()(f32x4 (&acc)[2][2][4][2], const Unit& u, int wr, int wc, int fr, int fq) const {
        const int row0 = u.pm * BM + wr * 64 + fr, col0 = u.pn * BM + wc * 32 + 8 * fq;
#pragma unroll
        for (int ai = 0; ai < 2; ++ai)
#pragma unroll
            for (int m = 0; m < 4; ++m) {
                const int row = row0 + ai * HALF + m * 16;
                const f32x4* pp = (const f32x4*)(part + (size_t)(row + row_base) * 16);
                const f32x4 p0 = pp[0], p1 = pp[1], p2 = pp[2], p3 = pp[3];
                const float ss = ((p0[0] + p0[1]) + (p0[2] + p0[3])) + ((p1[0] + p1[1]) + (p1[2] + p1[3])) + ((p2[0] + p2[1]) + (p2[2] + p2[3])) + ((p3[0] + p3[1]) + (p3[2] + p3[3]));
                const float rs = 1.0f / sqrtf(ss * (1.0f / DM) + EPS);
#pragma unroll
                for (int bj = 0; bj < 2; ++bj) {
                    const f32x4 v0 = acc[ai][bj][m][0] * rs, v1 = acc[ai][bj][m][1] * rs;
                    u32x4 o; o.x = pk2(v0[0], v0[1]); o.y = pk2(v0[2], v0[3]); o.z = pk2(v1[0], v1[1]); o.w = pk2(v1[2], v1[3]);
                    *(u32x4*)(O + (size_t)row * UPC + col0 + bj * HALF) = o;
                }
            }
    }
};

template <int CTRL> __device__ __forceinline__ f32x4 dpp4(f32x4 v) { f32x4 r; r[0] = dppf<CTRL>(v[0]); r[1] = dppf<CTRL>(v[1]); r[2] = dppf<CTRL>(v[2]); r[3] = dppf<CTRL>(v[3]); return r; }
__device__ __forceinline__ f32x4 gelu_fast4(f32x4 x) {
    f32x4 t = x * x; t = t * (-0.10294324f) + (-2.3022082f); t = t * x;
    f32x4 e; e[0] = __builtin_amdgcn_exp2f(t[0]); e[1] = __builtin_amdgcn_exp2f(t[1]); e[2] = __builtin_amdgcn_exp2f(t[2]); e[3] = __builtin_amdgcn_exp2f(t[3]);
    e = e + 1.0f;
    f32x4 r; r[0] = __builtin_amdgcn_rcpf(e[0]); r[1] = __builtin_amdgcn_rcpf(e[1]); r[2] = __builtin_amdgcn_rcpf(e[2]); r[3] = __builtin_amdgcn_rcpf(e[3]);
    return x * r;
}
__device__ __forceinline__ float gelu_fast(float x) {
    const float e = __builtin_amdgcn_exp2f(x * (-2.3022082f + -0.10294324f * x * x));
    return x * __builtin_amdgcn_rcpf(1.0f + e);
}
struct EpiFfn {
    static constexpr int BMAP = 1;
    bf16_t* Gout; const float* part; const float* cw; const float* cb; LAS float* X;
    __device__ __forceinline__ void operator()(f32x4 (&acc)[2][2][4][2], const Unit& u, int wr, int wc, int fr, int fq) const {
        const int seq = u.pm / 17, tbase = (u.pm % 17) * 254 - 1;
        const int colh = u.pn * 128 + wc * 32 + 8 * fq;
        f32x4 pq[2][4];
#pragma unroll
        for (int ai = 0; ai < 2; ++ai)
#pragma unroll
            for (int m = 0; m < 4; ++m) {
                const int t = tbase + 128 * ai + 64 * wr + 16 * m + fr;
                const int tc = t < 0 ? 0 : (t >= SEQL ? SEQL - 1 : t);
                pq[ai][m] = *(const f32x4*)(part + (size_t)(seq * SEQL + tc) * 4);
            }
#pragma unroll
        for (int ai = 0; ai < 2; ++ai)
#pragma unroll
            for (int m = 0; m < 4; ++m) {
                const int t = tbase + 128 * ai + 64 * wr + 16 * m + fr;
                const float ss = (pq[ai][m][0] + pq[ai][m][1]) + (pq[ai][m][2] + pq[ai][m][3]);
                const float rs = (t >= 0 && t < SEQL) ? __builtin_amdgcn_rsqf(ss * (1.0f / DM) + EPS) : 0.f;
#pragma unroll
                for (int bj = 0; bj < 2; ++bj)
#pragma unroll
                    for (int n = 0; n < 2; ++n) acc[ai][bj][m][n] = acc[ai][bj][m][n] * rs;
            }
#pragma unroll
        for (int ai = 0; ai < 2; ++ai)
#pragma unroll
            for (int bj = 0; bj < 2; ++bj)
#pragma unroll
                for (int n = 0; n < 2; ++n) {
                    LAS float* xb = X + ((2 * ai + wr) * 2) * 256 + bj * 128 + wc * 32 + 8 * fq + 4 * n;
                    if (fr == 0) *(LAS f32x4*)xb = acc[ai][bj][0][n];
                    if (fr == 15) *(LAS f32x4*)(xb + 256) = acc[ai][bj][3][n];
                }
        LDS_WAIT(); __builtin_amdgcn_s_barrier(); asm volatile("" ::: "memory");
#pragma unroll
        for (int n = 0; n < 2; ++n) {
            const int ca = colh + 4 * n;
            f32x4 wa[3], wb[3];
#pragma unroll
            for (int k = 0; k < 3; ++k) { wa[k] = *(const f32x4*)(cw + k * UPC + ca); wb[k] = *(const f32x4*)(cw + k * UPC + DFF + ca); }
            const f32x4 ba = *(const f32x4*)(cb + ca), bb = *(const f32x4*)(cb + DFF + ca);
#pragma unroll
            for (int ai = 0; ai < 2; ++ai) {
                const int strip = 2 * ai + wr;
                f32x4 xp[2], xn[2];
#pragma unroll
                for (int bj = 0; bj < 2; ++bj) {
                    LAS const float* xb = X + bj * 128 + wc * 32 + 8 * fq + 4 * n;
                    xp[bj] = (strip > 0) ? *(LAS const f32x4*)(xb + ((strip - 1) * 2 + 1) * 256) : (f32x4){0.f, 0.f, 0.f, 0.f};
                    xn[bj] = (strip < 3) ? *(LAS const f32x4*)(xb + ((strip + 1) * 2) * 256) : (f32x4){0.f, 0.f, 0.f, 0.f};
                }
#pragma unroll
                for (int m = 0; m < 4; ++m) {
                    f32x4 y[2];
#pragma unroll
                    for (int bj = 0; bj < 2; ++bj) {
                        const f32x4 cur = acc[ai][bj][m][n];
                        const f32x4 up = (m > 0) ? acc[ai][bj][m - 1][n] : xp[bj];
                        const f32x4 dn = (m < 3) ? acc[ai][bj][m + 1][n] : xn[bj];
                        f32x4 su, sd;
#pragma unroll
                        for (int j = 0; j < 4; ++j) { su[j] = (fr == 15) ? up[j] : cur[j]; sd[j] = (fr == 0) ? dn[j] : cur[j]; }
                        const f32x4 prev = dpp4<0x121>(su);
                        const f32x4 next = dpp4<0x12F>(sd);
                        y[bj] = bj ? (wb[0] * prev + wb[1] * cur + wb[2] * next + bb) : (wa[0] * prev + wa[1] * cur + wa[2] * next + ba);
                    }
                    const int lr = 128 * ai + 64 * wr + 16 * m + fr, t = tbase + lr;
                    const f32x4 gv = gelu_fast4(y[0]) * y[1];
                    u32x2 o; o.x = pk2(gv[0], gv[1]); o.y = pk2(gv[2], gv[3]);
                    if (lr >= 1 && lr <= 254 && t < SEQL) *(u32x2*)(Gout + (size_t)(seq * SEQL + t) * DFF + ca) = o;
                }
            }
        }
    }
};
struct EpiDown {
    static constexpr int BMAP = 1;
    unsigned char* ws; const bf16_t* X1; float* part;
    __device__ __forceinline__ void operator()(f32x4 (&acc)[2][2][4][2], const Unit& u, int wr, int wc, int fr, int fq) const {
        const int row0 = u.pm * BM + wr * 64 + fr, col0 = u.pn * BM + wc * 32 + 8 * fq;
#pragma unroll
        for (int ai = 0; ai < 2; ++ai) {
            u32x4 xr4[4][2];
#pragma unroll
            for (int m = 0; m < 4; ++m)
#pragma unroll
                for (int bj = 0; bj < 2; ++bj) xr4[m][bj] = *(const u32x4*)(X1 + (size_t)(row0 + ai * HALF + m * 16) * DM + col0 + bj * HALF);
#pragma unroll
            for (int m = 0; m < 4; ++m) {
                const int row = row0 + ai * HALF + m * 16;
                bf16_t* yr = y_row(ws, row);
                float ss = 0.f;
#pragma unroll
                for (int bj = 0; bj < 2; ++bj) {
                    const int col = col0 + bj * HALF;
                    const u32x4 xr = xr4[m][bj];
                    f32x4 v0 = acc[ai][bj][m][0], v1 = acc[ai][bj][m][1];
                    v0[0] += bflo(xr.x); v0[1] += bfhi(xr.x); v0[2] += bflo(xr.y); v0[3] += bfhi(xr.y);
                    v1[0] += bflo(xr.z); v1[1] += bfhi(xr.z); v1[2] += bflo(xr.w); v1[3] += bfhi(xr.w);
                    ss += v0[0] * v0[0] + v0[1] * v0[1] + v0[2] * v0[2] + v0[3] * v0[3] + v1[0] * v1[0] + v1[1] * v1[1] + v1[2] * v1[2] + v1[3] * v1[3];
                    u32x4 o; o.x = pk2(v0[0], v0[1]); o.y = pk2(v0[2], v0[3]); o.z = pk2(v1[0], v1[1]); o.w = pk2(v1[2], v1[3]);
                    *(u32x4*)(yr + col) = o;
                }
                ss += __shfl_xor(ss, 16); ss += __shfl_xor(ss, 32);
                if (fq == 0) part[(size_t)row * 16 + u.pn * 4 + wc] = ss;
            }
        }
    }
};

struct EpiNull { static constexpr int BMAP = 1;
    __device__ __forceinline__ void operator()(f32x4 (&acc)[2][2][4][2], const Unit& u, int wr, int wc, int fr, int fq) const {
        float s = 0.f;
#pragma unroll
        for (int ai = 0; ai < 2; ++ai)
#pragma unroll
            for (int bj = 0; bj < 2; ++bj)
#pragma unroll
                for (int m = 0; m < 4; ++m)
#pragma unroll
                    for (int n = 0; n < 2; ++n) s += acc[ai][bj][m][n][0] + acc[ai][bj][m][n][1] + acc[ai][bj][m][n][2] + acc[ai][bj][m][n][3];
        if (s == 123.456f) *sink = s;
    }
    float* sink; };
template <int UPPERM>
__device__ __forceinline__ void transpose_item(const float* W, const float* gk, int K, int N, bf16_t* WT, LAS float* scr, int item, int lane) {
    const int nblk = N / 32, kb = item / nblk, nb = item % nblk, k0 = 64 * kb, n0 = 32 * nb;
#pragma unroll 16
    for (int i = 0; i < 32; ++i) { const int kk = 2 * i + (lane >> 5); const float s = gk ? gk[k0 + kk] : 1.0f; scr[kk * 33 + (lane & 31)] = W[(size_t)(k0 + kk) * N + n0 + (lane & 31)] * s; }
    LDS_WAIT();
    const int c = lane & 7;
#pragma unroll
    for (int j = 0; j < 4; ++j) { const int n = (lane >> 3) + 8 * j; const LAS float* s = scr + (8 * c) * 33 + n;
        u32x4 o; o.x = pk2(s[0 * 33], s[1 * 33]); o.y = pk2(s[2 * 33], s[3 * 33]); o.z = pk2(s[4 * 33], s[5 * 33]); o.w = pk2(s[6 * 33], s[7 * 33]);
        int nr = n0 + n;
        if (UPPERM) { const int oo = nr < DFF ? nr : nr - DFF; nr = 256 * (oo >> 7) + (oo & 127) + (nr < DFF ? 0 : 128); }
        *(u32x4*)(WT + (size_t)nr * K + k0 + 8 * c) = o; }
    LDS_WAIT();
}
__device__ __forceinline__ void phase_a(const Params& p, LAS unsigned char* lds) {
    const int tid = opaque_tid(), wave = tid >> 6, lane = tid & 63;
    const int gw = blockIdx.x * 8 + wave, NGW = gridDim.x * 8;
    unsigned char* ws = p.ws;
    LAS float* scr = (LAS float*)(lds + wave * 8704);
    constexpr int I_IN = 16 * (3584 / 32), I_OUT = 16 * 32, I_UP = 16 * (UPC / 32), I_DN = (DFF / 64) * 32;
    constexpr int I_T = I_IN + I_OUT + I_UP + I_DN, I_H3 = SEQL, I_X = NTOK;
    for (int it = gw; it < I_T + I_H3; it += NGW) {
        int r = it;
        if (r < I_IN) { transpose_item<0>(p.in[3], p.in[2], DM, 3584, (bf16_t*)(ws + WS_WIN), scr, r, lane); continue; } r -= I_IN;
        if (r < I_OUT) { transpose_item<0>(p.in[18], nullptr, DM, DM, (bf16_t*)(ws + WS_WOUT), scr, r, lane); continue; } r -= I_OUT;
        if (r < I_UP) { transpose_item<1>(p.in[20], p.in[19], DM, UPC, (bf16_t*)(ws + WS_WUP), scr, r, lane); continue; } r -= I_UP;
        if (r < I_DN) { transpose_item<0>(p.in[23], nullptr, DFF, DM, (bf16_t*)(ws + WS_WDN), scr, r, lane); continue; } r -= I_DN;
        if (r < I_H3) {
            const int l = r; const float fl = (float)l;
            float z = 0.f;
            if (lane == 0) z = fl * (1.0f / 4095.0f);
            else if (lane < 33) { const int bi = (lane - 1) & 15; const float band = 1e-4f + (float)bi * ((15.0f - 1e-4f) / 15.0f);
                const float ang = (6.283185307179586f / 4096.0f) * fl * band; z = (lane < 17) ? cosf(ang) : -sinf(ang); }
            const float fr = p.in[12][lane];
            float a = p.in[7][lane];
            for (int e = 0; e < 33; ++e) a += __shfl(z, e) * p.in[6][e * 64 + lane];
            float h = sinf(fr * a);
            a = p.in[9][lane];
            for (int e = 0; e < 64; ++e) a += __shfl(h, e) * p.in[8][e * 64 + lane];
            h = sinf(fr * a);
            a = p.in[11][lane];
            for (int e = 0; e < 64; ++e) a += __shfl(h, e) * p.in[10][e * 64 + lane];
            h = sinf(fr * a);
            ((float*)(ws + WS_H3T))[lane * SEQL + l] = h;
            continue;
        }
        (void)r;
    }
    for (int row0 = gw; row0 < I_X; row0 += 2 * NGW) {
        const int row1 = row0 + NGW; const bool has1 = row1 < I_X;
        const int rr1 = has1 ? row1 : row0;
        const float* xr0 = (row0 < NTOK_P) ? p.in[0] + (size_t)row0 * DM : p.in[1] + (size_t)(row0 - NTOK_P) * DM;
        const float* xr1 = (rr1 < NTOK_P) ? p.in[0] + (size_t)rr1 * DM : p.in[1] + (size_t)(rr1 - NTOK_P) * DM;
        f32x4 v0[4], v1[4]; float s0 = 0.f, s1 = 0.f;
#pragma unroll
        for (int j = 0; j < 4; ++j) { v0[j] = *(const f32x4*)(xr0 + 256 * j + 4 * lane); v1[j] = *(const f32x4*)(xr1 + 256 * j + 4 * lane); }
#pragma unroll
        for (int j = 0; j < 4; ++j) { s0 += v0[j][0] * v0[j][0] + v0[j][1] * v0[j][1] + v0[j][2] * v0[j][2] + v0[j][3] * v0[j][3]; s1 += v1[j][0] * v1[j][0] + v1[j][1] * v1[j][1] + v1[j][2] * v1[j][2] + v1[j][3] * v1[j][3]; }
        s0 = wave_sum(s0); s1 = wave_sum(s1);
        if (lane == 0) { ((float*)(ws + WS_RS1))[row0] = 1.0f / sqrtf(s0 * (1.0f / DM) + EPS); if (has1) ((float*)(ws + WS_RS1))[row1] = 1.0f / sqrtf(s1 * (1.0f / DM) + EPS); }
        bf16_t* xb0 = (bf16_t*)(ws + WS_A) + (size_t)row0 * DM; bf16_t* xb1 = (bf16_t*)(ws + WS_A) + (size_t)rr1 * DM;
#pragma unroll
        for (int j = 0; j < 4; ++j) { u32x2 o; o.x = pk2(v0[j][0], v0[j][1]); o.y = pk2(v0[j][2], v0[j][3]); *(u32x2*)(xb0 + 256 * j + 4 * lane) = o; }
        if (has1) {
#pragma unroll
            for (int j = 0; j < 4; ++j) { u32x2 o; o.x = pk2(v1[j][0], v1[j][1]); o.y = pk2(v1[j][2], v1[j][3]); *(u32x2*)(xb1 + 256 * j + 4 * lane) = o; }
        }
    }
    for (int e = blockIdx.x * 512 + tid; e < 64 * 2048; e += gridDim.x * 512) ((float*)(ws + WS_W4T))[e] = p.in[13][(e & 63) * 2048 + (e >> 6)];
    for (int e = blockIdx.x * 512 + tid; e < SEQL * 32; e += gridDim.x * 512) {
        const int t = e >> 5, i = e & 31;
        const float inv = powf(10000.0f, -(float)(2 * i) / 64.0f);
        const float ang = (float)t * inv;
        float* cs = (float*)(ws + WS_CS) + (size_t)t * 64;
        cs[i] = cosf(ang); cs[32 + i] = sinf(ang);
    }
}
__device__ __forceinline__ void phase_b(const Params& p) {
    const int tid = opaque_tid();
    const float* h3t = (const float*)(p.ws + WS_H3T); const float* w4 = p.in[13];
    float* hft = (float*)(p.ws + WS_D);
    for (int it = blockIdx.x; it < 256 * 8; it += gridDim.x) {
        const int cg8 = it >> 3, l = (it & 7) * 512 + tid, col0 = cg8 * 8;
        float a[8];
#pragma unroll
        for (int j = 0; j < 8; ++j) a[j] = 0.f;
        for (int k = 0; k < 64; ++k) {
            const float hv = h3t[k * SEQL + l];
            const f32x4 w0 = *(const f32x4*)(w4 + k * 2048 + col0), w1 = *(const f32x4*)(w4 + k * 2048 + col0 + 4);
            a[0] += hv * w0[0]; a[1] += hv * w0[1]; a[2] += hv * w0[2]; a[3] += hv * w0[3];
            a[4] += hv * w1[0]; a[5] += hv * w1[1]; a[6] += hv * w1[2]; a[7] += hv * w1[3];
        }
        const float tl = (float)l * (1.0f / 4095.0f);
        const float d0 = -15.350567286626973f, d1 = -3.0701134573253945f;
#pragma unroll
        for (int j = 0; j < 8; ++j) {
            const int c = (col0 + j) & 511;
            const float delta = fabsf(d0 + (float)c * ((d1 - d0) / 511.0f));
            hft[(size_t)(col0 + j) * SEQL + l] = a[j] * expf(-tl * delta);
        }
    }
}
__device__ __forceinline__ void phase_toep(const Params& p) {
    const int tid = opaque_tid();
    const float* hft = (const float*)(p.ws + WS_D); const float* bias = p.in[14];
    bf16_t* T = (bf16_t*)(p.ws + WS_B);
    for (int it = blockIdx.x; it < 2048; it += gridDim.x) {
        const int oc = it >> 1, sh = it & 1;
        const float* hf = hft + (size_t)oc * SEQL; const float* hb = hft + (size_t)(1024 + oc) * SEQL;
        const float bz = bias[oc];
        for (int up = tid; up < 1024; up += 512) {
            float v[8];
#pragma unroll
            for (int j = 0; j < 8; ++j) {
                const int m = 8 * (up - 512) + j + sh, d = -m;
                float x = 0.f;
                if (d >= 0 && d < SEQL) x = hf[d]; else if (d < 0 && d > -SEQL) x = hb[-d];
                if (d == 0) x += bz;
                v[j] = x;
            }
            u32x4 o; o.x = pk2(v[0], v[1]); o.y = pk2(v[2], v[3]); o.z = pk2(v[4], v[5]); o.w = pk2(v[6], v[7]);
            *(u32x4*)(T + ((size_t)it * 1024 + up) * 8) = o;
        }
    }
}

__device__ __forceinline__ void phase_rf(const Params& p) {
    const int tid = opaque_tid();
    const float* h3t = (const float*)(p.ws + WS_H3T); const float* w4t = (const float*)(p.ws + WS_W4T); const float* bias = p.in[14];
    bf16_t* T = (bf16_t*)(p.ws + WS_B);
    const float d0 = -15.350567286626973f, d1 = -3.0701134573253945f;
    for (int q = blockIdx.x; q < 256; q += gridDim.x) {
#pragma unroll 1
        for (int lp = 0; lp < 8; ++lp) {
            const int l = lp * 512 + tid;
            float h[64];
#pragma unroll
            for (int k = 0; k < 64; ++k) h[k] = h3t[k * SEQL + l];
            const float tl = (float)l * (1.0f / 4095.0f);
#pragma unroll 1
            for (int j = 0; j < 4; ++j) {
                const int oc = __builtin_amdgcn_readfirstlane(q * 4 + j), c = oc & 511;
                const float* wf = w4t + (size_t)oc * 64; const float* wb = w4t + (size_t)(1024 + oc) * 64;
                float af = 0.f, ab = 0.f;
#pragma unroll
                for (int k = 0; k < 64; ++k) { af += h[k] * wf[k]; ab += h[k] * wb[k]; }
                const float decay = expf(-tl * fabsf(d0 + (float)c * ((d1 - d0) / 511.0f)));
                af *= decay; ab *= decay;
                if (l == 0) af += bias[oc];
                const bf16_t vf = (bf16_t)(pk2(af, 0.f) & 0xffff), vb = (bf16_t)(pk2(ab, 0.f) & 0xffff);
                bf16_t* T0 = T + (size_t)(oc * 2) * 8192; bf16_t* T1 = T0 + 8192;
                T0[4096 - l] = vf; T1[4095 - l] = vf;
                if (l >= 1) { T0[4096 + l] = vb; T1[4095 + l] = vb; }
                else { T0[0] = 0; T1[8191] = 0; }
            }
        }
    }
}

constexpr int ZS = 4112;
#define MFMA16(a, b, c) __builtin_amdgcn_mfma_f32_16x16x32_bf16(a, b, c, 0, 0, 0)
typedef u32x4 u32x4_a4 __attribute__((aligned(4)));
__device__ __forceinline__ bf16x8 ld_filt(LAS const bf16_t* q) {
    const u32x4 v = *(LAS const u32x4_a4*)q;
    return __builtin_bit_cast(bf16x8, v);
}
__device__ __forceinline__ void hyena_group(LAS const bf16_t* Rl, LAS const bf16_t* Zl, int g, f32x4 (&acc)[16]) {
    bf16x8 Aw[16];
#pragma unroll
    for (int i = 0; i < 16; ++i) { Aw[i] = ld_filt(Rl - 16 * (16 * g + i)); acc[i] = (f32x4){0.f, 0.f, 0.f, 0.f}; }
    bf16x8 Bz = *(LAS const bf16x8*)(Zl);
    for (int q = 0; q < 16; ++q) {
#pragma unroll
        for (int e = 0; e < 8; ++e) {
            const int sg = 8 * q + e;
            const int dn = 16 * g - 2 * ((sg + 1) & 127);
            const bf16x8 Bn = *(LAS const bf16x8*)(Zl + 32 * ((sg + 1) & 127));
            const bf16x8 An0 = ld_filt(Rl - 16 * dn);
            const bf16x8 An1 = ld_filt(Rl - 16 * (dn + 1));
            __builtin_amdgcn_sched_barrier(0);
            __builtin_amdgcn_s_setprio(1);
#pragma unroll
            for (int i = 15; i >= 0; --i) acc[i] = MFMA16(Aw[(i - 2 * e) & 15], Bz, acc[i]);
            __builtin_amdgcn_s_setprio(0);
            __builtin_amdgcn_sched_barrier(0);
            Aw[(14 - 2 * e) & 15] = An0;
            Aw[(15 - 2 * e) & 15] = An1;
            Bz = Bn;
        }
    }
}
__device__ __forceinline__ f32x4 gate4(const bf16_t* raw, int t, float w0, float w1, float w2, float cb) {
    const u32x2 x = *(const u32x2*)(raw + t);
    const float xm0 = bf1(raw[t > 0 ? t - 1 : 0]), xp0 = bf1(raw[t + 4 < SEQL ? t + 4 : SEQL - 1]);
    const float xm = (t > 0) ? xm0 : 0.f, xp = (t + 4 < SEQL) ? xp0 : 0.f;
    const float x0 = bflo(x.x), x1 = bfhi(x.x), x2 = bflo(x.y), x3 = bfhi(x.y);
    f32x4 g;
    g[0] = w0 * xm + w1 * x0 + w2 * x1 + cb; g[1] = w0 * x0 + w1 * x1 + w2 * x2 + cb;
    g[2] = w0 * x1 + w1 * x2 + w2 * x3 + cb; g[3] = w0 * x2 + w1 * x3 + w2 * xp + cb;
    return g;
}
template <int FAKE>
__device__ __forceinline__ void hyena_channel(const Params& p, LAS unsigned char* lds, int c) {
    const int tid = opaque_tid(), wave = tid >> 6, lane = tid & 63, fr = lane & 15, fq = lane >> 4;
    const bf16_t* PhT = (const bf16_t*)(p.ws + WS_C);
    const bf16_t* RFg = (const bf16_t*)(p.ws + WS_B);
    bf16_t* Z2T = (bf16_t*)(p.ws + WS_D);
    const float* cw = p.in[4]; const float* cbv = p.in[5];
    LAS bf16_t* Z = (LAS bf16_t*)lds;
    LAS bf16_t* RF = (LAS bf16_t*)(lds + NBATCH * ZS * 2);
    __syncthreads();
    for (int i = tid; i < 2048; i += 512) *(LAS u32x4*)(RF + 8 * i) = *(const u32x4*)(RFg + (size_t)(0 * 512 + c) * 16384 + 8 * i);
    {
        const float w0 = cw[c], w1 = cw[HCOLS + c], w2 = cw[2 * HCOLS + c], cb = cbv[c];
#pragma unroll 1
        for (int h6 = 0; h6 < 12; h6 += 6) {
        u32x4 xv[6]; bf16_t xm[6], xp[6];
#pragma unroll
        for (int it = 0; it < 6; ++it) {
            const int idx = tid + 512 * (it + h6), b = idx >> 9, t8 = (idx & 511) * 8;
            const bf16_t* base = PhT + (size_t)c * NTOK + b * SEQL + t8;
            xv[it] = *(const u32x4*)base; xm[it] = base[t8 > 0 ? -1 : 0]; xp[it] = base[t8 + 8 < SEQL ? 8 : 7];
        }
#pragma unroll
        for (int it = 0; it < 6; ++it) {
            const int idx = tid + 512 * (it + h6), b = idx >> 9, t8 = (idx & 511) * 8;
            const u32x4 x = xv[it];
            float v[10];
            v[0] = (t8 > 0) ? bf1(xm[it]) : 0.f; v[9] = (t8 + 8 < SEQL) ? bf1(xp[it]) : 0.f;
            v[1] = bflo(x.x); v[2] = bfhi(x.x); v[3] = bflo(x.y); v[4] = bfhi(x.y); v[5] = bflo(x.z); v[6] = bfhi(x.z); v[7] = bflo(x.w); v[8] = bfhi(x.w);
            float o[8];
#pragma unroll
            for (int j = 0; j < 8; ++j) o[j] = w0 * v[j] + w1 * v[j + 1] + w2 * v[j + 2] + cb;
            u32x4 ov; ov.x = pk2(o[0], o[1]); ov.y = pk2(o[2], o[3]); ov.z = pk2(o[4], o[5]); ov.w = pk2(o[6], o[7]);
            *(LAS u32x4*)(Z + b * ZS + t8) = ov;
        }
        }
    }
    __syncthreads();
    const int bb = (fr < NBATCH) ? fr : fr - NBATCH;
    LAS const bf16_t* Rl = (fr & 1) ? RF + 8192 + 4096 + 8 * fq - fr - 1 : RF + 4096 + 8 * fq - fr;
    if (FAKE) Rl = RF + 4096 + 8 * fq - 16;
    LAS const bf16_t* Zl = Z + bb * ZS + 8 * fq;
    f32x4 acc[16];
    {
        const int gc = 512 + c;
        const float w0 = cw[gc], w1 = cw[HCOLS + gc], w2 = cw[2 * HCOLS + gc], cb = cbv[gc];
        const bf16_t* raw = PhT + (size_t)gc * NTOK + bb * SEQL;
#pragma unroll 1
        for (int gi = 0; gi < 2; ++gi) {
            const int g = wave + 8 * gi;
            hyena_group(Rl, Zl, g, acc);
            f32x4 gts[16];
#pragma unroll
            for (int i = 0; i < 16; ++i) gts[i] = gate4(raw, 256 * g + 16 * i + 4 * fq, w0, w1, w2, cb);
#pragma unroll
            for (int i = 0; i < 16; ++i) {
                const int t = 256 * g + 16 * i + 4 * fq;
                const f32x4 zz = gts[i] * acc[i];
                u32x2 o; o.x = pk2(zz[0], zz[1]); o.y = pk2(zz[2], zz[3]);
                if (fr < NBATCH && (!FAKE || zz[0] == 123.4567f)) *(u32x2*)(Z2T + (size_t)c * NTOK + fr * SEQL + t) = o;
            }
        }
    }
    asm volatile("s_waitcnt vmcnt(0)" ::: "memory");
    __syncthreads();
    for (int i = tid; i < 2048; i += 512) *(LAS u32x4*)(RF + 8 * i) = *(const u32x4*)(RFg + (size_t)(1 * 512 + c) * 16384 + 8 * i);
#pragma unroll 1
    for (int h6 = 0; h6 < 12; h6 += 6) {
        u32x4 zv[6];
#pragma unroll
        for (int it = 0; it < 6; ++it) { const int idx = tid + 512 * (it + h6), b = idx >> 9, t8 = (idx & 511) * 8;
            zv[it] = __builtin_nontemporal_load((const u32x4*)(Z2T + (size_t)c * NTOK + b * SEQL + t8)); }
#pragma unroll
        for (int it = 0; it < 6; ++it) { const int idx = tid + 512 * (it + h6), b = idx >> 9, t8 = (idx & 511) * 8; *(LAS u32x4*)(Z + b * ZS + t8) = zv[it]; }
    }
    __syncthreads();
    {
        const int gc = 1024 + c;
        const float w0 = cw[gc], w1 = cw[HCOLS + gc], w2 = cw[2 * HCOLS + gc], cb = cbv[gc];
        const bf16_t* raw = PhT + (size_t)gc * NTOK + bb * SEQL;
#pragma unroll 1
        for (int gi = 0; gi < 2; ++gi) {
            const int g = wave + 8 * gi;
            hyena_group(Rl, Zl, g, acc);
            f32x4 gts[16];
#pragma unroll
            for (int i = 0; i < 16; ++i) gts[i] = gate4(raw, 256 * g + 16 * i + 4 * fq, w0, w1, w2, cb);
#pragma unroll
            for (int i = 0; i < 16; ++i) {
                const int t = 256 * g + 16 * i + 4 * fq;
                const f32x4 zz = gts[i] * acc[i];
                u32x2 o; o.x = pk2(zz[0], zz[1]); o.y = pk2(zz[2], zz[3]);
                if (fr < NBATCH && (!FAKE || zz[0] == 123.4567f)) *(u32x2*)(Z2T + (size_t)c * NTOK + fr * SEQL + t) = o;
            }
        }
    }
}
__device__ __forceinline__ float lg2f_fwd(int h) { return log2f(1.0f - exp2f(-5.0f - (float)h)); }
__device__ __forceinline__ float lg2f_bwd(int h) { return log2f(1.0f - exp2f(-5.5f - (float)h)); }
constexpr int TS = 136;
struct KvRegs { u32x4 kx[2], vx[2]; };
__device__ __forceinline__ void ret_kv_load(const Params& p, int item, int tid, KvRegs& r) {
    const int bh = item >> 5, n = item & 31, b = bh >> 3, h = bh & 7;
    const bf16_t* Pr = (const bf16_t*)p.out;
    const size_t tok0 = (size_t)b * SEQL + n * 128;
#pragma unroll
    for (int q = 0; q < 2; ++q) {
        const int idx = tid + 512 * q, i = idx >> 3, dc = idx & 7;
        r.kx[q] = *(const u32x4*)(Pr + (tok0 + i) * RCOLS + 512 + 64 * h + 8 * dc);
        r.vx[q] = *(const u32x4*)(Pr + (tok0 + i) * RCOLS + 1024 + 64 * h + 8 * dc);
    }
}
__device__ __forceinline__ void ret_kv_item(const Params& p, LAS unsigned char* lds, int item, KvRegs& cur, int nxt_item) {
    const int tid = opaque_tid(), wave = tid >> 6, lane = tid & 63, fr = lane & 15, fq = lane >> 4;
    const int bh = item >> 5, n = item & 31, h = bh & 7;
    bf16_t* KV = (bf16_t*)(p.ws + WS_KV);
    LAS bf16_t* KfT = (LAS bf16_t*)lds; LAS bf16_t* KbT = KfT + 64 * TS; LAS bf16_t* VT = KbT + 64 * TS;
    const float lf = lg2f_fwd(h), lb = lg2f_bwd(h);
    __syncthreads();
#pragma unroll
    for (int q = 0; q < 2; ++q) {
        const int idx = tid + 512 * q, i = idx >> 3, dc = idx & 7;
        const u32x4 kx = cur.kx[q], vx = cur.vx[q];
        const float df = __builtin_amdgcn_exp2f((float)(127 - i) * lf), db = __builtin_amdgcn_exp2f((float)i * lb);
        const unsigned kk[4] = {kx.x, kx.y, kx.z, kx.w}, vv[4] = {vx.x, vx.y, vx.z, vx.w};
#pragma unroll
        for (int j = 0; j < 4; ++j) {
            const float k0 = bflo(kk[j]), k1 = bfhi(kk[j]);
            const unsigned f = pk2(k0 * df, k1 * df), bw = pk2(k0 * db, k1 * db);
            KfT[(8 * dc + 2 * j) * TS + i] = (bf16_t)(f & 0xffff); KfT[(8 * dc + 2 * j + 1) * TS + i] = (bf16_t)(f >> 16);
            KbT[(8 * dc + 2 * j) * TS + i] = (bf16_t)(bw & 0xffff); KbT[(8 * dc + 2 * j + 1) * TS + i] = (bf16_t)(bw >> 16);
            VT[(8 * dc + 2 * j) * TS + i] = (bf16_t)(vv[j] & 0xffff); VT[(8 * dc + 2 * j + 1) * TS + i] = (bf16_t)(vv[j] >> 16);
        }
    }
    if (nxt_item >= 0) ret_kv_load(p, nxt_item, tid, cur);
    __syncthreads();
    const int dir = wave >> 2, dt = wave & 3;
    LAS const bf16_t* KT = dir ? KbT : KfT;
    bf16x8 A[4];
#pragma unroll
    for (int kk = 0; kk < 4; ++kk) A[kk] = *(LAS const bf16x8*)(KT + (16 * dt + fr) * TS + 32 * kk + 8 * fq);
    bf16_t* dst = KV + ((size_t)(bh * 32 + n) * 2 + dir) * 4096;
#pragma unroll
    for (int et = 0; et < 4; ++et) {
        f32x4 o = (f32x4){0.f, 0.f, 0.f, 0.f};
#pragma unroll
        for (int kk = 0; kk < 4; ++kk) { const bf16x8 B = *(LAS const bf16x8*)(VT + (16 * et + fr) * TS + 32 * kk + 8 * fq); o = MFMA16(A[kk], B, o); }
        u32x2 w; w.x = pk2(o[0], o[1]); w.y = pk2(o[2], o[3]);
        *(u32x2*)(dst + (16 * et + fr) * 64 + 16 * dt + 4 * fq) = w;
    }
}

__device__ __forceinline__ void ret_kv_item_simple(const Params& p, int item) {
    const int bh = item >> 5, n = item & 31, b = bh >> 3, h = bh & 7;
    const bf16_t* Pr = (const bf16_t*)p.out;
    bf16_t* KV = (bf16_t*)(p.ws + WS_KV);
    const float lf = lg2f_fwd(h), lb = lg2f_bwd(h);
    const size_t tok0 = (size_t)b * SEQL + n * 128;
    for (int o = threadIdx.x; o < 8192; o += 512) {
        const int dir = o >> 12, e = (o >> 6) & 63, d = o & 63;
        float a = 0.f;
        for (int i = 0; i < 128; ++i) {
            const float dec = dir ? exp2f((float)i * lb) : exp2f((float)(127 - i) * lf);
            const float kq = bf1((bf16_t)(pk2(bf1(Pr[(tok0 + i) * RCOLS + 512 + 64 * h + d]) * dec, 0.f) & 0xffff));
            a += kq * bf1(Pr[(tok0 + i) * RCOLS + 1024 + 64 * h + e]);
        }
        KV[((size_t)(bh * 32 + n) * 2 + dir) * 4096 + e * 64 + d] = (bf16_t)(pk2(a, 0.f) & 0xffff);
    }
}
__device__ __forceinline__ void phase_d(const Params& p, LAS unsigned char* lds) {
    if (DIAG != 45 && DIAG != 47 && DIAG != 46) {
#pragma unroll 1
        for (int c = blockIdx.x; c < 512; c += gridDim.x) hyena_channel<0>(p, lds, c);
        if (PROBE == 6) { for (int c = blockIdx.x; c < 512; c += gridDim.x) hyena_channel<1>(p, lds, c); }
        if (PROBE == 1) { for (int c = blockIdx.x; c < 512; c += gridDim.x) hyena_channel<0>(p, lds, c); }
    }
    if (DIAG == 46) { for (int it = blockIdx.x; it < 96 * 32; it += gridDim.x) ret_kv_item_simple(p, it); return; }
    {
        KvRegs kr;
        if ((int)blockIdx.x < 96 * 32) ret_kv_load(p, blockIdx.x, opaque_tid(), kr);
#pragma unroll 1
        for (int it = blockIdx.x; it < 96 * 32; it += gridDim.x) { const int nx = it + (int)gridDim.x; ret_kv_item(p, lds, it, kr, nx < 96 * 32 ? nx : -1); }
    }
}

__device__ __forceinline__ void phase_e(const Params& p, LAS unsigned char* lds) {
    const int tid = opaque_tid(), wave = tid >> 6, lane = tid & 63;
    {
        bf16_t* KV = (bf16_t*)(p.ws + WS_KV);
        for (int id = blockIdx.x * 512 + tid; id < 96 * 2 * 512; id += gridDim.x * 512) {
            const int e8 = id & 511, dir = (id >> 9) & 1, bh = id >> 10, h = bh & 7;
            const float cd = exp2f(128.0f * (dir ? lg2f_bwd(h) : lg2f_fwd(h)));
            float s[8];
#pragma unroll
            for (int j = 0; j < 8; ++j) s[j] = 0.f;
            bf16_t* basep = KV + ((size_t)(bh * 32) * 2 + dir) * 4096 + e8 * 8;
#pragma unroll 1
            for (int q0 = 0; q0 < 32; q0 += 8) {
                u32x4 kvv[8];
#pragma unroll
                for (int j = 0; j < 8; ++j) { const int n = dir ? 31 - (q0 + j) : (q0 + j); kvv[j] = *(const u32x4*)(basep + (size_t)n * 8192); }
#pragma unroll
                for (int j = 0; j < 8; ++j) {
                    const int n = dir ? 31 - (q0 + j) : (q0 + j);
                    u32x4 o; o.x = pk2(s[0], s[1]); o.y = pk2(s[2], s[3]); o.z = pk2(s[4], s[5]); o.w = pk2(s[6], s[7]);
                    *(u32x4*)(basep + (size_t)n * 8192) = o;
                    const u32x4 kv = kvv[j];
                    s[0] = s[0] * cd + bflo(kv.x); s[1] = s[1] * cd + bfhi(kv.x); s[2] = s[2] * cd + bflo(kv.y); s[3] = s[3] * cd + bfhi(kv.y);
                    s[4] = s[4] * cd + bflo(kv.z); s[5] = s[5] * cd + bfhi(kv.z); s[6] = s[6] * cd + bflo(kv.w); s[7] = s[7] * cd + bfhi(kv.w);
                }
            }
        }
    }
    {
        const bf16_t* Z2T = (const bf16_t*)(p.ws + WS_D);
        bf16_t* Yc = (bf16_t*)(p.ws + WS_C);
        const float* og = p.in[15];
        LAS unsigned* Tl = (LAS unsigned*)lds;
        for (int it = blockIdx.x; it < NTOK / 64; it += gridDim.x) {
            const int tok0 = it * 64;
            __syncthreads();
            {
                const bf16_t* src = Z2T + (size_t)tid * NTOK + tok0;
#pragma unroll
                for (int q = 0; q < 8; ++q) { const u32x4 x = *(const u32x4*)(src + 8 * q);
                    Tl[tid * 33 + 4 * q] = x.x; Tl[tid * 33 + 4 * q + 1] = x.y; Tl[tid * 33 + 4 * q + 2] = x.z; Tl[tid * 33 + 4 * q + 3] = x.w; }
            }
            __syncthreads();
            LAS const bf16_t* Tb = (LAS const bf16_t*)lds;
            float ogv[8];
#pragma unroll
            for (int j = 0; j < 8; ++j) ogv[j] = og[lane + 64 * j];
#pragma unroll 4
            for (int q = 0; q < 8; ++q) {
                const int tt = wave * 8 + q;
                float v[8]; float ss = 0.f;
#pragma unroll
                for (int j = 0; j < 8; ++j) { v[j] = bf1(Tb[(lane + 64 * j) * 66 + tt]); ss += v[j] * v[j]; }
                ss = wave_sum(ss);
                const float rs = 1.0f / sqrtf(ss * (1.0f / 512.0f) + EPS);
#pragma unroll
                for (int j = 0; j < 8; ++j) { const float o = v[j] * rs * ogv[j]; Yc[(size_t)(tok0 + tt) * DM + lane + 64 * j] = (bf16_t)(pk2(o, 0.f) & 0xffff); }
            }
        }
    }
}

struct RoRegs { bf16x8 q[2][2]; u32x4 vx[2][2], kx[2][2], sx[2][2]; };
__device__ __forceinline__ void ret_out_load(const Params& p, int pair, int tid, RoRegs& r) {
    const int wave = tid >> 6, lane = tid & 63, fr = lane & 15, fq = lane >> 4;
    const int bh = pair >> 4, n0 = (pair & 15) * 2, b = bh >> 3, h = bh & 7, t0 = 16 * wave;
    const bf16_t* Pr = (const bf16_t*)p.out;
    const bf16_t* KV = (const bf16_t*)(p.ws + WS_KV);
#pragma unroll
    for (int sub = 0; sub < 2; ++sub) {
        const size_t tok0 = (size_t)b * SEQL + (n0 + sub) * 128;
        const bf16_t* Sf = KV + ((size_t)(bh * 32 + n0 + sub) * 2 + 0) * 4096;
#pragma unroll
        for (int kk = 0; kk < 2; ++kk) r.q[sub][kk] = *(const bf16x8*)(Pr + (tok0 + t0 + fr) * RCOLS + 64 * h + 32 * kk + 8 * fq);
#pragma unroll
        for (int it2 = 0; it2 < 2; ++it2) {
            const int idx = tid + 512 * it2, i = idx >> 3, dc = idx & 7;
            r.vx[sub][it2] = *(const u32x4*)(Pr + (tok0 + i) * RCOLS + 1024 + 64 * h + 8 * dc);
            r.kx[sub][it2] = *(const u32x4*)(Pr + (tok0 + i) * RCOLS + 512 + 64 * h + 8 * dc);
            r.sx[sub][it2] = *(const u32x4*)(Sf + (size_t)idx * 8);
        }
    }
}
__device__ __forceinline__ void ret_out_pair(const Params& p, LAS unsigned char* lds, int pair, RoRegs& cur, int nxt_pair) {
    const int tid = opaque_tid(), wave = tid >> 6, lane = tid & 63, fr = lane & 15, fq = lane >> 4;
    const int bh = pair >> 4, n0 = (pair & 15) * 2, b = bh >> 3, h = bh & 7;
    const bf16_t* Pr = (const bf16_t*)p.out;
    bf16_t* Yc = (bf16_t*)(p.ws + WS_C);
    constexpr int KS = 72;
    constexpr int IMG = 64 * TS + 128 * KS + 128 * KS;
    const float lf = lg2f_fwd(h), lb = lg2f_bwd(h);
    const int t0 = 16 * wave;
    bf16x8 qr2[2][2];
#pragma unroll
    for (int sub = 0; sub < 2; ++sub)
#pragma unroll
        for (int kk = 0; kk < 2; ++kk) qr2[sub][kk] = cur.q[sub][kk];
    __syncthreads();
#pragma unroll
    for (int sub = 0; sub < 2; ++sub) {
        LAS bf16_t* VT = (LAS bf16_t*)lds + sub * IMG; LAS bf16_t* KL = VT + 64 * TS; LAS bf16_t* SL = KL + 128 * KS;
#pragma unroll
        for (int it2 = 0; it2 < 2; ++it2) {
            const int idx = tid + 512 * it2, i = idx >> 3, dc = idx & 7;
            const u32x4 vx = cur.vx[sub][it2];
            *(LAS u32x4*)(KL + i * KS + 8 * dc) = cur.kx[sub][it2];
            *(LAS u32x4*)(SL + (idx >> 3) * KS + 8 * dc) = cur.sx[sub][it2];
            const unsigned vv[4] = {vx.x, vx.y, vx.z, vx.w};
#pragma unroll
            for (int j = 0; j < 4; ++j) { VT[(8 * dc + 2 * j) * TS + i] = (bf16_t)(vv[j] & 0xffff); VT[(8 * dc + 2 * j + 1) * TS + i] = (bf16_t)(vv[j] >> 16); }
        }
    }
    if (nxt_pair >= 0) ret_out_load(p, nxt_pair, tid, cur);
    __syncthreads();
#pragma unroll 1
    for (int sub = 0; sub < 2; ++sub) {
    const size_t tok0 = (size_t)b * SEQL + (n0 + sub) * 128;
    LAS const bf16_t* VT = (LAS const bf16_t*)lds + sub * IMG; LAS const bf16_t* KL = VT + 64 * TS; LAS const bf16_t* SL = KL + 128 * KS;
    bf16x8 qr[2]; qr[0] = sub ? qr2[1][0] : qr2[0][0]; qr[1] = sub ? qr2[1][1] : qr2[0][1];
    bf16_t gates[4][4];
#pragma unroll
    for (int r = 0; r < 4; ++r)
#pragma unroll
        for (int et = 0; et < 4; ++et) gates[r][et] = Pr[(tok0 + t0 + 4 * fq + r) * RCOLS + 1536 + 64 * h + 16 * et + fr];
    f32x4 st[8];
#pragma unroll
    for (int a = 0; a < 8; ++a) {
        st[a] = (f32x4){0.f, 0.f, 0.f, 0.f};
#pragma unroll
        for (int kk = 0; kk < 2; ++kk) { const bf16x8 kr = *(LAS const bf16x8*)(KL + (16 * a + fr) * KS + 32 * kk + 8 * fq); st[a] = MFMA16(kr, qr[kk], st[a]); }
        const int it = t0 + fr;
#pragma unroll
        for (int r = 0; r < 4; ++r) { const int is = 16 * a + 4 * fq + r; const int diff = it - is;
            const float dm = __builtin_amdgcn_exp2f((diff >= 0) ? (float)diff * lf : (float)(-diff) * lb); st[a][r] *= dm; }
    }
    f32x4 oi[4], of[4], ob[4];
#pragma unroll
    for (int et = 0; et < 4; ++et) { oi[et] = (f32x4){0.f, 0.f, 0.f, 0.f}; of[et] = oi[et]; ob[et] = oi[et]; }
#pragma unroll
    for (int kb = 0; kb < 4; ++kb) {
        bf16x8 pa;
        { const unsigned a0 = pk2(st[2 * kb][0], st[2 * kb][1]), a1 = pk2(st[2 * kb][2], st[2 * kb][3]), a2 = pk2(st[2 * kb + 1][0], st[2 * kb + 1][1]), a3 = pk2(st[2 * kb + 1][2], st[2 * kb + 1][3]);
          u32x4 t; t.x = a0; t.y = a1; t.z = a2; t.w = a3; pa = __builtin_bit_cast(bf16x8, t); }
#pragma unroll
        for (int et = 0; et < 4; ++et) {
            const u32x2 v0 = *(LAS const u32x2*)(VT + (16 * et + fr) * TS + 32 * kb + 4 * fq);
            const u32x2 v1 = *(LAS const u32x2*)(VT + (16 * et + fr) * TS + 32 * kb + 16 + 4 * fq);
            u32x4 t; t.x = v0.x; t.y = v0.y; t.z = v1.x; t.w = v1.y;
            oi[et] = MFMA16(pa, __builtin_bit_cast(bf16x8, t), oi[et]);
        }
    }
#pragma unroll
    for (int et = 0; et < 4; ++et)
#pragma unroll
        for (int kk = 0; kk < 2; ++kk) {
            const bf16x8 sf = *(LAS const bf16x8*)(SL + (16 * et + fr) * KS + 32 * kk + 8 * fq);
            const bf16x8 sb = *(LAS const bf16x8*)(SL + (64 + 16 * et + fr) * KS + 32 * kk + 8 * fq);
            of[et] = MFMA16(qr[kk], sf, of[et]); ob[et] = MFMA16(qr[kk], sb, ob[et]);
        }
    const float* gg = p.in[16] + 64 * h; const float* gb = p.in[17] + 64 * h;
#pragma unroll
    for (int r = 0; r < 4; ++r) {
        const int i = t0 + 4 * fq + r;
        const float qdf = __builtin_amdgcn_exp2f((float)(i + 1) * lf), qdb = __builtin_amdgcn_exp2f((float)(128 - i) * lb);
        float o[4]; float s = 0.f;
#pragma unroll
        for (int et = 0; et < 4; ++et) { o[et] = oi[et][r] + qdf * of[et][r] + qdb * ob[et][r]; s += o[et]; }
        s += dppf<0x128>(s); s += dppf<0x124>(s); s += dppf<0x122>(s); s += dppf<0x121>(s);
        const float mu = s * (1.0f / 64.0f);
        float vs = 0.f;
#pragma unroll
        for (int et = 0; et < 4; ++et) { o[et] -= mu; vs += o[et] * o[et]; }
        vs += dppf<0x128>(vs); vs += dppf<0x124>(vs); vs += dppf<0x122>(vs); vs += dppf<0x121>(vs);
        const float rstd = __builtin_amdgcn_rsqf(vs * (1.0f / 64.0f) + EPS);
        const size_t tok = tok0 + i;
#pragma unroll
        for (int et = 0; et < 4; ++et) {
            const int e = 16 * et + fr;
            const float gate = bf1(gates[r][et]);
            const float y = (o[et] * rstd * gg[e] + gb[e]) * (gate * __builtin_amdgcn_rcpf(1.0f + __builtin_amdgcn_exp2f(-1.4426950409f * gate)));
            Yc[tok * DM + 512 + 64 * h + e] = (bf16_t)(pk2(y, 0.f) & 0xffff);
        }
    }
    }
}
__device__ __forceinline__ float gelu_tanh(float x) {
    const float u = 0.7978845608028654f * (x + 0.044715f * x * x * x);
    return x / (1.0f + __expf(-2.0f * u));
}
__device__ __forceinline__ void unpack8(const u32x4 x, float (&v)[8]) {
    v[0] = bflo(x.x); v[1] = bfhi(x.x); v[2] = bflo(x.y); v[3] = bfhi(x.y); v[4] = bflo(x.z); v[5] = bfhi(x.z); v[6] = bflo(x.w); v[7] = bfhi(x.w);
}
__device__ __forceinline__ void phase_i(const Params& p, int g0) {
    const bf16_t* U = (const bf16_t*)p.out;
    bf16_t* G = (bf16_t*)(p.ws + WS_B);
    const float* cw = p.in[21]; const float* cb = p.in[22];
    constexpr int NCH = DFF / 4, RUN = 8;
    const int tid = opaque_tid();
    for (int id = blockIdx.x * 512 + tid; id < (GROUP_TOK / RUN) * NCH; id += gridDim.x * 512) {
        const int cc = id % NCH, run = id / NCH, ca = 4 * cc, cbcol = DFF + 4 * cc;
        const int l0 = run * RUN;
        const int t0 = (g0 + l0) & (SEQL - 1);
        u32x2 ra[RUN + 2], rb[RUN + 2];
#pragma unroll
        for (int q = 0; q < RUN + 2; ++q) {
            const bool valid = (q == 0) ? (t0 > 0) : ((q == RUN + 1) ? (t0 + RUN < SEQL) : true);
            ra[q] = (u32x2){0u, 0u}; rb[q] = (u32x2){0u, 0u};
            if (valid) { const bf16_t* rowp = U + (size_t)(l0 - 1 + q) * UPC; ra[q] = *(const u32x2*)(rowp + ca); rb[q] = *(const u32x2*)(rowp + cbcol); }
        }
        f32x4 wa[3], wb[3];
#pragma unroll
        for (int k = 0; k < 3; ++k) { wa[k] = *(const f32x4*)(cw + k * UPC + ca); wb[k] = *(const f32x4*)(cw + k * UPC + cbcol); }
        const f32x4 ba = *(const f32x4*)(cb + ca), bb = *(const f32x4*)(cb + cbcol);
#pragma unroll
        for (int q = 0; q < RUN; ++q) {
            f32x4 pa, ca_, na, pb, cb_, nb;
            pa[0] = bflo(ra[q].x); pa[1] = bfhi(ra[q].x); pa[2] = bflo(ra[q].y); pa[3] = bfhi(ra[q].y);
            ca_[0] = bflo(ra[q + 1].x); ca_[1] = bfhi(ra[q + 1].x); ca_[2] = bflo(ra[q + 1].y); ca_[3] = bfhi(ra[q + 1].y);
            na[0] = bflo(ra[q + 2].x); na[1] = bfhi(ra[q + 2].x); na[2] = bflo(ra[q + 2].y); na[3] = bfhi(ra[q + 2].y);
            pb[0] = bflo(rb[q].x); pb[1] = bfhi(rb[q].x); pb[2] = bflo(rb[q].y); pb[3] = bfhi(rb[q].y);
            cb_[0] = bflo(rb[q + 1].x); cb_[1] = bfhi(rb[q + 1].x); cb_[2] = bflo(rb[q + 1].y); cb_[3] = bfhi(rb[q + 1].y);
            nb[0] = bflo(rb[q + 2].x); nb[1] = bfhi(rb[q + 2].x); nb[2] = bflo(rb[q + 2].y); nb[3] = bfhi(rb[q + 2].y);
            const f32x4 av = wa[0] * pa + wa[1] * ca_ + wa[2] * na + ba;
            const f32x4 bv = wb[0] * pb + wb[1] * cb_ + wb[2] * nb + bb;
            u32x2 ov; ov.x = pk2(gelu_tanh(av[0]) * bv[0], gelu_tanh(av[1]) * bv[1]); ov.y = pk2(gelu_tanh(av[2]) * bv[2], gelu_tanh(av[3]) * bv[3]);
            *(u32x2*)(G + (size_t)(g0 + l0 + q) * DFF + ca) = ov;
        }
    }
}
__device__ __forceinline__ void phase_k(const Params& p) {
    const int tid = opaque_tid(), wave = tid >> 6, lane = tid & 63;
    const float* part = (const float*)(p.ws + WS_P3); const float* fg = p.in[24];
    f32x4 g[4];
#pragma unroll
    for (int j = 0; j < 4; ++j) g[j] = *(const f32x4*)(fg + 256 * j + 4 * lane);
    const int NGW = gridDim.x * 8;
    for (int row0 = blockIdx.x * 8 + wave; row0 < NTOK; row0 += 2 * NGW) {
        const int row1 = (row0 + NGW < NTOK) ? row0 + NGW : row0;
        float ss0 = (lane < 16) ? part[(size_t)row0 * 16 + lane] : 0.f, ss1 = (lane < 16) ? part[(size_t)row1 * 16 + lane] : 0.f;
        const bf16_t* y0 = y_row(p.ws, row0); const bf16_t* y1 = y_row(p.ws, row1);
        u32x2 v0[4], v1[4];
#pragma unroll
        for (int j = 0; j < 4; ++j) { v0[j] = *(const u32x2*)(y0 + 256 * j + 4 * lane); v1[j] = *(const u32x2*)(y1 + 256 * j + 4 * lane); }
        ss0 = wave_sum(ss0); ss1 = wave_sum(ss1);
        const float rs0 = 1.0f / sqrtf(ss0 * (1.0f / DM) + EPS), rs1 = 1.0f / sqrtf(ss1 * (1.0f / DM) + EPS);
        float* o0 = p.out + (size_t)row0 * DM; float* o1 = p.out + (size_t)row1 * DM;
#pragma unroll
        for (int j = 0; j < 4; ++j) { f32x4 v; v[0] = bflo(v0[j].x); v[1] = bfhi(v0[j].x); v[2] = bflo(v0[j].y); v[3] = bfhi(v0[j].y); *(f32x4*)(o0 + 256 * j + 4 * lane) = v * g[j] * rs0; }
        if (row1 != row0) {
#pragma unroll
            for (int j = 0; j < 4; ++j) { f32x4 v; v[0] = bflo(v1[j].x); v[1] = bfhi(v1[j].x); v[2] = bflo(v1[j].y); v[3] = bfhi(v1[j].y); *(f32x4*)(o1 + 256 * j + 4 * lane) = v * g[j] * rs1; }
        }
    }
}


__device__ __forceinline__ void diag_dump_bf16(const Params& p, const bf16_t* src) {
    for (size_t i = (size_t)blockIdx.x * 512 + threadIdx.x; i < (size_t)NTOK * DM; i += (size_t)gridDim.x * 512) p.out[i] = bf1(src[i]);
}
__device__ __forceinline__ void diag_dump_c(const Params& p) {
    const bf16_t* PhT = (const bf16_t*)(p.ws + WS_C);
    for (size_t i = (size_t)blockIdx.x * 512 + threadIdx.x; i < (size_t)NTOK * DM; i += (size_t)gridDim.x * 512) {
        const unsigned u = ((const unsigned*)p.out)[i]; const size_t tok = i >> 10; const int c = (int)(i & 1023);
        p.out[i] = bflo(u) + bfhi(u) + bf1(PhT[(size_t)c * NTOK + tok]) + bf1(PhT[(size_t)(c + 512) * NTOK + tok]);
    }
}

__device__ __forceinline__ void gsync(const Params& p, int k) {
#if USE_CG_SYNC
    cg::this_grid().sync();
#else
    __syncthreads();
    if (threadIdx.x == 0) {
        unsigned* bar = (unsigned*)(p.ws + WS_BAR);
        const unsigned gen = (unsigned)k * gridDim.x;
        __hip_atomic_fetch_add(bar, 1u, __ATOMIC_RELEASE, __HIP_MEMORY_SCOPE_AGENT);
        while (__hip_atomic_load(bar, __ATOMIC_ACQUIRE, __HIP_MEMORY_SCOPE_AGENT) < gen) __builtin_amdgcn_s_sleep(2);
    }
    __syncthreads();
#endif
}
__global__ void __launch_bounds__(512, 2) fwd_megakernel(Params p) {
    extern __shared__ __attribute__((aligned(16))) unsigned char shm[];
    LAS unsigned char* lds = (LAS unsigned char*)shm;
    unsigned char* ws = p.ws;
    pg8::StaticOrder S;
    const int G = gridDim.x, c = blockIdx.x;

    phase_a(p, lds);
    if (PROBE == 5) { __syncthreads(); phase_a(p, lds); }
    gsync(p, 1);
    phase_rf(p);
    __syncthreads();
#pragma unroll 1
    for (int rep = 0; rep < (PROBE == 2 ? 2 : 1); ++rep) {
    {
        pg8::Gemm g{(const bf16_t*)(ws + WS_WIN), (const bf16_t*)(ws + WS_A), HCOLS, NTOK, DM, 0};
        EpiHy E{(bf16_t*)(ws + WS_C), (const float*)(ws + WS_RS1)};
        S.init(g.M, g.N, G, c); pg8::gemm_phase(lds, g, S, E);
    }
    {
        pg8::Gemm g{(const bf16_t*)(ws + WS_A), (const bf16_t*)(ws + WS_WIN) + (size_t)HCOLS * DM, NTOK, RCOLS, DM, 0};
        EpiRet E{(bf16_t*)p.out, (const float*)(ws + WS_RS1), (const float*)(ws + WS_CS)};
        S.init(g.M, g.N, G, c); pg8::gemm_phase(lds, g, S, E);
    }
    }
    if (PROBE == 7) {
        EpiNull E{(float*)(ws + WS_BAR + 512)};
        pg8::Gemm g{(const bf16_t*)(ws + WS_A), (const bf16_t*)(ws + WS_WUP), 16384, 3072, DM, 0}; S.init(g.M, g.N, G, c); pg8::gemm_phase(lds, g, S, E);
    }
    if (PROBE == 4) {
        EpiNull E{(float*)(ws + WS_BAR + 512)};
        { pg8::Gemm g{(const bf16_t*)(ws + WS_WIN), (const bf16_t*)(ws + WS_A), HCOLS, NTOK, DM, 0}; S.init(g.M, g.N, G, c); pg8::gemm_phase(lds, g, S, E); }
        { pg8::Gemm g{(const bf16_t*)(ws + WS_A), (const bf16_t*)(ws + WS_WIN) + (size_t)HCOLS * DM, NTOK, RCOLS, DM, 0}; S.init(g.M, g.N, G, c); pg8::gemm_phase(lds, g, S, E); }
    }
    gsync(p, 3);
    if (DIAG == 3) { diag_dump_c(p); return; }
    if (DIAG == 32) {
        const bf16_t* Pr = (const bf16_t*)p.out; float* scr = (float*)(ws + WS_D);
        for (int i = blockIdx.x * 512 + threadIdx.x; i < 384 * 2048; i += gridDim.x * 512) {
            const int n = i >> 11, col = i & 2047; float a = 0.f;
            for (int r = 0; r < 128; ++r) a += bf1(Pr[(size_t)(n * 128 + r) * RCOLS + col]) * (float)(1 + (r & 3));
            scr[i] = a; }
        gsync(p, 4);
        for (size_t i = (size_t)blockIdx.x * 512 + threadIdx.x; i < (size_t)NTOK * DM; i += (size_t)gridDim.x * 512) p.out[i] = (i < 384 * 2048) ? scr[i] : 0.f;
        return; }
    phase_d(p, lds);
    gsync(p, 4);
    if (DIAG == 47) { const unsigned* KVu = (const unsigned*)(ws + WS_A);
        for (size_t i = (size_t)blockIdx.x * 512 + threadIdx.x; i < (size_t)NTOK * DM; i += (size_t)gridDim.x * 512) {
            float v = 0.f;
            if (i < (size_t)96 * 32 * 4096) { const unsigned u = __hip_atomic_load(KVu + i, __ATOMIC_RELAXED, __HIP_MEMORY_SCOPE_AGENT); v = bflo(u) + 2.0f * bfhi(u); }
            p.out[i] = v; }
        return; }
    if (DIAG == 44 || DIAG == 45 || DIAG == 46) { const bf16_t* KV = (const bf16_t*)(ws + WS_A);
        for (size_t i = (size_t)blockIdx.x * 512 + threadIdx.x; i < (size_t)NTOK * DM; i += (size_t)gridDim.x * 512) p.out[i] = (i < (size_t)96 * 32 * 2 * 4096) ? bf1(KV[i]) : 0.f;
        return; }
    phase_e(p, lds);
    gsync(p, 5);
    if (DIAG == 5) { const bf16_t* Yc = (const bf16_t*)(ws + WS_C);
        for (size_t i = (size_t)blockIdx.x * 512 + threadIdx.x; i < (size_t)NTOK * DM; i += (size_t)gridDim.x * 512) p.out[i] = bf1(Yc[(i & ~(size_t)1023) + (i & 511)]);
        return; }
    if (DIAG == 55) { const bf16_t* KV = (const bf16_t*)(ws + WS_A);
        for (size_t i = (size_t)blockIdx.x * 512 + threadIdx.x; i < (size_t)NTOK * DM; i += (size_t)gridDim.x * 512) p.out[i] = (i < (size_t)96 * 32 * 2 * 4096) ? bf1(KV[i]) : 0.f;
        return; }
    {
        RoRegs rr;
        if ((int)blockIdx.x < 96 * 16) ret_out_load(p, blockIdx.x, opaque_tid(), rr);
#pragma unroll 1
        for (int it = blockIdx.x; it < 96 * 16; it += gridDim.x) { const int nx = it + (int)gridDim.x; ret_out_pair(p, lds, it, rr, nx < 96 * 16 ? nx : -1); }
    }
    gsync(p, 6);
    if (DIAG == 6) { diag_dump_bf16(p, (const bf16_t*)(ws + WS_C)); return; }
    {
        pg8::Gemm g{(const bf16_t*)(ws + WS_C), (const bf16_t*)(ws + WS_WOUT), NTOK, DM, DM, 0};
        EpiOut E{(bf16_t*)(ws + WS_A), (float*)(ws + WS_P2), (LAS float*)(lds + 131072)};
        S.init(g.M, g.N, G, c); pg8::gemm_phase(lds, g, S, E);
    }
    gsync(p, 7);
    if (DIAG == 7) { diag_dump_bf16(p, (const bf16_t*)(ws + WS_A)); return; }
    {
        pg8::Gemm g{(const bf16_t*)(ws + WS_A), (const bf16_t*)(ws + WS_WUP), 12 * 17 * 256, UPC, DM, 17};
        EpiFfn E{(bf16_t*)(ws + WS_B), (const float*)(ws + WS_P2), p.in[21], p.in[22], (LAS float*)(lds + 131072)};
        S.init(g.M, g.N, G, c, 2); pg8::gemm_phase(lds, g, S, E);
    }
    gsync(p, 8);
    {
        pg8::Gemm g{(const bf16_t*)(ws + WS_B), (const bf16_t*)(ws + WS_WDN), NTOK, DM, DFF, 0};
        EpiDown E{ws, (const bf16_t*)(ws + WS_A), (float*)(ws + WS_P3)};
        S.init(g.M, g.N, G, c); pg8::gemm_phase(lds, g, S, E);
    }
    gsync(p, 9);
    phase_k(p);
}

extern "C" void kernel_launch(void* const* d_in, const int* in_sizes, int n_in, void* d_out, int out_size, void* d_ws, size_t ws_size, hipStream_t stream) {
    static int grid_blocks = 0;
    if (grid_blocks == 0) {
        if (n_in != 25 || out_size != NTOK * DM || ws_size < WS_END) { fprintf(stderr, "kernel_launch: unexpected shapes (n_in %d out %d ws %zu)\n", n_in, out_size, ws_size); grid_blocks = -1; return; }
        int dev = 0, cus = 0, per_cu = 0;
        hipGetDevice(&dev);
        hipDeviceGetAttribute(&cus, hipDeviceAttributeMultiprocessorCount, dev);
        hipFuncSetAttribute((const void*)fwd_megakernel, hipFuncAttributeMaxDynamicSharedMemorySize, LDS_BYTES);
        hipOccupancyMaxActiveBlocksPerMultiprocessor(&per_cu, (const void*)fwd_megakernel, 512, LDS_BYTES);
        if (per_cu < 1) { fprintf(stderr, "kernel_launch: occupancy query reports %d blocks per CU\n", per_cu); grid_blocks = -1; return; }
        if (per_cu > 1) per_cu = 1;
        grid_blocks = cus * per_cu;
    }
    if (grid_blocks < 0) return;
    Params p{};
    for (int i = 0; i < 25; ++i) p.in[i] = (const float*)d_in[i];
    p.out = (float*)d_out; p.ws = (unsigned char*)d_ws;
    void* args[] = {&p};
    hipError_t e = hipLaunchCooperativeKernel((const void*)fwd_megakernel, dim3(grid_blocks), dim3(512), args, LDS_BYTES, stream);
    if (e != hipSuccess) fprintf(stderr, "cooperative launch failed: %s (grid %d)\n", hipGetErrorString(e), grid_blocks);
}
```

```cpp
#include <hip/hip_runtime.h>
#include <hip/hip_cooperative_groups.h>
#include <cstdio>
namespace cg = cooperative_groups;

#define LAS __attribute__((address_space(3)))
typedef unsigned short bf16_t;
typedef short bf16x8 __attribute__((ext_vector_type(8)));
typedef float f32x4 __attribute__((ext_vector_type(4)));
typedef unsigned u32x4 __attribute__((ext_vector_type(4)));
typedef unsigned u32x2 __attribute__((ext_vector_type(2)));

constexpr int NTOK = 49152, NTOK_P = 32768, DM = 1024, SEQL = 4096, NBATCH = 12;
constexpr int HCOLS = 1536, RCOLS = 2048, DFF = 2816, UPC = 5632;
constexpr int GROUP_TOK = 16384;
constexpr size_t MiB = 1u << 20;
constexpr size_t WS_WIN = 0, WS_WOUT = 7 * MiB, WS_WUP = 9 * MiB, WS_WDN = 20 * MiB;
constexpr size_t WS_A = 26 * MiB;
constexpr size_t WS_B = 122 * MiB;
constexpr size_t WS_C = 250 * MiB;
constexpr size_t WS_D = 394 * MiB;
constexpr size_t WS_S = 466 * MiB;
constexpr size_t WS_RS1 = WS_S, WS_CS = WS_S + 1 * MiB, WS_H3T = WS_S + 2 * MiB, WS_P2 = WS_S + 3 * MiB, WS_P3 = WS_S + 6 * MiB, WS_BAR = WS_S + 9 * MiB, WS_END = 492 * MiB;
constexpr size_t WS_W4T = WS_S + 9 * MiB + 4096;
constexpr size_t WS_KV = WS_B + 32 * MiB;
constexpr size_t WS_Y1 = 386 * MiB, WS_Y2 = 476 * MiB; constexpr int Y_SPLIT = 40960;
constexpr int LDS_BYTES = 139264;
constexpr float EPS = 1e-6f;
#ifndef USE_CG_SYNC
#define USE_CG_SYNC 1
#endif
#ifndef PROBE
#define PROBE 0
#endif
#ifndef DIAG
#define DIAG 0
#endif

struct Params { const float* in[25]; float* out; unsigned char* ws; };

typedef __bf16 bf16v2 __attribute__((ext_vector_type(2)));
typedef float f32v2 __attribute__((ext_vector_type(2)));
__device__ __forceinline__ unsigned pk2(float lo, float hi) { f32v2 v = {lo, hi}; bf16v2 b = __builtin_convertvector(v, bf16v2); return __builtin_bit_cast(unsigned, b); }
__device__ __forceinline__ float bflo(unsigned u) { return __uint_as_float(u << 16); }
__device__ __forceinline__ float bfhi(unsigned u) { return __uint_as_float(u & 0xffff0000u); }
__device__ __forceinline__ float bf1(bf16_t b) { return __uint_as_float(((unsigned)b) << 16); }
__device__ __forceinline__ float wave_sum(float v) {
#pragma unroll
    for (int o = 1; o < 64; o <<= 1) v += __shfl_xor(v, o);
    return v;
}
__device__ __forceinline__ int opaque_tid() { int t = threadIdx.x; asm volatile("" : "+v"(t)); return t; }
template <int CTRL> __device__ __forceinline__ float dppf(float x) { return __builtin_bit_cast(float, __builtin_amdgcn_update_dpp(0, __builtin_bit_cast(int, x), CTRL, 0xF, 0xF, false)); }
__device__ __forceinline__ bf16_t* y_row(unsigned char* ws, int row) { return (row < Y_SPLIT) ? (bf16_t*)(ws + WS_Y1) + (size_t)row * DM : (bf16_t*)(ws + WS_Y2) + (size_t)(row - Y_SPLIT) * DM; }
#define LDS_WAIT() asm volatile("s_waitcnt lgkmcnt(0)" ::: "memory")

namespace pg8 {
constexpr int BM = 256, BK = 64, HALF = 128, HTB = HALF * BK * 2, NXCD = 8, WGM = 4;
__device__ __forceinline__ int lds_byte(int r, int c) { const int st = (r >> 4) * 2 + (c >> 5), rr = r & 15, cc = c & 31, ob = rr * 64 + cc * 2; return st * 1024 + (ob ^ (((ob >> 9) & 1) << 5)); }
__device__ __forceinline__ void stage_rc(int b, int& R, int& C) { const int st = b / 1024, sb = b % 1024, swz = sb ^ (((sb >> 9) & 1) << 5); R = (st >> 1) * 16 + swz / 64; C = (st & 1) * 32 + (swz % 64) / 2; }
__device__ __forceinline__ int perm32(int rho) { const int n = rho >> 4, i = rho & 15; return 8 * (i >> 2) + 4 * n + (i & 3); }
struct Unit { int pm, pn; };
struct Gemm { const bf16_t* A; const bf16_t* Bt; int M, N, K; int mtps; };
__device__ __forceinline__ long a_row0(const Gemm& g, int pm) { return g.mtps ? ((long)(pm / g.mtps) * 4096 + (long)(pm % g.mtps) * 254 - 1) : (long)pm * 256; }
struct StaticOrder {
    int nM, nN, nwg, G, c, wgm;
    __device__ void init(int M, int N, int G_, int c_, int wgm_ = WGM) { nM = M / BM; nN = N / BM; nwg = nM * nN; G = G_; c = c_; wgm = wgm_; }
    __device__ bool next(int i, Unit& u) const {
        const long L = (long)i * G + c; if (L >= nwg) return false;
        int wgid = (int)L; { const int q = nwg / NXCD, r = nwg % NXCD, xcd = wgid % NXCD, off = wgid / NXCD; wgid = (xcd < r ? xcd * (q + 1) : r * (q + 1) + (xcd - r) * q) + off; }
        const int nig = wgm * nN, gid = wgid / nig, fm = gid * wgm, gsz = (nM - fm) < wgm ? (nM - fm) : wgm;
        u.pm = fm + ((wgid % nig) % gsz); u.pn = (wgid % nig) / gsz; return true;
    }
};
template <class Epi>
__device__ __forceinline__ void gemm_phase(LAS unsigned char* lds, const Gemm g, const StaticOrder& S, const Epi& E) {
    const int tid = opaque_tid(), wid = __builtin_amdgcn_readfirstlane(tid >> 6), lane = tid & 63, wr = wid >> 2, wc = wid & 3, fr = lane & 15, fq = lane >> 4;
    const int K = g.K, nt = K / BK;
    unsigned voffA[2]; int voffB[2], voffB1[2];
#pragma unroll
    for (int i = 0; i < 2; ++i) { int R, C; stage_rc(tid * 16 + i * 8192, R, C);
        int Rb = R, Rb1 = R;
        if (Epi::BMAP == 1) { Rb = (R & ~31) + perm32(R & 31); Rb1 = Rb; }
        if (Epi::BMAP == 2) { Rb = (R & ~0x30) | ((R & 0x10) << 1) | ((R & 0x20) >> 1); Rb1 = Rb; }
        if (Epi::BMAP == 3) { Rb = 64 * (R >> 5) + perm32(R & 31); Rb1 = Rb + 32 - 128; }
        voffA[i] = (unsigned)(R * K + C) * 2u; voffB[i] = (Rb * K + C) * 2; voffB1[i] = (Rb1 * K + C) * 2; }
    const size_t kstep = (size_t)(BK * 2);
    const size_t hstep = (size_t)HALF * K * 2;
    const size_t tstep = 2 * hstep;
    const unsigned ldsw = (unsigned)wid * 1024u;
    const int aoff = lds_byte(wr * 64 + fr, fq * 8), boff = lds_byte(wc * 32 + fr, fq * 8);
#define PG8_SA(b, h) (((b) * 2 + (h)) * HTB)
#define PG8_SB(b, h) ((4 + (b) * 2 + (h)) * HTB)
#define PG8_STAGE(bufoff, gbase, voff) do { _Pragma("unroll") for (int _i = 0; _i < 2; ++_i) \
        __builtin_amdgcn_global_load_lds((const unsigned*)((const char*)(gbase) + (long)(voff)[_i]), (LAS unsigned*)(lds + (bufoff) + ldsw + _i * 8192), 16, 0, 0); } while (0)
#define PG8_LDA(dst, b, h) do { _Pragma("unroll") for (int m = 0; m < 4; ++m) _Pragma("unroll") for (int k = 0; k < 2; ++k) dst[m][k] = *(const LAS bf16x8*)(lds + PG8_SA(b, h) + aoff + m * 2048 + k * 1024); } while (0)
#define PG8_LDB(dst, b, h) do { _Pragma("unroll") for (int n = 0; n < 2; ++n) _Pragma("unroll") for (int k = 0; k < 2; ++k) dst[n][k] = *(const LAS bf16x8*)(lds + PG8_SB(b, h) + boff + n * 2048 + k * 1024); } while (0)
#define PG8_MMA(ai, bj, At, Bt) do { __builtin_amdgcn_s_setprio(1); _Pragma("unroll") for (int m = 0; m < 4; ++m) _Pragma("unroll") for (int n = 0; n < 2; ++n) _Pragma("unroll") for (int k = 0; k < 2; ++k) \
        acc[ai][bj][m][n] = __builtin_amdgcn_mfma_f32_16x16x32_bf16(Bt[n][k], At[m][k], acc[ai][bj][m][n], 0, 0, 0); __builtin_amdgcn_s_setprio(0); } while (0)
#define PG8_WAIT_V(n) asm volatile("s_waitcnt vmcnt(" #n ")" ::: "memory")
#define PG8_WAIT_L(n) asm volatile("s_waitcnt lgkmcnt(" #n ")" ::: "memory")
#define PG8_BAR __builtin_amdgcn_s_barrier()
#define PG8_SCHED __builtin_amdgcn_sched_barrier(0)
    Unit cur, nxt; int ui = 0;
    if (!S.next(0, cur)) return;
    f32x4 acc[2][2][4][2];
#pragma unroll
    for (int a = 0; a < 2; ++a)
#pragma unroll
        for (int b = 0; b < 2; ++b)
#pragma unroll
            for (int m = 0; m < 4; ++m)
#pragma unroll
                for (int n = 0; n < 2; ++n) acc[a][b][m][n] = (f32x4){0.f, 0.f, 0.f, 0.f};
    bf16x8 At[4][2], B0[2][2], B1[2][2];
    const char* cA = (const char*)g.A + a_row0(g, cur.pm) * (long)K * 2; const char* cB = (const char*)g.Bt + (size_t)cur.pn * tstep;
    PG8_STAGE(PG8_SB(0, 0), cB, voffB); PG8_STAGE(PG8_SA(0, 0), cA, voffA); PG8_STAGE(PG8_SB(0, 1), cB + hstep, voffB1); PG8_STAGE(PG8_SA(0, 1), cA + hstep, voffA);
    if (wr == 1) PG8_BAR;
    PG8_WAIT_V(4); PG8_BAR;
    PG8_STAGE(PG8_SB(1, 0), cB + kstep, voffB); PG8_STAGE(PG8_SA(1, 0), cA + kstep, voffA); PG8_STAGE(PG8_SB(1, 1), cB + hstep + kstep, voffB1);
    PG8_WAIT_V(6); PG8_BAR;
    for (;;) {
        const bool has_next = S.next(ui + 1, nxt);
        const char* nA = has_next ? (const char*)g.A + a_row0(g, nxt.pm) * (long)K * 2 : cA; const char* nB = has_next ? (const char*)g.Bt + (size_t)nxt.pn * tstep : cB;
        for (int t = 0; t < nt; t += 2) {
            const bool last = (t == nt - 2);
            const char* a1 = cA + (size_t)(t + 1) * kstep;
            const char* a2 = last ? nA : cA + (size_t)(t + 2) * kstep; const char* b2 = last ? nB : cB + (size_t)(t + 2) * kstep;
            const char* a3 = a2 + kstep; const char* b3 = b2 + kstep;
            PG8_LDB(B0, 0, 0); PG8_SCHED; PG8_LDA(At, 0, 0); PG8_STAGE(PG8_SA(1, 1), a1 + hstep, voffA);
            PG8_WAIT_L(8); PG8_BAR; PG8_WAIT_L(0); PG8_MMA(0, 0, At, B0); PG8_BAR; PG8_SCHED;
            PG8_LDB(B1, 0, 1); PG8_STAGE(PG8_SB(0, 0), b2, voffB);
            PG8_BAR; PG8_WAIT_L(0); PG8_MMA(0, 1, At, B1); PG8_BAR;
            PG8_LDA(At, 0, 1); PG8_STAGE(PG8_SA(0, 0), a2, voffA);
            PG8_BAR; PG8_WAIT_L(0); PG8_MMA(1, 0, At, B0); PG8_BAR; PG8_SCHED;
            PG8_STAGE(PG8_SB(0, 1), b2 + hstep, voffB1);
            PG8_WAIT_V(6); PG8_BAR; PG8_MMA(1, 1, At, B1); PG8_BAR;
            PG8_LDB(B0, 1, 0); PG8_SCHED; PG8_LDA(At, 1, 0); PG8_STAGE(PG8_SA(0, 1), a2 + hstep, voffA);
            PG8_WAIT_L(8); PG8_BAR; PG8_WAIT_L(0); PG8_MMA(0, 0, At, B0); PG8_BAR; PG8_SCHED;
            PG8_LDB(B1, 1, 1); PG8_STAGE(PG8_SB(1, 0), b3, voffB);
            PG8_BAR; PG8_WAIT_L(0); PG8_MMA(0, 1, At, B1); PG8_BAR;
            PG8_LDA(At, 1, 1); PG8_STAGE(PG8_SA(1, 0), a3, voffA);
            PG8_BAR; PG8_WAIT_L(0); PG8_MMA(1, 0, At, B0); PG8_BAR; PG8_SCHED;
            PG8_STAGE(PG8_SB(1, 1), b3 + hstep, voffB1);
            PG8_WAIT_V(6); PG8_BAR; PG8_MMA(1, 1, At, B1); PG8_BAR;
        }
        if (wr == 0) PG8_BAR;
        E(acc, cur, wr, wc, fr, fq);
        if (wr == 1) PG8_BAR;
        if (!has_next) break;
#pragma unroll
        for (int a = 0; a < 2; ++a)
#pragma unroll
            for (int b = 0; b < 2; ++b)
#pragma unroll
                for (int m = 0; m < 4; ++m)
#pragma unroll
                    for (int n = 0; n < 2; ++n) acc[a][b][m][n] = (f32x4){0.f, 0.f, 0.f, 0.f};
        cur = nxt; cA = nA; cB = nB; ++ui;
    }
    PG8_WAIT_V(0);
    if (wr == 0) PG8_BAR;
    PG8_BAR;
#undef PG8_SA
#undef PG8_SB
#undef PG8_STAGE
#undef PG8_LDA
#undef PG8_LDB
#undef PG8_MMA
#undef PG8_WAIT_V
#undef PG8_WAIT_L
#undef PG8_BAR
#undef PG8_SCHED
}
}
using pg8::Unit; using pg8::HALF; using pg8::BM;

struct EpiHy {
    static constexpr int BMAP = 1;
    bf16_t* O; const float* rs1;
    __device__ __forceinline__ void operator()(f32x4 (&acc)[2][2][4][2], const Unit& u, int wr, int wc, int fr, int fq) const {
        const int row0 = u.pm * BM + wr * 64 + fr, col0 = u.pn * BM + wc * 32 + 8 * fq;
        f32x4 sc[2][2];
#pragma unroll
        for (int bj = 0; bj < 2; ++bj) { sc[bj][0] = *(const f32x4*)(rs1 + col0 + bj * HALF); sc[bj][1] = *(const f32x4*)(rs1 + col0 + bj * HALF + 4); }
#pragma unroll
        for (int bj = 0; bj < 2; ++bj) {
#pragma unroll
            for (int ai = 0; ai < 2; ++ai)
#pragma unroll
                for (int m = 0; m < 4; ++m) {
                    const f32x4 v0 = acc[ai][bj][m][0] * sc[bj][0], v1 = acc[ai][bj][m][1] * sc[bj][1];
                    u32x4 o; o.x = pk2(v0[0], v0[1]); o.y = pk2(v0[2], v0[3]); o.z = pk2(v1[0], v1[1]); o.w = pk2(v1[2], v1[3]);
                    *(u32x4*)(O + (size_t)(row0 + ai * HALF + m * 16) * NTOK + col0 + bj * HALF) = o;
                }
        }
    }
};
struct EpiRet {
    static constexpr int BMAP = 3;
    bf16_t* O; const float* rs1; const float* cs;
    __device__ __forceinline__ void operator()(f32x4 (&acc)[2][2][4][2], const Unit& u, int wr, int wc, int fr, int fq) const {
        const int row0 = u.pm * BM + wr * 64 + fr;
        const bool rot = u.pn < 4; const float ksc = (u.pn >= 2 && u.pn < 4) ? 0.125f : 1.0f;
#pragma unroll
        for (int ai = 0; ai < 2; ++ai) {
            f32x4 cv[4][2], sv[4][2]; float rsv[4];
#pragma unroll
            for (int m = 0; m < 4; ++m) {
                const int row = row0 + ai * HALF + m * 16;
                rsv[m] = rs1[row];
                const float* cp = cs + (size_t)(row & (SEQL - 1)) * 64 + 8 * fq;
                cv[m][0] = *(const f32x4*)cp; cv[m][1] = *(const f32x4*)(cp + 4); sv[m][0] = *(const f32x4*)(cp + 32); sv[m][1] = *(const f32x4*)(cp + 36);
            }
            if (!rot) {
#pragma unroll
                for (int m = 0; m < 4; ++m) { cv[m][0] = cv[m][1] = (f32x4){1.f, 1.f, 1.f, 1.f}; sv[m][0] = sv[m][1] = (f32x4){0.f, 0.f, 0.f, 0.f}; }
            }
#pragma unroll
            for (int m = 0; m < 4; ++m) {
                const int row = row0 + ai * HALF + m * 16;
                const float rs = rsv[m] * ksc;
                u32x4 a, b2;
                {
                    const f32x4 x1 = acc[ai][0][m][0] * rs, x2 = acc[ai][1][m][0] * rs;
                    const f32x4 o1 = x1 * cv[m][0] - x2 * sv[m][0], o2 = x2 * cv[m][0] + x1 * sv[m][0];
                    a.x = pk2(o1[0], o1[1]); a.y = pk2(o1[2], o1[3]); b2.x = pk2(o2[0], o2[1]); b2.y = pk2(o2[2], o2[3]);
                }
                {
                    const f32x4 x1 = acc[ai][0][m][1] * rs, x2 = acc[ai][1][m][1] * rs;
                    const f32x4 o1 = x1 * cv[m][1] - x2 * sv[m][1], o2 = x2 * cv[m][1] + x1 * sv[m][1];
                    a.z = pk2(o1[0], o1[1]); a.w = pk2(o1[2], o1[3]); b2.z = pk2(o2[0], o2[1]); b2.w = pk2(o2[2], o2[3]);
                }
                bf16_t* pp = O + (size_t)row * RCOLS + u.pn * BM + 64 * wc + 8 * fq;
                *(u32x4*)pp = a; *(u32x4*)(pp + 32) = b2;
            }
        }
    }
};
struct EpiOut {
    static constexpr int BMAP = 1;
    bf16_t* O; float* part; LAS float* X;
    __device__ __forceinline__ void operator()(f32x4 (&acc)[2][2][4][2], const Unit& u, int wr, int wc, int fr, int fq) const {
        const int row0 = u.pm * BM + wr * 64 + fr, col0 = u.pn * BM + wc * 32 + 8 * fq;
#pragma unroll
        for (int ai = 0; ai < 2; ++ai) {
            u32x4 xr4[4][2];
#pragma unroll
            for (int m = 0; m < 4; ++m)
#pragma unroll
                for (int bj = 0; bj < 2; ++bj) xr4[m][bj] = *(const u32x4*)(O + (size_t)(row0 + ai * HALF + m * 16) * DM + col0 + bj * HALF);
#pragma unroll
            for (int m = 0; m < 4; ++m) {
                const int row = row0 + ai * HALF + m * 16;
                float ss = 0.f;
#pragma unroll
                for (int bj = 0; bj < 2; ++bj) {
                    u32x4* px = (u32x4*)(O + (size_t)row * DM + col0 + bj * HALF);
                    const u32x4 xr = xr4[m][bj];
                    f32x4 v0 = acc[ai][bj][m][0], v1 = acc[ai][bj][m][1];
                    v0[0] += bflo(xr.x); v0[1] += bfhi(xr.x); v0[2] += bflo(xr.y); v0[3] += bfhi(xr.y);
                    v1[0] += bflo(xr.z); v1[1] += bfhi(xr.z); v1[2] += bflo(xr.w); v1[3] += bfhi(xr.w);
                    ss += v0[0] * v0[0] + v0[1] * v0[1] + v0[2] * v0[2] + v0[3] * v0[3] + v1[0] * v1[0] + v1[1] * v1[1] + v1[2] * v1[2] + v1[3] * v1[3];
                    u32x4 o; o.x = pk2(v0[0], v0[1]); o.y = pk2(v0[2], v0[3]); o.z = pk2(v1[0], v1[1]); o.w = pk2(v1[2], v1[3]);
                    *px = o;
                }
                ss += __shfl_xor(ss, 16); ss += __shfl_xor(ss, 32);
                if (fq == 0) X[(ai * HALF + wr * 64 + m * 16 + fr) * 4 + wc] = ss;
            }
        }
        LDS_WAIT(); __builtin_amdgcn_s_barrier(); asm volatile("" ::: "memory");
        if (wr == 0) {
            const int r = wc * 64 + fq * 16 + fr;
            const f32x4 v = *(LAS const f32x4*)(X + r * 4);
            part[(size_t)(u.pm * BM + r) * 4 + u.pn] = (v[0] + v[1]) + (v[2] + v[3]);
        }
    }
};
struct EpiUp {
    static constexpr int BMAP = 1;
    bf16_t* O; const float* part; int row_base;
    __device__ __forceinline__ void operator()(f32x4 (&acc)[2][2][4][2], const Unit& u, int wr, int wc, int fr, int fq) const {
        const int row0 = u.pm * BM + wr * 64 + fr, col0 = u.pn * BM + wc * 32 + 8 * fq;
#pragma unroll
        for (int ai = 0; ai < 2; ++ai)
#pragma unroll
            for (int m = 0; m < 4; ++m) {
                const int row = row0 + ai * HALF + m * 16;
                const f32x4* pp = (const f32x4*)(part + (size_t)(row + row_base) * 16);
                const f32x4 p0 = pp[0], p1 = pp[1], p2 = pp[2], p3 = pp[3];
                const float ss = ((p0[0] + p0[1]) + (p0[2] + p0[3])) + ((p1[0] + p1[1]) + (p1[2] + p1[3])) + ((p2[0] + p2[1]) + (p2[2] + p2[3])) + ((p3[0] + p3[1]) + (p3[2] + p3[3]));
                const float rs = 1.0f / sqrtf(ss * (1.0f / DM) + EPS);
#pragma unroll
                for (int bj = 0; bj < 2; ++bj) {
                    const f32x4 v0 = acc[ai][bj][m][0] * rs, v1 = acc[ai][bj][m][1] * rs;
                    u32x4 o; o.x = pk2(v0[0], v0[1]); o.y = pk2(v0[2], v0[3]); o.z = pk2(v1[0], v1[1]); o.w = pk2(v1[2], v1[3]);
                    *(u32x4*)(O + (size_t)row * UPC + col0 + bj * HALF) = o;
                }
            }
    }
};

template <int CTRL> __device__ __forceinline__ f32x4 dpp4(f32x4 v) { f32x4 r; r[0] = dppf<CTRL>(v[0]); r[1] = dppf<CTRL>(v[1]); r[2] = dppf<CTRL>(v[2]); r[3] = dppf<CTRL>(v[3]); return r; }
__device__ __forceinline__ f32x4 gelu_fast4(f32x4 x) {
    f32x4 t = x * x; t = t * (-0.10294324f) + (-2.3022082f); t = t * x;
    f32x4 e; e[0] = __builtin_amdgcn_exp2f(t[0]); e[1] = __builtin_amdgcn_exp2f(t[1]); e[2] = __builtin_amdgcn_exp2f(t[2]); e[3] = __builtin_amdgcn_exp2f(t[3]);
    e = e + 1.0f;
    f32x4 r; r[0] = __builtin_amdgcn_rcpf(e[0]); r[1] = __builtin_amdgcn_rcpf(e[1]); r[2] = __builtin_amdgcn_rcpf(e[2]); r[3] = __builtin_amdgcn_rcpf(e[3]);
    return x * r;
}
__device__ __forceinline__ float gelu_fast(float x) {
    const float e = __builtin_amdgcn_exp2f(x * (-2.3022082f + -0.10294324f * x * x));
    return x * __builtin_amdgcn_rcpf(1.0f + e);
}
struct EpiFfn {
    static constexpr int BMAP = 1;
    bf16_t* Gout; const float* part; const float* cw; const float* cb; LAS float* X;
    __device__ __forceinline__ void operator()(f32x4 (&acc)[2][2][4][2], const Unit& u, int wr, int wc, int fr, int fq) const {
        const int seq = u.pm / 17, tbase = (u.pm % 17) * 254 - 1;
        const int colh = u.pn * 128 + wc * 32 + 8 * fq;
        f32x4 pq[2][4];
#pragma unroll
        for (int ai = 0; ai < 2; ++ai)
#pragma unroll
            for (int m = 0; m < 4; ++m) {
                const int t = tbase + 128 * ai + 64 * wr + 16 * m + fr;
                const int tc = t < 0 ? 0 : (t >= SEQL ? SEQL - 1 : t);
                pq[ai][m] = *(const f32x4*)(part + (size_t)(seq * SEQL + tc) * 4);
            }
#pragma unroll
        for (int ai = 0; ai < 2; ++ai)
#pragma unroll
            for (int m = 0; m < 4; ++m) {
                const int t = tbase + 128 * ai + 64 * wr + 16 * m + fr;
                const float ss = (pq[ai][m][0] + pq[ai][m][1]) + (pq[ai][m][2] + pq[ai][m][3]);
                const float rs = (t >= 0 && t < SEQL) ? __builtin_amdgcn_rsqf(ss * (1.0f / DM) + EPS) : 0.f;
#pragma unroll
                for (int bj = 0; bj < 2; ++bj)
#pragma unroll
                    for (int n = 0; n < 2; ++n) acc[ai][bj][m][n] = acc[ai][bj][m][n] * rs;
            }
#pragma unroll
        for (int ai = 0; ai < 2; ++ai)
#pragma unroll
            for (int bj = 0; bj < 2; ++bj)
#pragma unroll
                for (int n = 0; n < 2; ++n) {
                    LAS float* xb = X + ((2 * ai + wr) * 2) * 256 + bj * 128 + wc * 32 + 8 * fq + 4 * n;
                    if (fr == 0) *(LAS f32x4*)xb = acc[ai][bj][0][n];
                    if (fr == 15) *(LAS f32x4*)(xb + 256) = acc[ai][bj][3][n];
                }
        LDS_WAIT(); __builtin_amdgcn_s_barrier(); asm volatile("" ::: "memory");
#pragma unroll
        for (int n = 0; n < 2; ++n) {
            const int ca = colh + 4 * n;
            f32x4 wa[3], wb[3];
#pragma unroll
            for (int k = 0; k < 3; ++k) { wa[k] = *(const f32x4*)(cw + k * UPC + ca); wb[k] = *(const f32x4*)(cw + k * UPC + DFF + ca); }
            const f32x4 ba = *(const f32x4*)(cb + ca), bb = *(const f32x4*)(cb + DFF + ca);
#pragma unroll
            for (int ai = 0; ai < 2; ++ai) {
                const int strip = 2 * ai + wr;
                f32x4 xp[2], xn[2];
#pragma unroll
                for (int bj = 0; bj < 2; ++bj) {
                    LAS const float* xb = X + bj * 128 + wc * 32 + 8 * fq + 4 * n;
                    xp[bj] = (strip > 0) ? *(LAS const f32x4*)(xb + ((strip - 1) * 2 + 1) * 256) : (f32x4){0.f, 0.f, 0.f, 0.f};
                    xn[bj] = (strip < 3) ? *(LAS const f32x4*)(xb + ((strip + 1) * 2) * 256) : (f32x4){0.f, 0.f, 0.f, 0.f};
                }
#pragma unroll
                for (int m = 0; m < 4; ++m) {
                    f32x4 y[2];
#pragma unroll
                    for (int bj = 0; bj < 2; ++bj) {
                        const f32x4 cur = acc[ai][bj][m][n];
                        const f32x4 up = (m > 0) ? acc[ai][bj][m - 1][n] : xp[bj];
                        const f32x4 dn = (m < 3) ? acc[ai][bj][m + 1][n] : xn[bj];
                        f32x4 su, sd;
#pragma unroll
                        for (int j = 0; j < 4; ++j) { su[j] = (fr == 15) ? up[j] : cur[j]; sd[j] = (fr == 0) ? dn[j] : cur[j]; }
                        const f32x4 prev = dpp4<0x121>(su);
                        const f32x4 next = dpp4<0x12F>(sd);
                        y[bj] = bj ? (wb[0] * prev + wb[1] * cur + wb[2] * next + bb) : (wa[0] * prev + wa[1] * cur + wa[2] * next + ba);
                    }
                    const int lr = 128 * ai + 64 * wr + 16 * m + fr, t = tbase + lr;
                    const f32x4 gv = gelu_fast4(y[0]) * y[1];
                    u32x2 o; o.x = pk2(gv[0], gv[1]); o.y = pk2(gv[2], gv[3]);
                    if (lr >= 1 && lr <= 254 && t < SEQL) *(u32x2*)(Gout + (size_t)(seq * SEQL + t) * DFF + ca) = o;
                }
            }
        }
    }
};
struct EpiDown {
    static constexpr int BMAP = 1;
    unsigned char* ws; const bf16_t* X1; float* part;
    __device__ __forceinline__ void operator()(f32x4 (&acc)[2][2][4][2], const Unit& u, int wr, int wc, int fr, int fq) const {
        const int row0 = u.pm * BM + wr * 64 + fr, col0 = u.pn * BM + wc * 32 + 8 * fq;
#pragma unroll
        for (int ai = 0; ai < 2; ++ai) {
            u32x4 xr4[4][2];
#pragma unroll
            for (int m = 0; m < 4; ++m)
#pragma unroll
                for (int bj = 0; bj < 2; ++bj) xr4[m][bj] = *(const u32x4*)(X1 + (size_t)(row0 + ai * HALF + m * 16) * DM + col0 + bj * HALF);
#pragma unroll
            for (int m = 0; m < 4; ++m) {
                const int row = row0 + ai * HALF + m * 16;
                bf16_t* yr = y_row(ws, row);
                float ss = 0.f;
#pragma unroll
                for (int bj = 0; bj < 2; ++bj) {
                    const int col = col0 + bj * HALF;
                    const u32x4 xr = xr4[m][bj];
                    f32x4 v0 = acc[ai][bj][m][0], v1 = acc[ai][bj][m][1];
                    v0[0] += bflo(xr.x); v0[1] += bfhi(xr.x); v0[2] += bflo(xr.y); v0[3] += bfhi(xr.y);
                    v1[0] += bflo(xr.z); v1[1] += bfhi(xr.z); v1[2] += bflo(xr.w); v1[3] += bfhi(xr.w);
                    ss += v0[0] * v0[0] + v0[1] * v0[1] + v0[2] * v0[2] + v0[3] * v0[3] + v1[0] * v1[0] + v1[1] * v1[1] + v1[2] * v1[2] + v1[3] * v1[3];
                    u32x4 o; o.x = pk2(v0[0], v0[1]); o.y = pk2(v0[2], v0[3]); o.z = pk2(v1[0], v1[1]); o.w = pk2(v1[2], v1[3]);
                    *(u32x4*)(yr + col) = o;
                }
                ss += __shfl_xor(ss, 16); ss += __shfl_xor(ss, 32);
                if (fq == 0) part[(size_t)row * 16 + u.pn * 4 + wc] = ss;
            }
        }
    }
};

struct EpiNull { static constexpr int BMAP = 1;
    __device__ __forceinline__ void operator()(f32x4 (&acc)[2][2][4][2], const Unit& u, int wr, int wc, int fr, int fq) const {
        float s = 0.f;
#pragma unroll
        for (int ai = 0; ai < 2; ++ai)
#pragma unroll
            for (int bj = 0; bj < 2; ++bj)
#pragma unroll
                for (int m = 0; m < 4; ++m)
#pragma unroll
                    for (int n = 0; n < 2; ++n) s += acc[ai][bj][m][n][0] + acc[ai][bj][m][n][1] + acc[ai][bj][m][n][2] + acc[ai][bj][m][n][3];
        if (s == 123.456f) *sink = s;
    }
    float* sink; };
template <int UPPERM>
__device__ __forceinline__ void transpose_item(const float* W, const float* gk, int K, int N, bf16_t* WT, LAS float* scr, int item, int lane) {
    const int nblk = N / 32, kb = item / nblk, nb = item % nblk, k0 = 64 * kb, n0 = 32 * nb;
#pragma unroll 16
    for (int i = 0; i < 32; ++i) { const int kk = 2 * i + (lane >> 5); const float s = gk ? gk[k0 + kk] : 1.0f; scr[kk * 33 + (lane & 31)] = W[(size_t)(k0 + kk) * N + n0 + (lane & 31)] * s; }
    LDS_WAIT();
    const int c = lane & 7;
#pragma unroll
    for (int j = 0; j < 4; ++j) { const int n = (lane >> 3) + 8 * j; const LAS float* s = scr + (8 * c) * 33 + n;
        u32x4 o; o.x = pk2(s[0 * 33], s[1 * 33]); o.y = pk2(s[2 * 33], s[3 * 33]); o.z = pk2(s[4 * 33], s[5 * 33]); o.w = pk2(s[6 * 33], s[7 * 33]);
        int nr = n0 + n;
        if (UPPERM) { const int oo = nr < DFF ? nr : nr - DFF; nr = 256 * (oo >> 7) + (oo & 127) + (nr < DFF ? 0 : 128); }
        *(u32x4*)(WT + (size_t)nr * K + k0 + 8 * c) = o; }
    LDS_WAIT();
}
__device__ __forceinline__ void phase_a(const Params& p, LAS unsigned char* lds) {
    const int tid = opaque_tid(), wave = tid >> 6, lane = tid & 63;
    const int gw = blockIdx.x * 8 + wave, NGW = gridDim.x * 8;
    unsigned char* ws = p.ws;
    LAS float* scr = (LAS float*)(lds + wave * 8704);
    constexpr int I_IN = 16 * (3584 / 32), I_OUT = 16 * 32, I_UP = 16 * (UPC / 32), I_DN = (DFF / 64) * 32;
    constexpr int I_T = I_IN + I_OUT + I_UP + I_DN, I_H3 = SEQL, I_X = NTOK;
    for (int it = gw; it < I_T + I_H3; it += NGW) {
        int r = it;
        if (r < I_IN) { transpose_item<0>(p.in[3], p.in[2], DM, 3584, (bf16_t*)(ws + WS_WIN), scr, r, lane); continue; } r -= I_IN;
        if (r < I_OUT) { transpose_item<0>(p.in[18], nullptr, DM, DM, (bf16_t*)(ws + WS_WOUT), scr, r, lane); continue; } r -= I_OUT;
        if (r < I_UP) { transpose_item<1>(p.in[20], p.in[19], DM, UPC, (bf16_t*)(ws + WS_WUP), scr, r, lane); continue; } r -= I_UP;
        if (r < I_DN) { transpose_item<0>(p.in[23], nullptr, DFF, DM, (bf16_t*)(ws + WS_WDN), scr, r, lane); continue; } r -= I_DN;
        if (r < I_H3) {
            const int l = r; const float fl = (float)l;
            float z = 0.f;
            if (lane == 0) z = fl * (1.0f / 4095.0f);
            else if (lane < 33) { const int bi = (lane - 1) & 15; const float band = 1e-4f + (float)bi * ((15.0f - 1e-4f) / 15.0f);
                const float ang = (6.283185307179586f / 4096.0f) * fl * band; z = (lane < 17) ? cosf(ang) : -sinf(ang); }
            const float fr = p.in[12][lane];
            float a = p.in[7][lane];
            for (int e = 0; e < 33; ++e) a += __shfl(z, e) * p.in[6][e * 64 + lane];
            float h = sinf(fr * a);
            a = p.in[9][lane];
            for (int e = 0; e < 64; ++e) a += __shfl(h, e) * p.in[8][e * 64 + lane];
            h = sinf(fr * a);
            a = p.in[11][lane];
            for (int e = 0; e < 64; ++e) a += __shfl(h, e) * p.in[10][e * 64 + lane];
            h = sinf(fr * a);
            ((float*)(ws + WS_H3T))[lane * SEQL + l] = h;
            continue;
        }
        (void)r;
    }
    for (int row0 = gw; row0 < I_X; row0 += 2 * NGW) {
        const int row1 = row0 + NGW; const bool has1 = row1 < I_X;
        const int rr1 = has1 ? row1 : row0;
        const float* xr0 = (row0 < NTOK_P) ? p.in[0] + (size_t)row0 * DM : p.in[1] + (size_t)(row0 - NTOK_P) * DM;
        const float* xr1 = (rr1 < NTOK_P) ? p.in[0] + (size_t)rr1 * DM : p.in[1] + (size_t)(rr1 - NTOK_P) * DM;
        f32x4 v0[4], v1[4]; float s0 = 0.f, s1 = 0.f;
#pragma unroll
        for (int j = 0; j < 4; ++j) { v0[j] = *(const f32x4*)(xr0 + 256 * j + 4 * lane); v1[j] = *(const f32x4*)(xr1 + 256 * j + 4 * lane); }
#pragma unroll
        for (int j = 0; j < 4; ++j) { s0 += v0[j][0] * v0[j][0] + v0[j][1] * v0[j][1] + v0[j][2] * v0[j][2] + v0[j][3] * v0[j][3]; s1 += v1[j][0] * v1[j][0] + v1[j][1] * v1[j][1] + v1[j][2] * v1[j][2] + v1[j][3] * v1[j][3]; }
        s0 = wave_sum(s0); s1 = wave_sum(s1);
        if (lane == 0) { ((float*)(ws + WS_RS1))[row0] = 1.0f / sqrtf(s0 * (1.0f / DM) + EPS); if (has1) ((float*)(ws + WS_RS1))[row1] = 1.0f / sqrtf(s1 * (1.0f / DM) + EPS); }
        bf16_t* xb0 = (bf16_t*)(ws + WS_A) + (size_t)row0 * DM; bf16_t* xb1 = (bf16_t*)(ws + WS_A) + (size_t)rr1 * DM;
#pragma unroll
        for (int j = 0; j < 4; ++j) { u32x2 o; o.x = pk2(v0[j][0], v0[j][1]); o.y = pk2(v0[j][2], v0[j][3]); *(u32x2*)(xb0 + 256 * j + 4 * lane) = o; }
        if (has1) {
#pragma unroll
            for (int j = 0; j < 4; ++j) { u32x2 o; o.x = pk2(v1[j][0], v1[j][1]); o.y = pk2(v1[j][2], v1[j][3]); *(u32x2*)(xb1 + 256 * j + 4 * lane) = o; }
        }
    }
    for (int e = blockIdx.x * 512 + tid; e < 64 * 2048; e += gridDim.x * 512) ((float*)(ws + WS_W4T))[e] = p.in[13][(e & 63) * 2048 + (e >> 6)];
    for (int e = blockIdx.x * 512 + tid; e < SEQL * 32; e += gridDim.x * 512) {
        const int t = e >> 5, i = e & 31;
        const float inv = powf(10000.0f, -(float)(2 * i) / 64.0f);
        const float ang = (float)t * inv;
        float* cs = (float*)(ws + WS_CS) + (size_t)t * 64;
        cs[i] = cosf(ang); cs[32 + i] = sinf(ang);
    }
}
__device__ __forceinline__ void phase_b(const Params& p) {
    const int tid = opaque_tid();
    const float* h3t = (const float*)(p.ws + WS_H3T); const float* w4 = p.in[13];
    float* hft = (float*)(p.ws + WS_D);
    for (int it = blockIdx.x; it < 256 * 8; it += gridDim.x) {
        const int cg8 = it >> 3, l = (it & 7) * 512 + tid, col0 = cg8 * 8;
        float a[8];
#pragma unroll
        for (int j = 0; j < 8; ++j) a[j] = 0.f;
        for (int k = 0; k < 64; ++k) {
            const float hv = h3t[k * SEQL + l];
            const f32x4 w0 = *(const f32x4*)(w4 + k * 2048 + col0), w1 = *(const f32x4*)(w4 + k * 2048 + col0 + 4);
            a[0] += hv * w0[0]; a[1] += hv * w0[1]; a[2] += hv * w0[2]; a[3] += hv * w0[3];
            a[4] += hv * w1[0]; a[5] += hv * w1[1]; a[6] += hv * w1[2]; a[7] += hv * w1[3];
        }
        const float tl = (float)l * (1.0f / 4095.0f);
        const float d0 = -15.350567286626973f, d1 = -3.0701134573253945f;
#pragma unroll
        for (int j = 0; j < 8; ++j) {
            const int c = (col0 + j) & 511;
            const float delta = fabsf(d0 + (float)c * ((d1 - d0) / 511.0f));
            hft[(size_t)(col0 + j) * SEQL + l] = a[j] * expf(-tl * delta);
        }
    }
}
__device__ __forceinline__ void phase_toep(const Params& p) {
    const int tid = opaque_tid();
    const float* hft = (const float*)(p.ws + WS_D); const float* bias = p.in[14];
    bf16_t* T = (bf16_t*)(p.ws + WS_B);
    for (int it = blockIdx.x; it < 2048; it += gridDim.x) {
        const int oc = it >> 1, sh = it & 1;
        const float* hf = hft + (size_t)oc * SEQL; const float* hb = hft + (size_t)(1024 + oc) * SEQL;
        const float bz = bias[oc];
        for (int up = tid; up < 1024; up += 512) {
            float v[8];
#pragma unroll
            for (int j = 0; j < 8; ++j) {
                const int m = 8 * (up - 512) + j + sh, d = -m;
                float x = 0.f;
                if (d >= 0 && d < SEQL) x = hf[d]; else if (d < 0 && d > -SEQL) x = hb[-d];
                if (d == 0) x += bz;
                v[j] = x;
            }
            u32x4 o; o.x = pk2(v[0], v[1]); o.y = pk2(v[2], v[3]); o.z = pk2(v[4], v[5]); o.w = pk2(v[6], v[7]);
            *(u32x4*)(T + ((size_t)it * 1024 + up) * 8) = o;
        }
    }
}

__device__ __forceinline__ void phase_rf(const Params& p) {
    const int tid = opaque_tid();
    const float* h3t = (const float*)(p.ws + WS_H3T); const float* w4t = (const float*)(p.ws + WS_W4T); const float* bias = p.in[14];
    bf16_t* T = (bf16_t*)(p.ws + WS_B);
    const float d0 = -15.350567286626973f, d1 = -3.0701134573253945f;
    for (int q = blockIdx.x; q < 256; q += gridDim.x) {
#pragma unroll 1
        for (int lp = 0; lp < 8; ++lp) {
            const int l = lp * 512 + tid;
            float h[64];
#pragma unroll
            for (int k = 0; k < 64; ++k) h[k] = h3t[k * SEQL + l];
            const float tl = (float)l * (1.0f / 4095.0f);
#pragma unroll 1
            for (int j = 0; j < 4; ++j) {
                const int oc = __builtin_amdgcn_readfirstlane(q * 4 + j), c = oc & 511;
                const float* wf = w4t + (size_t)oc * 64; const float* wb = w4t + (size_t)(1024 + oc) * 64;
                float af = 0.f, ab = 0.f;
#pragma unroll
                for (int k = 0; k < 64; ++k) { af += h[k] * wf[k]; ab += h[k] * wb[k]; }
                const float decay = expf(-tl * fabsf(d0 + (float)c * ((d1 - d0) / 511.0f)));
                af *= decay; ab *= decay;
                if (l == 0) af += bias[oc];
                const bf16_t vf = (bf16_t)(pk2(af, 0.f) & 0xffff), vb = (bf16_t)(pk2(ab, 0.f) & 0xffff);
                bf16_t* T0 = T + (size_t)(oc * 2) * 8192; bf16_t* T1 = T0 + 8192;
                T0[4096 - l] = vf; T1[4095 - l] = vf;
                if (l >= 1) { T0[4096 + l] = vb; T1[4095 + l] = vb; }
                else { T0[0] = 0; T1[8191] = 0; }
            }
        }
    }
}

constexpr int ZS = 4112;
#define MFMA16(a, b, c) __builtin_amdgcn_mfma_f32_16x16x32_bf16(a, b, c, 0, 0, 0)
typedef u32x4 u32x4_a4 __attribute__((aligned(4)));
__device__ __forceinline__ bf16x8 ld_filt(LAS const bf16_t* q) {
    const u32x4 v = *(LAS const u32x4_a4*)q;
    return __builtin_bit_cast(bf16x8, v);
}
__device__ __forceinline__ void hyena_group(LAS const bf16_t* Rl, LAS const bf16_t* Zl, int g, f32x4 (&acc)[16]) {
    bf16x8 Aw[16];
#pragma unroll
    for (int i = 0; i < 16; ++i) { Aw[i] = ld_filt(Rl - 16 * (16 * g + i)); acc[i] = (f32x4){0.f, 0.f, 0.f, 0.f}; }
    bf16x8 Bz = *(LAS const bf16x8*)(Zl);
    for (int q = 0; q < 16; ++q) {
#pragma unroll
        for (int e = 0; e < 8; ++e) {
            const int sg = 8 * q + e;
            const int dn = 16 * g - 2 * ((sg + 1) & 127);
            const bf16x8 Bn = *(LAS const bf16x8*)(Zl + 32 * ((sg + 1) & 127));
            const bf16x8 An0 = ld_filt(Rl - 16 * dn);
            const bf16x8 An1 = ld_filt(Rl - 16 * (dn + 1));
            __builtin_amdgcn_sched_barrier(0);
            __builtin_amdgcn_s_setprio(1);
#pragma unroll
            for (int i = 15; i >= 0; --i) acc[i] = MFMA16(Aw[(i - 2 * e) & 15], Bz, acc[i]);
            __builtin_amdgcn_s_setprio(0);
            __builtin_amdgcn_sched_barrier(0);
            Aw[(14 - 2 * e) & 15] = An0;
            Aw[(15 - 2 * e) & 15] = An1;
            Bz = Bn;
        }
    }
}
__device__ __forceinline__ f32x4 gate4(const bf16_t* raw, int t, float w0, float w1, float w2, float cb) {
    const u32x2 x = *(const u32x2*)(raw + t);
    const float xm0 = bf1(raw[t > 0 ? t - 1 : 0]), xp0 = bf1(raw[t + 4 < SEQL ? t + 4 : SEQL - 1]);
    const float xm = (t > 0) ? xm0 : 0.f, xp = (t + 4 < SEQL) ? xp0 : 0.f;
    const float x0 = bflo(x.x), x1 = bfhi(x.x), x2 = bflo(x.y), x3 = bfhi(x.y);
    f32x4 g;
    g[0] = w0 * xm + w1 * x0 + w2 * x1 + cb; g[1] = w0 * x0 + w1 * x1 + w2 * x2 + cb;
    g[2] = w0 * x1 + w1 * x2 + w2 * x3 + cb; g[3] = w0 * x2 + w1 * x3 + w2 * xp + cb;
    return g;
}
template <int FAKE>
__device__ __forceinline__ void hyena_channel(const Params& p, LAS unsigned char* lds, int c) {
    const int tid = opaque_tid(), wave = tid >> 6, lane = tid & 63, fr = lane & 15, fq = lane >> 4;
    const bf16_t* PhT = (const bf16_t*)(p.ws + WS_C);
    const bf16_t* RFg = (const bf16_t*)(p.ws + WS_B);
    bf16_t* Z2T = (bf16_t*)(p.ws + WS_D);
    const float* cw = p.in[4]; const float* cbv = p.in[5];
    LAS bf16_t* Z = (LAS bf16_t*)lds;
    LAS bf16_t* RF = (LAS bf16_t*)(lds + NBATCH * ZS * 2);
    __syncthreads();
    for (int i = tid; i < 2048; i += 512) *(LAS u32x4*)(RF + 8 * i) = *(const u32x4*)(RFg + (size_t)(0 * 512 + c) * 16384 + 8 * i);
    {
        const float w0 = cw[c], w1 = cw[HCOLS + c], w2 = cw[2 * HCOLS + c], cb = cbv[c];
#pragma unroll 1
        for (int h6 = 0; h6 < 12; h6 += 6) {
        u32x4 xv[6]; bf16_t xm[6], xp[6];
#pragma unroll
        for (int it = 0; it < 6; ++it) {
            const int idx = tid + 512 * (it + h6), b = idx >> 9, t8 = (idx & 511) * 8;
            const bf16_t* base = PhT + (size_t)c * NTOK + b * SEQL + t8;
            xv[it] = *(const u32x4*)base; xm[it] = base[t8 > 0 ? -1 : 0]; xp[it] = base[t8 + 8 < SEQL ? 8 : 7];
        }
#pragma unroll
        for (int it = 0; it < 6; ++it) {
            const int idx = tid + 512 * (it + h6), b = idx >> 9, t8 = (idx & 511) * 8;
            const u32x4 x = xv[it];
            float v[10];
            v[0] = (t8 > 0) ? bf1(xm[it]) : 0.f; v[9] = (t8 + 8 < SEQL) ? bf1(xp[it]) : 0.f;
            v[1] = bflo(x.x); v[2] = bfhi(x.x); v[3] = bflo(x.y); v[4] = bfhi(x.y); v[5] = bflo(x.z); v[6] = bfhi(x.z); v[7] = bflo(x.w); v[8] = bfhi(x.w);
            float o[8];
#pragma unroll
            for (int j = 0; j < 8; ++j) o[j] = w0 * v[j] + w1 * v[j + 1] + w2 * v[j + 2] + cb;
            u32x4 ov; ov.x = pk2(o[0], o[1]); ov.y = pk2(o[2], o[3]); ov.z = pk2(o[4], o[5]); ov.w = pk2(o[6], o[7]);
            *(LAS u32x4*)(Z + b * ZS + t8) = ov;
        }
        }
    }
    __syncthreads();
    const int bb = (fr < NBATCH) ? fr : fr - NBATCH;
    LAS const bf16_t* Rl = (fr & 1) ? RF + 8192 + 4096 + 8 * fq - fr - 1 : RF + 4096 + 8 * fq - fr;
    if (FAKE) Rl = RF + 4096 + 8 * fq - 16;
    LAS const bf16_t* Zl = Z + bb * ZS + 8 * fq;
    f32x4 acc[16];
    {
        const int gc = 512 + c;
        const float w0 = cw[gc], w1 = cw[HCOLS + gc], w2 = cw[2 * HCOLS + gc], cb = cbv[gc];
        const bf16_t* raw = PhT + (size_t)gc * NTOK + bb * SEQL;
#pragma unroll 1
        for (int gi = 0; gi < 2; ++gi) {
            const int g = wave + 8 * gi;
            hyena_group(Rl, Zl, g, acc);
            f32x4 gts[16];
#pragma unroll
            for (int i = 0; i < 16; ++i) gts[i] = gate4(raw, 256 * g + 16 * i + 4 * fq, w0, w1, w2, cb);
#pragma unroll
            for (int i = 0; i < 16; ++i) {
                const int t = 256 * g + 16 * i + 4 * fq;
                const f32x4 zz = gts[i] * acc[i];
                u32x2 o; o.x = pk2(zz[0], zz[1]); o.y = pk2(zz[2], zz[3]);
                if (fr < NBATCH && (!FAKE || zz[0] == 123.4567f)) *(u32x2*)(Z2T + (size_t)c * NTOK + fr * SEQL + t) = o;
            }
        }
    }
    asm volatile("s_waitcnt vmcnt(0)" ::: "memory");
    __syncthreads();
    for (int i = tid; i < 2048; i += 512) *(LAS u32x4*)(RF + 8 * i) = *(const u32x4*)(RFg + (size_t)(1 * 512 + c) * 16384 + 8 * i);
#pragma unroll 1
    for (int h6 = 0; h6 < 12; h6 += 6) {
        u32x4 zv[6];
#pragma unroll
        for (int it = 0; it < 6; ++it) { const int idx = tid + 512 * (it + h6), b = idx >> 9, t8 = (idx & 511) * 8;
            zv[it] = __builtin_nontemporal_load((const u32x4*)(Z2T + (size_t)c * NTOK + b * SEQL + t8)); }
#pragma unroll
        for (int it = 0; it < 6; ++it) { const int idx = tid + 512 * (it + h6), b = idx >> 9, t8 = (idx & 511) * 8; *(LAS u32x4*)(Z + b * ZS + t8) = zv[it]; }
    }
    __syncthreads();
    {
        const int gc = 1024 + c;
        const float w0 = cw[gc], w1 = cw[HCOLS + gc], w2 = cw[2 * HCOLS + gc], cb = cbv[gc];
        const bf16_t* raw = PhT + (size_t)gc * NTOK + bb * SEQL;
#pragma unroll 1
        for (int gi = 0; gi < 2; ++gi) {
            const int g = wave + 8 * gi;
            hyena_group(Rl, Zl, g, acc);
            f32x4 gts[16];
#pragma unroll
            for (int i = 0; i < 16; ++i) gts[i] = gate4(raw, 256 * g + 16 * i + 4 * fq, w0, w1, w2, cb);
#pragma unroll
            for (int i = 0; i < 16; ++i) {
                const int t = 256 * g + 16 * i + 4 * fq;
                const f32x4 zz = gts[i] * acc[i];
                u32x2 o; o.x = pk2(zz[0], zz[1]); o.y = pk2(zz[2], zz[3]);
                if (fr < NBATCH && (!FAKE || zz[0] == 123.4567f)) *(u32x2*)(Z2T + (size_t)c * NTOK + fr * SEQL + t) = o;
            }
        }
    }
}
__device__ __forceinline__ float lg2f_fwd(int h) { return log2f(1.0f - exp2f(-5.0f - (float)h)); }
__device__ __forceinline__ float lg2f_bwd(int h) { return log2f(1.0f - exp2f(-5.5f - (float)h)); }
constexpr int TS = 136;
struct KvRegs { u32x4 kx[2], vx[2]; };
__device__ __forceinline__ void ret_kv_load(const Params& p, int item, int tid, KvRegs& r) {
    const int bh = item >> 5, n = item & 31, b = bh >> 3, h = bh & 7;
    const bf16_t* Pr = (const bf16_t*)p.out;
    const size_t tok0 = (size_t)b * SEQL + n * 128;
#pragma unroll
    for (int q = 0; q < 2; ++q) {
        const int idx = tid + 512 * q, i = idx >> 3, dc = idx & 7;
        r.kx[q] = *(const u32x4*)(Pr + (tok0 + i) * RCOLS + 512 + 64 * h + 8 * dc);
        r.vx[q] = *(const u32x4*)(Pr + (tok0 + i) * RCOLS + 1024 + 64 * h + 8 * dc);
    }
}
__device__ __forceinline__ void ret_kv_item(const Params& p, LAS unsigned char* lds, int item, KvRegs& cur, int nxt_item) {
    const int tid = opaque_tid(), wave = tid >> 6, lane = tid & 63, fr = lane & 15, fq = lane >> 4;
    const int bh = item >> 5, n = item & 31, h = bh & 7;
    bf16_t* KV = (bf16_t*)(p.ws + WS_KV);
    LAS bf16_t* KfT = (LAS bf16_t*)lds; LAS bf16_t* KbT = KfT + 64 * TS; LAS bf16_t* VT = KbT + 64 * TS;
    const float lf = lg2f_fwd(h), lb = lg2f_bwd(h);
    __syncthreads();
#pragma unroll
    for (int q = 0; q < 2; ++q) {
        const int idx = tid + 512 * q, i = idx >> 3, dc = idx & 7;
        const u32x4 kx = cur.kx[q], vx = cur.vx[q];
        const float df = __builtin_amdgcn_exp2f((float)(127 - i) * lf), db = __builtin_amdgcn_exp2f((float)i * lb);
        const unsigned kk[4] = {kx.x, kx.y, kx.z, kx.w}, vv[4] = {vx.x, vx.y, vx.z, vx.w};
#pragma unroll
        for (int j = 0; j < 4; ++j) {
            const float k0 = bflo(kk[j]), k1 = bfhi(kk[j]);
            const unsigned f = pk2(k0 * df, k1 * df), bw = pk2(k0 * db, k1 * db);
            KfT[(8 * dc + 2 * j) * TS + i] = (bf16_t)(f & 0xffff); KfT[(8 * dc + 2 * j + 1) * TS + i] = (bf16_t)(f >> 16);
            KbT[(8 * dc + 2 * j) * TS + i] = (bf16_t)(bw & 0xffff); KbT[(8 * dc + 2 * j + 1) * TS + i] = (bf16_t)(bw >> 16);
            VT[(8 * dc + 2 * j) * TS + i] = (bf16_t)(vv[j] & 0xffff); VT[(8 * dc + 2 * j + 1) * TS + i] = (bf16_t)(vv[j] >> 16);
        }
    }
    if (nxt_item >= 0) ret_kv_load(p, nxt_item, tid, cur);
    __syncthreads();
    const int dir = wave >> 2, dt = wave & 3;
    LAS const bf16_t* KT = dir ? KbT : KfT;
    bf16x8 A[4];
#pragma unroll
    for (int kk = 0; kk < 4; ++kk) A[kk] = *(LAS const bf16x8*)(KT + (16 * dt + fr) * TS + 32 * kk + 8 * fq);
    bf16_t* dst = KV + ((size_t)(bh * 32 + n) * 2 + dir) * 4096;
#pragma unroll
    for (int et = 0; et < 4; ++et) {
        f32x4 o = (f32x4){0.f, 0.f, 0.f, 0.f};
#pragma unroll
        for (int kk = 0; kk < 4; ++kk) { const bf16x8 B = *(LAS const bf16x8*)(VT + (16 * et + fr) * TS + 32 * kk + 8 * fq); o = MFMA16(A[kk], B, o); }
        u32x2 w; w.x = pk2(o[0], o[1]); w.y = pk2(o[2], o[3]);
        *(u32x2*)(dst + (16 * et + fr) * 64 + 16 * dt + 4 * fq) = w;
    }
}

__device__ __forceinline__ void ret_kv_item_simple(const Params& p, int item) {
    const int bh = item >> 5, n = item & 31, b = bh >> 3, h = bh & 7;
    const bf16_t* Pr = (const bf16_t*)p.out;
    bf16_t* KV = (bf16_t*)(p.ws + WS_KV);
    const float lf = lg2f_fwd(h), lb = lg2f_bwd(h);
    const size_t tok0 = (size_t)b * SEQL + n * 128;
    for (int o = threadIdx.x; o < 8192; o += 512) {
        const int dir = o >> 12, e = (o >> 6) & 63, d = o & 63;
        float a = 0.f;
        for (int i = 0; i < 128; ++i) {
            const float dec = dir ? exp2f((float)i * lb) : exp2f((float)(127 - i) * lf);
            const float kq = bf1((bf16_t)(pk2(bf1(Pr[(tok0 + i) * RCOLS + 512 + 64 * h + d]) * dec, 0.f) & 0xffff));
            a += kq * bf1(Pr[(tok0 + i) * RCOLS + 1024 + 64 * h + e]);
        }
        KV[((size_t)(bh * 32 + n) * 2 + dir) * 4096 + e * 64 + d] = (bf16_t)(pk2(a, 0.f) & 0xffff);
    }
}
__device__ __forceinline__ void phase_d(const Params& p, LAS unsigned char* lds) {
    if (DIAG != 45 && DIAG != 47 && DIAG != 46) {
#pragma unroll 1
        for (int c = blockIdx.x; c < 512; c += gridDim.x) hyena_channel<0>(p, lds, c);
        if (PROBE == 6) { for (int c = blockIdx.x; c < 512; c += gridDim.x) hyena_channel<1>(p, lds, c); }
        if (PROBE == 1) { for (int c = blockIdx.x; c < 512; c += gridDim.x) hyena_channel<0>(p, lds, c); }
    }
    if (DIAG == 46) { for (int it = blockIdx.x; it < 96 * 32; it += gridDim.x) ret_kv_item_simple(p, it); return; }
    {
        KvRegs kr;
        if ((int)blockIdx.x < 96 * 32) ret_kv_load(p, blockIdx.x, opaque_tid(), kr);
#pragma unroll 1
        for (int it = blockIdx.x; it < 96 * 32; it += gridDim.x) { const int nx = it + (int)gridDim.x; ret_kv_item(p, lds, it, kr, nx < 96 * 32 ? nx : -1); }
    }
}

__device__ __forceinline__ void phase_e(const Params& p, LAS unsigned char* lds) {
    const int tid = opaque_tid(), wave = tid >> 6, lane = tid & 63;
    {
        bf16_t* KV = (bf16_t*)(p.ws + WS_KV);
        for (int id = blockIdx.x * 512 + tid; id < 96 * 2 * 512; id += gridDim.x * 512) {
            const int e8 = id & 511, dir = (id >> 9) & 1, bh = id >> 10, h = bh & 7;
            const float cd = exp2f(128.0f * (dir ? lg2f_bwd(h) : lg2f_fwd(h)));
            float s[8];
#pragma unroll
            for (int j = 0; j < 8; ++j) s[j] = 0.f;
            bf16_t* basep = KV + ((size_t)(bh * 32) * 2 + dir) * 4096 + e8 * 8;
#pragma unroll 1
            for (int q0 = 0; q0 < 32; q0 += 8) {
                u32x4 kvv[8];
#pragma unroll
                for (int j = 0; j < 8; ++j) { const int n = dir ? 31 - (q0 + j) : (q0 + j); kvv[j] = *(const u32x4*)(basep + (size_t)n * 8192); }
#pragma unroll
                for (int j = 0; j < 8; ++j) {
                    const int n = dir ? 31 - (q0 + j) : (q0 + j);
                    u32x4 o; o.x = pk2(s[0], s[1]); o.y = pk2(s[2], s[3]); o.z = pk2(s[4], s[5]); o.w = pk2(s[6], s[7]);
                    *(u32x4*)(basep + (size_t)n * 8192) = o;
                    const u32x4 kv = kvv[j];
                    s[0] = s[0] * cd + bflo(kv.x); s[1] = s[1] * cd + bfhi(kv.x); s[2] = s[2] * cd + bflo(kv.y); s[3] = s[3] * cd + bfhi(kv.y);
                    s[4] = s[4] * cd + bflo(kv.z); s[5] = s[5] * cd + bfhi(kv.z); s[6] = s[6] * cd + bflo(kv.w); s[7] = s[7] * cd + bfhi(kv.w);
                }
            }
        }
    }
    {
        const bf16_t* Z2T = (const bf16_t*)(p.ws + WS_D);
        bf16_t* Yc = (bf16_t*)(p.ws + WS_C);
        const float* og = p.in[15];
        LAS unsigned* Tl = (LAS unsigned*)lds;
        for (int it = blockIdx.x; it < NTOK / 64; it += gridDim.x) {
            const int tok0 = it * 64;
            __syncthreads();
            {
                const bf16_t* src = Z2T + (size_t)tid * NTOK + tok0;
#pragma unroll
                for (int q = 0; q < 8; ++q) { const u32x4 x = *(const u32x4*)(src + 8 * q);
                    Tl[tid * 33 + 4 * q] = x.x; Tl[tid * 33 + 4 * q + 1] = x.y; Tl[tid * 33 + 4 * q + 2] = x.z; Tl[tid * 33 + 4 * q + 3] = x.w; }
            }
            __syncthreads();
            LAS const bf16_t* Tb = (LAS const bf16_t*)lds;
            float ogv[8];
#pragma unroll
            for (int j = 0; j < 8; ++j) ogv[j] = og[lane + 64 * j];
#pragma unroll 4
            for (int q = 0; q < 8; ++q) {
                const int tt = wave * 8 + q;
                float v[8]; float ss = 0.f;
#pragma unroll
                for (int j = 0; j < 8; ++j) { v[j] = bf1(Tb[(lane + 64 * j) * 66 + tt]); ss += v[j] * v[j]; }
                ss = wave_sum(ss);
                const float rs = 1.0f / sqrtf(ss * (1.0f / 512.0f) + EPS);
#pragma unroll
                for (int j = 0; j < 8; ++j) { const float o = v[j] * rs * ogv[j]; Yc[(size_t)(tok0 + tt) * DM + lane + 64 * j] = (bf16_t)(pk2(o, 0.f) & 0xffff); }
            }
        }
    }
}

struct RoRegs { bf16x8 q[2][2]; u32x4 vx[2][2], kx[2][2], sx[2][2]; };
__device__ __forceinline__ void ret_out_load(const Params& p, int pair, int tid, RoRegs& r) {
    const int wave = tid >> 6, lane = tid & 63, fr = lane & 15, fq = lane >> 4;
    const int bh = pair >> 4, n0 = (pair & 15) * 2, b = bh >> 3, h = bh & 7, t0 = 16 * wave;
    const bf16_t* Pr = (const bf16_t*)p.out;
    const bf16_t* KV = (const bf16_t*)(p.ws + WS_KV);
#pragma unroll
    for (int sub = 0; sub < 2; ++sub) {
        const size_t tok0 = (size_t)b * SEQL + (n0 + sub) * 128;
        const bf16_t* Sf = KV + ((size_t)(bh * 32 + n0 + sub) * 2 + 0) * 4096;
#pragma unroll
        for (int kk = 0; kk < 2; ++kk) r.q[sub][kk] = *(const bf16x8*)(Pr + (tok0 + t0 + fr) * RCOLS + 64 * h + 32 * kk + 8 * fq);
#pragma unroll
        for (int it2 = 0; it2 < 2; ++it2) {
            const int idx = tid + 512 * it2, i = idx >> 3, dc = idx & 7;
            r.vx[sub][it2] = *(const u32x4*)(Pr + (tok0 + i) * RCOLS + 1024 + 64 * h + 8 * dc);
            r.kx[sub][it2] = *(const u32x4*)(Pr + (tok0 + i) * RCOLS + 512 + 64 * h + 8 * dc);
            r.sx[sub][it2] = *(const u32x4*)(Sf + (size_t)idx * 8);
        }
    }
}
__device__ __forceinline__ void ret_out_pair(const Params& p, LAS unsigned char* lds, int pair, RoRegs& cur, int nxt_pair) {
    const int tid = opaque_tid(), wave = tid >> 6, lane = tid & 63, fr = lane & 15, fq = lane >> 4;
    const int bh = pair >> 4, n0 = (pair & 15) * 2, b = bh >> 3, h = bh & 7;
    const bf16_t* Pr = (const bf16_t*)p.out;
    bf16_t* Yc = (bf16_t*)(p.ws + WS_C);
    constexpr int KS = 72;
    constexpr int IMG = 64 * TS + 128 * KS + 128 * KS;
    const float lf = lg2f_fwd(h), lb = lg2f_bwd(h);
    const int t0 = 16 * wave;
    bf16x8 qr2[2][2];
#pragma unroll
    for (int sub = 0; sub < 2; ++sub)
#pragma unroll
        for (int kk = 0; kk < 2; ++kk) qr2[sub][kk] = cur.q[sub][kk];
    __syncthreads();
#pragma unroll
    for (int sub = 0; sub < 2; ++sub) {
        LAS bf16_t* VT = (LAS bf16_t*)lds + sub * IMG; LAS bf16_t* KL = VT + 64 * TS; LAS bf16_t* SL = KL + 128 * KS;
#pragma unroll
        for (int it2 = 0; it2 < 2; ++it2) {
            const int idx = tid + 512 * it2, i = idx >> 3, dc = idx & 7;
            const u32x4 vx = cur.vx[sub][it2];
            *(LAS u32x4*)(KL + i * KS + 8 * dc) = cur.kx[sub][it2];
            *(LAS u32x4*)(SL + (idx >> 3) * KS + 8 * dc) = cur.sx[sub][it2];
            const unsigned vv[4] = {vx.x, vx.y, vx.z, vx.w};
#pragma unroll
            for (int j = 0; j < 4; ++j) { VT[(8 * dc + 2 * j) * TS + i] = (bf16_t)(vv[j] & 0xffff); VT[(8 * dc + 2 * j + 1) * TS + i] = (bf16_t)(vv[j] >> 16); }
        }
    }
    if (nxt_pair >= 0) ret_out_load(p, nxt_pair, tid, cur);
    __syncthreads();
#pragma unroll 1
    for (int sub = 0; sub < 2; ++sub) {
    const size_t tok0 = (size_t)b * SEQL + (n0 + sub) * 128;
    LAS const bf16_t* VT = (LAS const bf16_t*)lds + sub * IMG; LAS const bf16_t* KL = VT + 64 * TS; LAS const bf16_t* SL = KL + 128 * KS;
    bf16x8 qr[2]; qr[0] = sub ? qr2[1][0] : qr2[0][0]; qr[1] = sub ? qr2[1][1] : qr2[0][1];
    bf16_t gates[4][4];
#pragma unroll
    for (int r = 0; r < 4; ++r)
#pragma unroll
        for (int et = 0; et < 4; ++et) gates[r][et] = Pr[(tok0 + t0 + 4 * fq + r) * RCOLS + 1536 + 64 * h + 16 * et + fr];
    f32x4 st[8];
#pragma unroll
    for (int a = 0; a < 8; ++a) {
        st[a] = (f32x4){0.f, 0.f, 0.f, 0.f};
#pragma unroll
        for (int kk = 0; kk < 2; ++kk) { const bf16x8 kr = *(LAS const bf16x8*)(KL + (16 * a + fr) * KS + 32 * kk + 8 * fq); st[a] = MFMA16(kr, qr[kk], st[a]); }
        const int it = t0 + fr;
#pragma unroll
        for (int r = 0; r < 4; ++r) { const int is = 16 * a + 4 * fq + r; const int diff = it - is;
            const float dm = __builtin_amdgcn_exp2f((diff >= 0) ? (float)diff * lf : (float)(-diff) * lb); st[a][r] *= dm; }
    }
    f32x4 oi[4], of[4], ob[4];
#pragma unroll
    for (int et = 0; et < 4; ++et) { oi[et] = (f32x4){0.f, 0.f, 0.f, 0.f}; of[et] = oi[et]; ob[et] = oi[et]; }
#pragma unroll
    for (int kb = 0; kb < 4; ++kb) {
        bf16x8 pa;
        { const unsigned a0 = pk2(st[2 * kb][0], st[2 * kb][1]), a1 = pk2(st[2 * kb][2], st[2 * kb][3]), a2 = pk2(st[2 * kb + 1][0], st[2 * kb + 1][1]), a3 = pk2(st[2 * kb + 1][2], st[2 * kb + 1][3]);
          u32x4 t; t.x = a0; t.y = a1; t.z = a2; t.w = a3; pa = __builtin_bit_cast(bf16x8, t); }
#pragma unroll
        for (int et = 0; et < 4; ++et) {
            const u32x2 v0 = *(LAS const u32x2*)(VT + (16 * et + fr) * TS + 32 * kb + 4 * fq);
            const u32x2 v1 = *(LAS const u32x2*)(VT + (16 * et + fr) * TS + 32 * kb + 16 + 4 * fq);
            u32x4 t; t.x = v0.x; t.y = v0.y; t.z = v1.x; t.w = v1.y;
            oi[et] = MFMA16(pa, __builtin_bit_cast(bf16x8, t), oi[et]);
        }
    }
#pragma unroll
    for (int et = 0; et < 4; ++et)
#pragma unroll
        for (int kk = 0; kk < 2; ++kk) {
            const bf16x8 sf = *(LAS const bf16x8*)(SL + (16 * et + fr) * KS + 32 * kk + 8 * fq);
            const bf16x8 sb = *(LAS const bf16x8*)(SL + (64 + 16 * et + fr) * KS + 32 * kk + 8 * fq);
            of[et] = MFMA16(qr[kk], sf, of[et]); ob[et] = MFMA16(qr[kk], sb, ob[et]);
        }
    const float* gg = p.in[16] + 64 * h; const float* gb = p.in[17] + 64 * h;
#pragma unroll
    for (int r = 0; r < 4; ++r) {
        const int i = t0 + 4 * fq + r;
        const float qdf = __builtin_amdgcn_exp2f((float)(i + 1) * lf), qdb = __builtin_amdgcn_exp2f((float)(128 - i) * lb);
        float o[4]; float s = 0.f;
#pragma unroll
        for (int et = 0; et < 4; ++et) { o[et] = oi[et][r] + qdf * of[et][r] + qdb * ob[et][r]; s += o[et]; }
        s += dppf<0x128>(s); s += dppf<0x124>(s); s += dppf<0x122>(s); s += dppf<0x121>(s);
        const float mu = s * (1.0f / 64.0f);
        float vs = 0.f;
#pragma unroll
        for (int et = 0; et < 4; ++et) { o[et] -= mu; vs += o[et] * o[et]; }
        vs += dppf<0x128>(vs); vs += dppf<0x124>(vs); vs += dppf<0x122>(vs); vs += dppf<0x121>(vs);
        const float rstd = __builtin_amdgcn_rsqf(vs * (1.0f / 64.0f) + EPS);
        const size_t tok = tok0 + i;
#pragma unroll
        for (int et = 0; et < 4; ++et) {
            const int e = 16 * et + fr;
            const float gate = bf1(gates[r][et]);
            const float y = (o[et] * rstd * gg[e] + gb[e]) * (gate * __builtin_amdgcn_rcpf(1.0f + __builtin_amdgcn_exp2f(-1.4426950409f * gate)));
            Yc[tok * DM + 512 + 64 * h + e] = (bf16_t)(pk2(y, 0.f) & 0xffff);
        }
    }
    }
}
__device__ __forceinline__ float gelu_tanh(float x) {
    const float u = 0.7978845608028654f * (x + 0.044715f * x * x * x);
    return x / (1.0f + __expf(-2.0f * u));
}
__device__ __forceinline__ void unpack8(const u32x4 x, float (&v)[8]) {
    v[0] = bflo(x.x); v[1] = bfhi(x.x); v[2] = bflo(x.y); v[3] = bfhi(x.y); v[4] = bflo(x.z); v[5] = bfhi(x.z); v[6] = bflo(x.w); v[7] = bfhi(x.w);
}
__device__ __forceinline__ void phase_i(const Params& p, int g0) {
    const bf16_t* U = (const bf16_t*)p.out;
    bf16_t* G = (bf16_t*)(p.ws + WS_B);
    const float* cw = p.in[21]; const float* cb = p.in[22];
    constexpr int NCH = DFF / 4, RUN = 8;
    const int tid = opaque_tid();
    for (int id = blockIdx.x * 512 + tid; id < (GROUP_TOK / RUN) * NCH; id += gridDim.x * 512) {
        const int cc = id % NCH, run = id / NCH, ca = 4 * cc, cbcol = DFF + 4 * cc;
        const int l0 = run * RUN;
        const int t0 = (g0 + l0) & (SEQL - 1);
        u32x2 ra[RUN + 2], rb[RUN + 2];
#pragma unroll
        for (int q = 0; q < RUN + 2; ++q) {
            const bool valid = (q == 0) ? (t0 > 0) : ((q == RUN + 1) ? (t0 + RUN < SEQL) : true);
            ra[q] = (u32x2){0u, 0u}; rb[q] = (u32x2){0u, 0u};
            if (valid) { const bf16_t* rowp = U + (size_t)(l0 - 1 + q) * UPC; ra[q] = *(const u32x2*)(rowp + ca); rb[q] = *(const u32x2*)(rowp + cbcol); }
        }
        f32x4 wa[3], wb[3];
#pragma unroll
        for (int k = 0; k < 3; ++k) { wa[k] = *(const f32x4*)(cw + k * UPC + ca); wb[k] = *(const f32x4*)(cw + k * UPC + cbcol); }
        const f32x4 ba = *(const f32x4*)(cb + ca), bb = *(const f32x4*)(cb + cbcol);
#pragma unroll
        for (int q = 0; q < RUN; ++q) {
            f32x4 pa, ca_, na, pb, cb_, nb;
            pa[0] = bflo(ra[q].x); pa[1] = bfhi(ra[q].x); pa[2] = bflo(ra[q].y); pa[3] = bfhi(ra[q].y);
            ca_[0] = bflo(ra[q + 1].x); ca_[1] = bfhi(ra[q + 1].x); ca_[2] = bflo(ra[q + 1].y); ca_[3] = bfhi(ra[q + 1].y);
            na[0] = bflo(ra[q + 2].x); na[1] = bfhi(ra[q + 2].x); na[2] = bflo(ra[q + 2].y); na[3] = bfhi(ra[q + 2].y);
            pb[0] = bflo(rb[q].x); pb[1] = bfhi(rb[q].x); pb[2] = bflo(rb[q].y); pb[3] = bfhi(rb[q].y);
            cb_[0] = bflo(rb[q + 1].x); cb_[1] = bfhi(rb[q + 1].x); cb_[2] = bflo(rb[q + 1].y); cb_[3] = bfhi(rb[q + 1].y);
            nb[0] = bflo(rb[q + 2].x); nb[1] = bfhi(rb[q + 2].x); nb[2] = bflo(rb[q + 2].y); nb[3] = bfhi(rb[q + 2].y);
            const f32x4 av = wa[0] * pa + wa[1] * ca_ + wa[2] * na + ba;
            const f32x4 bv = wb[0] * pb + wb[1] * cb_ + wb[2] * nb + bb;
            u32x2 ov; ov.x = pk2(gelu_tanh(av[0]) * bv[0], gelu_tanh(av[1]) * bv[1]); ov.y = pk2(gelu_tanh(av[2]) * bv[2], gelu_tanh(av[3]) * bv[3]);
            *(u32x2*)(G + (size_t)(g0 + l0 + q) * DFF + ca) = ov;
        }
    }
}
__device__ __forceinline__ void phase_k(const Params& p) {
    const int tid = opaque_tid(), wave = tid >> 6, lane = tid & 63;
    const float* part = (const float*)(p.ws + WS_P3); const float* fg = p.in[24];
    f32x4 g[4];
#pragma unroll
    for (int j = 0; j < 4; ++j) g[j] = *(const f32x4*)(fg + 256 * j + 4 * lane);
    const int NGW = gridDim.x * 8;
    for (int row0 = blockIdx.x * 8 + wave; row0 < NTOK; row0 += 2 * NGW) {
        const int row1 = (row0 + NGW < NTOK) ? row0 + NGW : row0;
        float ss0 = (lane < 16) ? part[(size_t)row0 * 16 + lane] : 0.f, ss1 = (lane < 16) ? part[(size_t)row1 * 16 + lane] : 0.f;
        const bf16_t* y0 = y_row(p.ws, row0); const bf16_t* y1 = y_row(p.ws, row1);
        u32x2 v0[4], v1[4];
#pragma unroll
        for (int j = 0; j < 4; ++j) { v0[j] = *(const u32x2*)(y0 + 256 * j + 4 * lane); v1[j] = *(const u32x2*)(y1 + 256 * j + 4 * lane); }
        ss0 = wave_sum(ss0); ss1 = wave_sum(ss1);
        const float rs0 = 1.0f / sqrtf(ss0 * (1.0f / DM) + EPS), rs1 = 1.0f / sqrtf(ss1 * (1.0f / DM) + EPS);
        float* o0 = p.out + (size_t)row0 * DM; float* o1 = p.out + (size_t)row1 * DM;
#pragma unroll
        for (int j = 0; j < 4; ++j) { f32x4 v; v[0] = bflo(v0[j].x); v[1] = bfhi(v0[j].x); v[2] = bflo(v0[j].y); v[3] = bfhi(v0[j].y); *(f32x4*)(o0 + 256 * j + 4 * lane) = v * g[j] * rs0; }
        if (row1 != row0) {
#pragma unroll
            for (int j = 0; j < 4; ++j) { f32x4 v; v[0] = bflo(v1[j].x); v[1] = bfhi(v1[j].x); v[2] = bflo(v1[j].y); v[3] = bfhi(v1[j].y); *(f32x4*)(o1 + 256 * j + 4 * lane) = v * g[j] * rs1; }
        }
    }
}


__device__ __forceinline__ void diag_dump_bf16(const Params& p, const bf16_t* src) {
    for (size_t i = (size_t)blockIdx.x * 512 + threadIdx.x; i < (size_t)NTOK * DM; i += (size_t)gridDim.x * 512) p.out[i] = bf1(src[i]);
}
__device__ __forceinline__ void diag_dump_c(const Params& p) {
    const bf16_t* PhT = (const bf16_t*)(p.ws + WS_C);
    for (size_t i = (size_t)blockIdx.x * 512 + threadIdx.x; i < (size_t)NTOK * DM; i += (size_t)gridDim.x * 512) {
        const unsigned u = ((const unsigned*)p.out)[i]; const size_t tok = i >> 10; const int c = (int)(i & 1023);
        p.out[i] = bflo(u) + bfhi(u) + bf1(PhT[(size_t)c * NTOK + tok]) + bf1(PhT[(size_t)(c + 512) * NTOK + tok]);
    }
}

__device__ __forceinline__ void gsync(const Params& p, int k, int xok = 0) {
    if (!xok) { cg::this_grid().sync(); return; }
    asm volatile("s_waitcnt vmcnt(0)" ::: "memory");
    __syncthreads();
    if (threadIdx.x == 0) {
        unsigned* bar = (unsigned*)(p.ws + WS_BAR);
        const unsigned r = (unsigned)(k - 2), per = gridDim.x >> 3;
        const unsigned xcc = (unsigned)__builtin_amdgcn_s_getreg((3 << 11) | 20) & 7u;
        const unsigned a = __hip_atomic_fetch_add(bar + 64 + 64 * xcc, 1u, __ATOMIC_RELAXED, __HIP_MEMORY_SCOPE_AGENT) + 1u;
        if (a == per * r) {
            __builtin_amdgcn_fence(__ATOMIC_RELEASE, "agent");
            asm volatile("s_waitcnt vmcnt(0)" ::: "memory");
            __hip_atomic_fetch_add(bar + 900, 1u, __ATOMIC_RELAXED, __HIP_MEMORY_SCOPE_AGENT);
        }
        unsigned spins = 0;
        while (__hip_atomic_load(bar + 900, __ATOMIC_RELAXED, __HIP_MEMORY_SCOPE_AGENT) < 8u * r && ++spins < (1u << 22)) __builtin_amdgcn_s_sleep(2);
        __builtin_amdgcn_fence(__ATOMIC_ACQUIRE, "agent");
        asm volatile("s_waitcnt vmcnt(0)" ::: "memory");
    }
    __syncthreads();
}
__global__ void __launch_bounds__(512, 2) fwd_megakernel(Params p) {
    extern __shared__ __attribute__((aligned(16))) unsigned char shm[];
    LAS unsigned char* lds = (LAS unsigned char*)shm;
    unsigned char* ws = p.ws;
    pg8::StaticOrder S;
    const int G = gridDim.x, c = blockIdx.x;

    if (threadIdx.x == 0) __hip_atomic_fetch_add((unsigned*)(ws + WS_BAR) + 16 + ((unsigned)__builtin_amdgcn_s_getreg((3 << 11) | 20) & 7u), 1u, __ATOMIC_RELAXED, __HIP_MEMORY_SCOPE_AGENT);
    phase_a(p, lds);
    gsync(p, 1);
    int xok;
    {
        const unsigned* cnt = (const unsigned*)(ws + WS_BAR) + 16;
        bool ok = (G % 8) == 0;
#pragma unroll
        for (int x = 0; x < 8; ++x) ok = ok && (__hip_atomic_load(cnt + x, __ATOMIC_RELAXED, __HIP_MEMORY_SCOPE_AGENT) == (unsigned)(G / 8));
        xok = __builtin_amdgcn_readfirstlane(ok ? 1 : 0);
    }
    phase_rf(p);
    __syncthreads();
#pragma unroll 1
    for (int rep = 0; rep < (PROBE == 2 ? 2 : 1); ++rep) {
    {
        pg8::Gemm g{(const bf16_t*)(ws + WS_WIN), (const bf16_t*)(ws + WS_A), HCOLS, NTOK, DM, 0};
        EpiHy E{(bf16_t*)(ws + WS_C), (const float*)(ws + WS_RS1)};
        S.init(g.M, g.N, G, c); pg8::gemm_phase(lds, g, S, E);
    }
    {
        pg8::Gemm g{(const bf16_t*)(ws + WS_A), (const bf16_t*)(ws + WS_WIN) + (size_t)HCOLS * DM, NTOK, RCOLS, DM, 0};
        EpiRet E{(bf16_t*)p.out, (const float*)(ws + WS_RS1), (const float*)(ws + WS_CS)};
        S.init(g.M, g.N, G, c); pg8::gemm_phase(lds, g, S, E);
    }
    }
    if (PROBE == 7) {
        EpiNull E{(float*)(ws + WS_BAR + 512)};
        pg8::Gemm g{(const bf16_t*)(ws + WS_A), (const bf16_t*)(ws + WS_WUP), 16384, 3072, DM, 0}; S.init(g.M, g.N, G, c); pg8::gemm_phase(lds, g, S, E);
    }
    if (PROBE == 4) {
        EpiNull E{(float*)(ws + WS_BAR + 512)};
        { pg8::Gemm g{(const bf16_t*)(ws + WS_WIN), (const bf16_t*)(ws + WS_A), HCOLS, NTOK, DM, 0}; S.init(g.M, g.N, G, c); pg8::gemm_phase(lds, g, S, E); }
        { pg8::Gemm g{(const bf16_t*)(ws + WS_A), (const bf16_t*)(ws + WS_WIN) + (size_t)HCOLS * DM, NTOK, RCOLS, DM, 0}; S.init(g.M, g.N, G, c); pg8::gemm_phase(lds, g, S, E); }
    }
    gsync(p, 3, xok);
    if (DIAG == 3) { diag_dump_c(p); return; }
    if (DIAG == 32) {
        const bf16_t* Pr = (const bf16_t*)p.out; float* scr = (float*)(ws + WS_D);
        for (int i = blockIdx.x * 512 + threadIdx.x; i < 384 * 2048; i += gridDim.x * 512) {
            const int n = i >> 11, col = i & 2047; float a = 0.f;
            for (int r = 0; r < 128; ++r) a += bf1(Pr[(size_t)(n * 128 + r) * RCOLS + col]) * (float)(1 + (r & 3));
            scr[i] = a; }
        gsync(p, 4, xok);
        for (size_t i = (size_t)blockIdx.x * 512 + threadIdx.x; i < (size_t)NTOK * DM; i += (size_t)gridDim.x * 512) p.out[i] = (i < 384 * 2048) ? scr[i] : 0.f;
        return; }
    phase_d(p, lds);
    gsync(p, 4, xok);
    if (DIAG == 47) { const unsigned* KVu = (const unsigned*)(ws + WS_A);
        for (size_t i = (size_t)blockIdx.x * 512 + threadIdx.x; i < (size_t)NTOK * DM; i += (size_t)gridDim.x * 512) {
            float v = 0.f;
            if (i < (size_t)96 * 32 * 4096) { const unsigned u = __hip_atomic_load(KVu + i, __ATOMIC_RELAXED, __HIP_MEMORY_SCOPE_AGENT); v = bflo(u) + 2.0f * bfhi(u); }
            p.out[i] = v; }
        return; }
    if (DIAG == 44 || DIAG == 45 || DIAG == 46) { const bf16_t* KV = (const bf16_t*)(ws + WS_A);
        for (size_t i = (size_t)blockIdx.x * 512 + threadIdx.x; i < (size_t)NTOK * DM; i += (size_t)gridDim.x * 512) p.out[i] = (i < (size_t)96 * 32 * 2 * 4096) ? bf1(KV[i]) : 0.f;
        return; }
    phase_e(p, lds);
    gsync(p, 5, xok);
    if (DIAG == 5) { const bf16_t* Yc = (const bf16_t*)(ws + WS_C);
        for (size_t i = (size_t)blockIdx.x * 512 + threadIdx.x; i < (size_t)NTOK * DM; i += (size_t)gridDim.x * 512) p.out[i] = bf1(Yc[(i & ~(size_t)1023) + (i & 511)]);
        return; }
    if (DIAG == 55) { const bf16_t* KV = (const bf16_t*)(ws + WS_A);
        for (size_t i = (size_t)blockIdx.x * 512 + threadIdx.x; i < (size_t)NTOK * DM; i += (size_t)gridDim.x * 512) p.out[i] = (i < (size_t)96 * 32 * 2 * 4096) ? bf1(KV[i]) : 0.f;
        return; }
    {
        RoRegs rr;
        if ((int)blockIdx.x < 96 * 16) ret_out_load(p, blockIdx.x, opaque_tid(), rr);
#pragma unroll 1
        for (int it = blockIdx.x; it < 96 * 16; it += gridDim.x) { const int nx = it + (int)gridDim.x; ret_out_pair(p, lds, it, rr, nx < 96 * 16 ? nx : -1); }
    }
    gsync(p, 6, xok);
    if (DIAG == 6) { diag_dump_bf16(p, (const bf16_t*)(ws + WS_C)); return; }
    {
        pg8::Gemm g{(const bf16_t*)(ws + WS_C), (const bf16_t*)(ws + WS_WOUT), NTOK, DM, DM, 0};
        EpiOut E{(bf16_t*)(ws + WS_A), (float*)(ws + WS_P2), (LAS float*)(lds + 131072)};
        S.init(g.M, g.N, G, c); pg8::gemm_phase(lds, g, S, E);
    }
    gsync(p, 7, xok);
    if (DIAG == 7) { diag_dump_bf16(p, (const bf16_t*)(ws + WS_A)); return; }
    {
        pg8::Gemm g{(const bf16_t*)(ws + WS_A), (const bf16_t*)(ws + WS_WUP), 12 * 17 * 256, UPC, DM, 17};
        EpiFfn E{(bf16_t*)(ws + WS_B), (const float*)(ws + WS_P2), p.in[21], p.in[22], (LAS float*)(lds + 131072)};
        S.init(g.M, g.N, G, c, 2); pg8::gemm_phase(lds, g, S, E);
    }
    gsync(p, 8, xok);
    {
        pg8::Gemm g{(const bf16_t*)(ws + WS_B), (const bf16_t*)(ws + WS_WDN), NTOK, DM, DFF, 0};
        EpiDown E{ws, (const bf16_t*)(ws + WS_A), (float*)(ws + WS_P3)};
        S.init(g.M, g.N, G, c); pg8::gemm_phase(lds, g, S, E);
    }
    gsync(p, 9, xok);
    phase_k(p);
}

extern "C" void kernel_launch(void* const* d_in, const int* in_sizes, int n_in, void* d_out, int out_size, void* d_ws, size_t ws_size, hipStream_t stream) {
    static int grid_blocks = 0;
    if (grid_blocks == 0) {
        if (n_in != 25 || out_size != NTOK * DM || ws_size < WS_END) { fprintf(stderr, "kernel_launch: unexpected shapes (n_in %d out %d ws %zu)\n", n_in, out_size, ws_size); grid_blocks = -1; return; }
        int dev = 0, cus = 0, per_cu = 0;
        hipGetDevice(&dev);
        hipDeviceGetAttribute(&cus, hipDeviceAttributeMultiprocessorCount, dev);
        hipFuncSetAttribute((const void*)fwd_megakernel, hipFuncAttributeMaxDynamicSharedMemorySize, LDS_BYTES);
        hipOccupancyMaxActiveBlocksPerMultiprocessor(&per_cu, (const void*)fwd_megakernel, 512, LDS_BYTES);
        if (per_cu < 1) { fprintf(stderr, "kernel_launch: occupancy query reports %d blocks per CU\n", per_cu); grid_blocks = -1; return; }
        if (per_cu > 1) per_cu = 1;
        grid_blocks = cus * per_cu;
    }
    if (grid_blocks < 0) return;
    Params p{};
    for (int i = 0; i < 25; ++i) p.in[i] = (const float*)d_in[i];
    p.out = (float*)d_out; p.ws = (unsigned char*)d_ws;
    hipMemsetAsync((char*)d_ws + WS_BAR, 0, 4096, stream);
    void* args[] = {&p};
    hipError_t e = hipLaunchCooperativeKernel((const void*)fwd_megakernel, dim3(grid_blocks), dim3(512), args, LDS_BYTES, stream);
    if (e != hipSuccess) fprintf(stderr, "cooperative launch failed: %s (grid %d)\n", hipGetErrorString(e), grid_blocks);
}
```
